# Optimizing an MI355X kernel written in HIP

```python
import jax, jax.numpy as jnp
from jax import lax
import numpy as np

D_MODEL = 1024
BATCH = 1
SEQ = 16384
DEPTH = 1

HEAD_DIM = 64
N_HEADS_MOBA = 8
N_HEADS_SB = 8
D_MOBA = N_HEADS_MOBA * HEAD_DIM
D_SB = N_HEADS_SB * HEAD_DIM
MOBA_BLOCK = 256
MOBA_TOP_K = 3
Q_CHUNK = 128
ROPE_THETA = 500000.0
ROPE_DIM = HEAD_DIM // 4
D_FF = 2816
FFN_RES = 0.5
EPS = 1e-6
D_IN = 3 * D_MOBA + 3 * D_SB + 2 * D_MODEL
NEG = -1e30

kernel_name = "hybrid_moba_stickbreaking_macaron"


def rms_norm(x, g):
    x32 = x.astype(jnp.float32)
    y = x32 * lax.rsqrt(jnp.mean(x32 * x32, axis=-1, keepdims=True) + EPS)
    return y.astype(x.dtype) * g


def swiglu(x, w_gate, w_up, w_down):
    return (jax.nn.silu(x @ w_gate) * (x @ w_up)) @ w_down


def partial_rotary(x, positions):
    half = ROPE_DIM // 2
    inv_freq = ROPE_THETA ** (-jnp.arange(half, dtype=jnp.float32) * 2.0 / ROPE_DIM)
    ang = positions.astype(jnp.float32)[:, None, :, None] * inv_freq
    cos = jnp.cos(ang).astype(x.dtype)
    sin = jnp.sin(ang).astype(x.dtype)
    x1, x2, rest = x[..., :half], x[..., half:ROPE_DIM], x[..., ROPE_DIM:]
    return jnp.concatenate([x1 * cos - x2 * sin, x2 * cos + x1 * sin, rest], axis=-1)


def split_heads(x, n):
    b, t, _ = x.shape
    return x.reshape(b, t, n, HEAD_DIM).transpose(0, 2, 1, 3)


def merge_heads(x):
    b, h, t, d = x.shape
    return x.transpose(0, 2, 1, 3).reshape(b, t, h * d)


def moba_attention(q, k, v):
    B, H, T, hd = q.shape
    nb = -(-T // MOBA_BLOCK)
    pad = nb * MOBA_BLOCK - T
    k_pad = jnp.pad(k, ((0, 0), (0, 0), (0, pad), (0, 0)))
    v_pad = jnp.pad(v, ((0, 0), (0, 0), (0, pad), (0, 0)))
    kb = k_pad.reshape(B, H, nb, MOBA_BLOCK, hd)
    vb = v_pad.reshape(B, H, nb, MOBA_BLOCK, hd)
    k_mean = jnp.mean(kb.astype(jnp.float32), axis=3)
    k_sel = min(MOBA_TOP_K, nb)
    scale = hd ** -0.5
    bi = jnp.arange(B)[:, None, None, None]
    hi = jnp.arange(H)[None, :, None, None]
    offs = jnp.arange(MOBA_BLOCK)
    blk_ids = jnp.arange(nb)

    def chunk(c):
        start = c * Q_CHUNK
        qc = lax.dynamic_slice_in_dim(q, start, Q_CHUNK, axis=2)
        t = start + jnp.arange(Q_CHUNK)
        own = start // MOBA_BLOCK
        gate = jnp.einsum('bhqd,bhnd->bhqn', qc.astype(jnp.float32), k_mean)
        gate = jnp.where(blk_ids < own, gate, NEG)
        _, idx = lax.top_k(gate, k_sel)
        valid = idx < own
        ks = kb[bi, hi, idx]
        vs = vb[bi, hi, idx]
        s_sel = jnp.einsum('bhqd,bhqkld->bhqkl', qc, ks).astype(jnp.float32) * scale
        s_sel = jnp.where(valid[..., None], s_sel, NEG).reshape(B, H, Q_CHUNK, k_sel * MOBA_BLOCK)
        k_own = lax.dynamic_index_in_dim(kb, own, axis=2, keepdims=False)
        v_own = lax.dynamic_index_in_dim(vb, own, axis=2, keepdims=False)
        s_own = jnp.einsum('bhqd,bhld->bhql', qc, k_own).astype(jnp.float32) * scale
        pos_own = own * MOBA_BLOCK + offs
        s_own = jnp.where(pos_own[None, :] <= t[:, None], s_own, NEG)
        p = jax.nn.softmax(jnp.concatenate([s_sel, s_own], axis=-1), axis=-1).astype(v.dtype)
        p_sel = p[..., :k_sel * MOBA_BLOCK].reshape(B, H, Q_CHUNK, k_sel, MOBA_BLOCK)
        p_own = p[..., k_sel * MOBA_BLOCK:]
        return (jnp.einsum('bhqkl,bhqkld->bhqd', p_sel, vs)
                + jnp.einsum('bhql,bhld->bhqd', p_own, v_own))

    out = lax.map(chunk, jnp.arange(T // Q_CHUNK))
    return out.transpose(1, 2, 0, 3, 4).reshape(B, H, T, hd)


def stick_breaking_attention(q, k, v):
    B, H, T, hd = q.shape
    scale = hd ** -0.5
    s_pos = jnp.arange(T)

    def chunk(c):
        start = c * Q_CHUNK
        qc = lax.dynamic_slice_in_dim(q, start, Q_CHUNK, axis=2)
        t = start + jnp.arange(Q_CHUNK)
        z = jnp.einsum('bhqd,bhsd->bhqs', qc, k).astype(jnp.float32) * scale
        past = s_pos[None, :] < t[:, None]
        log_fail = jnp.where(past, jax.nn.log_sigmoid(-z), 0.0)
        later = lax.cumsum(log_fail, axis=3, reverse=True) - log_fail
        w = jnp.where(past, jnp.exp(jax.nn.log_sigmoid(z) + later), 0.0)
        return jnp.einsum('bhqs,bhsd->bhqd', w.astype(v.dtype), v)

    out = lax.map(chunk, jnp.arange(T // Q_CHUNK))
    return out.transpose(1, 2, 0, 3, 4).reshape(B, H, T, hd)


def hybrid_mixer(u, positions, w_in, b_gate, w_branch_moba, w_branch_sb, w_out):
    proj = u @ w_in
    cuts = [D_MOBA, 2 * D_MOBA, 3 * D_MOBA, 3 * D_MOBA + D_SB, 3 * D_MOBA + 2 * D_SB,
            3 * D_MOBA + 3 * D_SB, 3 * D_MOBA + 3 * D_SB + D_MODEL]
    q_a, k_a, v_a, q_b, k_b, v_b, g_a, g_b = jnp.split(proj, cuts, axis=-1)
    q_a = partial_rotary(split_heads(q_a, N_HEADS_MOBA), positions)
    k_a = partial_rotary(split_heads(k_a, N_HEADS_MOBA), positions)
    y_a = merge_heads(moba_attention(q_a, k_a, split_heads(v_a, N_HEADS_MOBA)))
    y_b = merge_heads(stick_breaking_attention(split_heads(q_b, N_HEADS_SB),
                                               split_heads(k_b, N_HEADS_SB),
                                               split_heads(v_b, N_HEADS_SB)))
    gates = jax.nn.sigmoid(jnp.concatenate([g_a, g_b], axis=-1) + b_gate)
    gate_a, gate_b = gates[..., :D_MODEL], gates[..., D_MODEL:]
    merged = gate_a * (y_a @ w_branch_moba) + gate_b * (y_b @ w_branch_sb)
    return merged @ w_out


def setup_inputs(seed: int = 0) -> dict:
    key = jax.random.key(seed)
    ks = jax.random.split(key, 18)

    def w(k, shape, fan_in):
        return jax.random.normal(k, shape, jnp.float32) * fan_in ** -0.5

    def gain(k):
        return 1.0 + 0.05 * jax.random.normal(k, (DEPTH, D_MODEL), jnp.float32)

    return {
        "x": jax.random.normal(ks[0], (BATCH, SEQ, D_MODEL), jnp.float32),
        "positions": jnp.broadcast_to(jnp.arange(SEQ, dtype=jnp.int32), (BATCH, SEQ)),
        "ffn1_norm": gain(ks[1]),
        "ffn1_w_gate": w(ks[2], (DEPTH, D_MODEL, D_FF), D_MODEL),
        "ffn1_w_up": w(ks[3], (DEPTH, D_MODEL, D_FF), D_MODEL),
        "ffn1_w_down": w(ks[4], (DEPTH, D_FF, D_MODEL), D_FF),
        "mix_norm": gain(ks[5]),
        "w_in": w(ks[6], (DEPTH, D_MODEL, D_IN), D_MODEL),
        "b_gate": 0.02 * jax.random.normal(ks[7], (DEPTH, 2 * D_MODEL), jnp.float32),
        "w_branch_moba": w(ks[8], (DEPTH, D_MOBA, D_MODEL), D_MOBA),
        "w_branch_sb": w(ks[9], (DEPTH, D_SB, D_MODEL), D_SB),
        "w_out": w(ks[10], (DEPTH, D_MODEL, D_MODEL), D_MODEL),
        "ffn2_norm": gain(ks[11]),
        "ffn2_w_gate": w(ks[12], (DEPTH, D_MODEL, D_FF), D_MODEL),
        "ffn2_w_up": w(ks[13], (DEPTH, D_MODEL, D_FF), D_MODEL),
        "ffn2_w_down": w(ks[14], (DEPTH, D_FF, D_MODEL), D_FF),
        "final_norm": 1.0 + 0.05 * jax.random.normal(ks[15], (D_MODEL,), jnp.float32),
    }


def reference(x, positions, ffn1_norm, ffn1_w_gate, ffn1_w_up, ffn1_w_down, mix_norm, w_in,
              b_gate, w_branch_moba, w_branch_sb, w_out, ffn2_norm, ffn2_w_gate, ffn2_w_up,
              ffn2_w_down, final_norm):
    h = x
    for l in range(DEPTH):
        h = h + FFN_RES * swiglu(rms_norm(h, ffn1_norm[l]), ffn1_w_gate[l], ffn1_w_up[l], ffn1_w_down[l])
        h = h + hybrid_mixer(rms_norm(h, mix_norm[l]), positions, w_in[l], b_gate[l],
                             w_branch_moba[l], w_branch_sb[l], w_out[l])
        h = h + FFN_RES * swiglu(rms_norm(h, ffn2_norm[l]), ffn2_w_gate[l], ffn2_w_up[l], ffn2_w_down[l])
    return rms_norm(h, final_norm)
```

```cpp
#include <hip/hip_runtime.h>
#include <hip/hip_cooperative_groups.h>
#include <cstdio>
namespace cg = cooperative_groups;

#define LAS __attribute__((address_space(3)))
typedef unsigned short u16;
typedef short bf16x8 __attribute__((ext_vector_type(8)));
typedef short s16x4 __attribute__((ext_vector_type(4)));
typedef float f32x4 __attribute__((ext_vector_type(4)));
typedef unsigned u32x4 __attribute__((ext_vector_type(4)));
typedef unsigned u32x2 __attribute__((ext_vector_type(2)));

constexpr int T_ = 16384, D_ = 1024, DFF = 2816, DIN = 5120, NH = 8, HD = 64;
constexpr int LDA_ = 1536;
constexpr float EPS = 1e-6f;
constexpr int LISTH = 256 * 2016;
constexpr int N_PHASES = 12;
#ifndef PH_MASK
#define PH_MASK 0x1fff
#endif

constexpr size_t SZ_GU = (size_t)2 * DFF * D_ * 2, SZ_DN = (size_t)D_ * DFF * 2, SZ_IN = (size_t)DIN * D_ * 2, SZ_BR = (size_t)D_ * 512 * 2, SZ_WO = (size_t)D_ * D_ * 2;
constexpr size_t WS_GU1 = 0, WS_DN1 = WS_GU1 + SZ_GU, WS_IN = WS_DN1 + SZ_DN, WS_BA = WS_IN + SZ_IN, WS_BB = WS_BA + SZ_BR, WS_WO = WS_BB + SZ_BR,
                 WS_GU2 = WS_WO + SZ_WO, WS_DN2 = WS_GU2 + SZ_GU, WS_CS = WS_DN2 + SZ_DN;
constexpr size_t SZ_PART = (size_t)T_ * 16 * 4;
constexpr size_t WS_P0 = WS_CS + (size_t)T_ * 16 * 4, WS_P1 = WS_P0 + SZ_PART, WS_P2 = WS_P1 + SZ_PART, WS_P3 = WS_P2 + SZ_PART;
constexpr size_t WS_KMEAN = WS_P3 + SZ_PART, WS_CNT = WS_KMEAN + (size_t)64 * 2 * 512 * 4, WS_BAR = WS_CNT + 4096, WS_PML = WS_BAR + 32768;
constexpr size_t WS_LIST = WS_PML + (size_t)T_ * NH * 3 * 2 * 4;
constexpr size_t WS_AB = WS_LIST + (size_t)NH * LISTH * 2;
constexpr size_t WS_BIG = WS_AB + (size_t)T_ * D_ * 2;
constexpr size_t SZ_QKV = (size_t)T_ * LDA_ * 2;
constexpr size_t WS_GATES = WS_BIG, WS_QKVA = WS_GATES + (size_t)T_ * 2048 * 2, WS_QKVB = WS_QKVA + SZ_QKV, WS_END = WS_QKVB + SZ_QKV;
constexpr size_t WS_ACT = WS_BIG, WS_TMP = WS_QKVA, WS_MERGED = WS_TMP + (size_t)T_ * D_ * 4, WS_PO = WS_QKVB;
static_assert(WS_END <= (size_t)256 * 1024 * 1024, "workspace");
static_assert(WS_AB % 256 == 0 && WS_BIG % 256 == 0 && WS_LIST % 16 == 0, "align");

struct Params {
    const float* x; const int* pos;
    const float *n1, *g1, *u1, *d1, *nm, *win, *bg, *wba, *wbb, *wo, *n2, *g2, *u2, *d2, *nf;
    float* out; unsigned char* ws;
    int ph_lo, ph_hi, fpart, use_cg;
};

typedef __bf16 bf16x2_t __attribute__((ext_vector_type(2)));
typedef float f32x2_t __attribute__((ext_vector_type(2)));
__device__ __forceinline__ unsigned cvt_pk_bf16(float lo, float hi) { f32x2_t v = {lo, hi}; bf16x2_t b = __builtin_convertvector(v, bf16x2_t); return __builtin_bit_cast(unsigned, b); }
__device__ __forceinline__ float bf2f(u16 b) { return __uint_as_float(((unsigned)b) << 16); }
__device__ __forceinline__ float bflo(unsigned w) { return __uint_as_float(w << 16); }
__device__ __forceinline__ float bfhi(unsigned w) { return __uint_as_float(w & 0xffff0000u); }
__device__ __forceinline__ float fexp2(float x) { return __builtin_amdgcn_exp2f(x); }
__device__ __forceinline__ float frcp(float x) { return __builtin_amdgcn_rcpf(x); }

namespace pg8 {
constexpr int BM = 256, BK = 64, HALF = 128, HTB = HALF * BK * 2, STAGE_BYTES = 8 * HTB, NXCD = 8, WGM = 8;
__host__ __device__ __forceinline__ int lds_byte(int r, int c) { const int st = (r >> 4) * 2 + (c >> 5), rr = r & 15, cc = c & 31, ob = rr * 64 + cc * 2; return st * 1024 + (ob ^ (((ob >> 9) & 1) << 5)); }
__host__ __device__ __forceinline__ void stage_rc(int b, int& R, int& C) { const int st = b / 1024, sb = b % 1024, swz = sb ^ (((sb >> 9) & 1) << 5); R = (st >> 1) * 16 + swz / 64; C = (st & 1) * 32 + (swz % 64) / 2; }
struct Unit { int pm, pn; };
struct Gemm { const u16* A; const u16* Bt; int M, N, K; };
struct StaticOrder {
    int nM, nN, nwg, G, c;
    __host__ __device__ void init(int M, int N, int G_, int c_) { nM = M / BM; nN = N / BM; nwg = nM * nN; G = G_; c = c_; }
    __host__ __device__ bool next(int i, Unit& u) const {
        const long L = (long)i * G + c; if (L >= nwg) return false;
        int wgid = (int)L; { const int q = nwg / NXCD, r = nwg % NXCD, xcd = wgid % NXCD, off = wgid / NXCD; wgid = (xcd < r ? xcd * (q + 1) : r * (q + 1) + (xcd - r) * q) + off; }
        const int nig = WGM * nN, gid = wgid / nig, fm = gid * WGM, gsz = (nM - fm) < WGM ? (nM - fm) : WGM;
        u.pm = fm + ((wgid % nig) % gsz); u.pn = (wgid % nig) / gsz; return true;
    }
};

template <class Epi>
__device__ __forceinline__ void gemm_phase(LAS unsigned char* lds, const Gemm g, const StaticOrder& S, const Epi& E) {
    int tid_ = threadIdx.x; asm volatile("" : "+v"(tid_));
    const int tid = tid_, wid = __builtin_amdgcn_readfirstlane(tid >> 6), lane = tid & 63, wr = wid >> 2, wc = wid & 3, fr = lane & 15, fq = lane >> 4;
    const int K = g.K, nt = K / BK;
    unsigned voffA[2];
#pragma unroll
    for (int i = 0; i < 2; ++i) { int R, C; stage_rc(tid * 16 + i * 8192, R, C); voffA[i] = (unsigned)(R * K + C) * 2u; }
    const size_t kstep = (size_t)(BK * 2);
    const size_t hstep = (size_t)HALF * K * 2;
    const size_t tstep = 2 * hstep;
    const unsigned ldsw = (unsigned)wid * 1024u;
    const int aoff = lds_byte(wr * 64 + fr, fq * 8), boff = lds_byte(wc * 32 + fr, fq * 8);
#define PG8_SA(b, h) (((b) * 2 + (h)) * HTB)
#define PG8_SB(b, h) ((4 + (b) * 2 + (h)) * HTB)
#define PG8_STAGE(bufoff, gbase, voff) do { _Pragma("unroll") for (int _i = 0; _i < 2; ++_i) \
        __builtin_amdgcn_global_load_lds((const unsigned*)((const char*)(gbase) + (voff)[_i]), (LAS unsigned*)(lds + (bufoff) + ldsw + _i * 8192), 16, 0, 0); } while (0)
#define PG8_LDA(dst, b, h) do { _Pragma("unroll") for (int m = 0; m < 4; ++m) _Pragma("unroll") for (int k = 0; k < 2; ++k) dst[m][k] = *(const LAS bf16x8*)(lds + PG8_SA(b, h) + aoff + m * 2048 + k * 1024); } while (0)
#define PG8_LDB(dst, b, h) do { _Pragma("unroll") for (int n = 0; n < 2; ++n) _Pragma("unroll") for (int k = 0; k < 2; ++k) dst[n][k] = *(const LAS bf16x8*)(lds + PG8_SB(b, h) + boff + n * 2048 + k * 1024); } while (0)
#define PG8_MMA(ai, bj, At, Bt) do { __builtin_amdgcn_s_setprio(1); _Pragma("unroll") for (int m = 0; m < 4; ++m) _Pragma("unroll") for (int n = 0; n < 2; ++n) _Pragma("unroll") for (int k = 0; k < 2; ++k) \
        acc[ai][bj][m][n] = __builtin_amdgcn_mfma_f32_16x16x32_bf16(Bt[n][k], At[m][k], acc[ai][bj][m][n], 0, 0, 0); __builtin_amdgcn_s_setprio(0); } while (0)
#define PG8_WAIT_V(n) asm volatile("s_waitcnt vmcnt(" #n ")" ::: "memory")
#define PG8_WAIT_L(n) asm volatile("s_waitcnt lgkmcnt(" #n ")" ::: "memory")
#define PG8_BAR __builtin_amdgcn_s_barrier()
#define PG8_SCHED __builtin_amdgcn_sched_barrier(0)
    Unit cur, nxt; int ui = 0;
    if (!S.next(0, cur)) return;
    f32x4 acc[2][2][4][2];
#pragma unroll
    for (int a = 0; a < 2; ++a)
#pragma unroll
        for (int b = 0; b < 2; ++b)
#pragma unroll
            for (int m = 0; m < 4; ++m)
#pragma unroll
                for (int n = 0; n < 2; ++n) acc[a][b][m][n] = (f32x4){0.f, 0.f, 0.f, 0.f};
    bf16x8 At[4][2], B0[2][2], B1[2][2];
    const char* cA = (const char*)g.A + (size_t)cur.pm * tstep; const char* cB = (const char*)g.Bt + (size_t)cur.pn * tstep;
    PG8_STAGE(PG8_SB(0, 0), cB, voffA); PG8_STAGE(PG8_SA(0, 0), cA, voffA); PG8_STAGE(PG8_SB(0, 1), cB + hstep, voffA); PG8_STAGE(PG8_SA(0, 1), cA + hstep, voffA);
    if (wr == 1) PG8_BAR;
    PG8_WAIT_V(4); PG8_BAR;
    PG8_STAGE(PG8_SB(1, 0), cB + kstep, voffA); PG8_STAGE(PG8_SA(1, 0), cA + kstep, voffA); PG8_STAGE(PG8_SB(1, 1), cB + hstep + kstep, voffA);
    PG8_WAIT_V(6); PG8_BAR;
    for (;;) {
        const bool has_next = S.next(ui + 1, nxt);
        const char* nA = has_next ? (const char*)g.A + (size_t)nxt.pm * tstep : cA; const char* nB = has_next ? (const char*)g.Bt + (size_t)nxt.pn * tstep : cB;
        for (int t = 0; t < nt; t += 2) {
            const bool last = (t == nt - 2);
            const char* a1 = cA + (size_t)(t + 1) * kstep;
            const char* a2 = last ? nA : cA + (size_t)(t + 2) * kstep; const char* b2 = last ? nB : cB + (size_t)(t + 2) * kstep;
            const char* a3 = a2 + kstep; const char* b3 = b2 + kstep;
            PG8_LDB(B0, 0, 0); PG8_SCHED; PG8_LDA(At, 0, 0); PG8_STAGE(PG8_SA(1, 1), a1 + hstep, voffA);
            PG8_WAIT_L(8); PG8_BAR; PG8_WAIT_L(0); PG8_MMA(0, 0, At, B0); PG8_BAR; PG8_SCHED;
            PG8_LDB(B1, 0, 1); PG8_STAGE(PG8_SB(0, 0), b2, voffA);
            PG8_BAR; PG8_WAIT_L(0); PG8_MMA(0, 1, At, B1); PG8_BAR;
            PG8_LDA(At, 0, 1); PG8_STAGE(PG8_SA(0, 0), a2, voffA);
            PG8_BAR; PG8_WAIT_L(0); PG8_MMA(1, 0, At, B0); PG8_BAR; PG8_SCHED;
            PG8_STAGE(PG8_SB(0, 1), b2 + hstep, voffA);
            PG8_WAIT_V(6); PG8_BAR; PG8_MMA(1, 1, At, B1); PG8_BAR;
            PG8_LDB(B0, 1, 0); PG8_SCHED; PG8_LDA(At, 1, 0); PG8_STAGE(PG8_SA(0, 1), a2 + hstep, voffA);
            PG8_WAIT_L(8); PG8_BAR; PG8_WAIT_L(0); PG8_MMA(0, 0, At, B0); PG8_BAR; PG8_SCHED;
            PG8_LDB(B1, 1, 1); PG8_STAGE(PG8_SB(1, 0), b3, voffA);
            PG8_BAR; PG8_WAIT_L(0); PG8_MMA(0, 1, At, B1); PG8_BAR;
            PG8_LDA(At, 1, 1); PG8_STAGE(PG8_SA(1, 0), a3, voffA);
            PG8_BAR; PG8_WAIT_L(0); PG8_MMA(1, 0, At, B0); PG8_BAR; PG8_SCHED;
            PG8_STAGE(PG8_SB(1, 1), b3 + hstep, voffA);
            PG8_WAIT_V(6); PG8_BAR; PG8_MMA(1, 1, At, B1); PG8_BAR;
        }
        if constexpr (!Epi::AFTER_DRAIN) E(acc, cur, ui, wr, wc, fr, fq);
        if (!has_next) break;
#pragma unroll
        for (int a = 0; a < 2; ++a)
#pragma unroll
            for (int b = 0; b < 2; ++b)
#pragma unroll
                for (int m = 0; m < 4; ++m)
#pragma unroll
                    for (int n = 0; n < 2; ++n) acc[a][b][m][n] = (f32x4){0.f, 0.f, 0.f, 0.f};
        cur = nxt; cA = nA; cB = nB; ++ui;
    }
    PG8_WAIT_V(0);
    if (wr == 0) PG8_BAR;
    PG8_BAR;
    if constexpr (Epi::AFTER_DRAIN) E.fused(acc, cur, wr, wc, fr, fq, lane);
#undef PG8_SA
#undef PG8_SB
#undef PG8_STAGE
#undef PG8_LDA
#undef PG8_LDB
#undef PG8_MMA
#undef PG8_WAIT_V
#undef PG8_WAIT_L
#undef PG8_BAR
#undef PG8_SCHED
}
}
using pg8::Unit;
typedef f32x4 Acc[2][2][4][2];

constexpr int XST_OFF = 152 * 1024, RTAB_OFF = XST_OFF + 64;
__device__ __forceinline__ void build_rtab(LAS unsigned char* lds, const pg8::StaticOrder& S, const float* part) {
    LAS float* rtab = (LAS float*)(lds + RTAB_OFF);
    int nu = 0; { pg8::Unit u; while (nu < 7 && S.next(nu, u)) ++nu; }
    for (int idx = threadIdx.x; idx < nu * 256; idx += 512) { pg8::Unit u; S.next(idx >> 8, u);
        const f32x4* pp = (const f32x4*)(part + (size_t)(u.pm * 256 + (idx & 255)) * 16);
        f32x4 a = pp[0], b = pp[1], c = pp[2], d = pp[3]; f32x4 sv = (a + b) + (c + d);
        rtab[idx] = __builtin_amdgcn_rsqf((sv[0] + sv[1] + sv[2] + sv[3]) * (1.0f / D_) + EPS); }
    __syncthreads();
}
__device__ __forceinline__ void rtab_get(float (&rinv)[2][4], LAS const unsigned char* lds, int ui, int wr, int fr) {
    LAS const float* rtab = (LAS const float*)(lds + RTAB_OFF) + ui * 256 + wr * 64 + fr;
#pragma unroll
    for (int ai = 0; ai < 2; ++ai)
#pragma unroll
        for (int m = 0; m < 4; ++m) rinv[ai][m] = rtab[ai * 128 + m * 16];
}

struct EpiSwiglu {
    static constexpr bool AFTER_DRAIN = false;
    u16* act; LAS const unsigned char* lds;
    __device__ __forceinline__ void operator()(const Acc& acc, const Unit& u, int ui, int wr, int wc, int fr, int fq) const {
        const int row0 = u.pm * 256 + wr * 64 + fr, col0 = u.pn * 128 + wc * 32 + fq * 8;
        float rinv[2][4]; rtab_get(rinv, lds, ui, wr, fr);
#pragma unroll
        for (int ai = 0; ai < 2; ++ai)
#pragma unroll
            for (int m = 0; m < 4; ++m) {
                const float ri = rinv[ai][m]; float v[8];
#pragma unroll
                for (int n = 0; n < 2; ++n)
#pragma unroll
                    for (int j = 0; j < 4; ++j) { const float g = acc[ai][0][m][n][j] * ri, up = acc[ai][1][m][n][j] * ri;
                        v[n * 4 + j] = g * frcp(1.0f + fexp2(-1.4426950408889634f * g)) * up; }
                u32x4 o; o[0] = cvt_pk_bf16(v[0], v[1]); o[1] = cvt_pk_bf16(v[2], v[3]); o[2] = cvt_pk_bf16(v[4], v[5]); o[3] = cvt_pk_bf16(v[6], v[7]);
                *(u32x4*)(act + (size_t)(row0 + ai * 128 + m * 16) * DFF + col0) = o;
            }
    }
};

template <bool OF> struct EpiResid {
    static constexpr bool AFTER_DRAIN = false;
    const u16* resid; float* out; u16* hb; float* part; float scale;
    __device__ __forceinline__ void operator()(const Acc& acc, const Unit& u, int ui, int wr, int wc, int fr, int fq) const {
        const int row0 = u.pm * 256 + wr * 64 + fr, col0 = u.pn * 256 + wc * 32 + fq * 8;
        u32x4 rwa[2][4][2];
#pragma unroll
        for (int ai = 0; ai < 2; ++ai)
#pragma unroll
            for (int m = 0; m < 4; ++m)
#pragma unroll
                for (int bj = 0; bj < 2; ++bj) rwa[ai][m][bj] = *(const u32x4*)(resid + (size_t)(row0 + ai * 128 + m * 16) * D_ + col0 + bj * 128);
#pragma unroll
        for (int ai = 0; ai < 2; ++ai) {
#pragma unroll
            for (int m = 0; m < 4; ++m) {
                const int row = row0 + ai * 128 + m * 16; float ss = 0.f;
#pragma unroll
                for (int bj = 0; bj < 2; ++bj) {
                    const size_t o = (size_t)row * D_ + col0 + bj * 128;
                    const u32x4 w = rwa[ai][m][bj];
                    f32x4 h0 = (f32x4){bflo(w[0]), bfhi(w[0]), bflo(w[1]), bfhi(w[1])} + acc[ai][bj][m][0] * scale;
                    f32x4 h1 = (f32x4){bflo(w[2]), bfhi(w[2]), bflo(w[3]), bfhi(w[3])} + acc[ai][bj][m][1] * scale;
                    ss += h0[0] * h0[0] + h0[1] * h0[1] + h0[2] * h0[2] + h0[3] * h0[3] + h1[0] * h1[0] + h1[1] * h1[1] + h1[2] * h1[2] + h1[3] * h1[3];
                    if (OF) { *(f32x4*)(out + o) = h0; *(f32x4*)(out + o + 4) = h1; }
                    else { u32x4 b; b[0] = cvt_pk_bf16(h0[0], h0[1]); b[1] = cvt_pk_bf16(h0[2], h0[3]); b[2] = cvt_pk_bf16(h1[0], h1[1]); b[3] = cvt_pk_bf16(h1[2], h1[3]); *(u32x4*)(hb + o) = b; }
                }
                ss += __shfl_xor(ss, 16); ss += __shfl_xor(ss, 32);
                if (fq == 0) part[(size_t)row * 16 + u.pn * 4 + wc] = ss;
            }
        }
    }
};

struct EpiWin {
    static constexpr bool AFTER_DRAIN = false;
    u16 *qkva, *qkvb, *gates; LAS const unsigned char* lds; const float *cs, *bgate; float* kmp;
    __device__ __forceinline__ void operator()(const Acc& acc, const Unit& u, int ui, int wr, int wc, int fr, int fq) const {
        const int row0 = u.pm * 256 + wr * 64 + fr;
        const int pn = u.pn;
        LAS const float* rtab = (LAS const float*)(lds + RTAB_OFF) + ui * 256 + wr * 64 + fr;
        if (pn >= 12) {
            f32x4 bb[2][2];
#pragma unroll
            for (int bj = 0; bj < 2; ++bj) { const int gc = pn * 256 + bj * 128 + wc * 32 - 3072 + fq * 8; bb[bj][0] = *(const f32x4*)(bgate + gc); bb[bj][1] = *(const f32x4*)(bgate + gc + 4); }
#pragma unroll
            for (int bj = 0; bj < 2; ++bj) { const int gc = pn * 256 + bj * 128 + wc * 32 - 3072 + fq * 8;
#pragma unroll
                for (int ai = 0; ai < 2; ++ai)
#pragma unroll
                    for (int m = 0; m < 4; ++m) { const float ri = rtab[ai * 128 + m * 16]; float v[8];
#pragma unroll
                        for (int j = 0; j < 4; ++j) { v[j] = acc[ai][bj][m][0][j] * ri + bb[bj][0][j]; v[4 + j] = acc[ai][bj][m][1][j] * ri + bb[bj][1][j]; }
#pragma unroll
                        for (int j = 0; j < 8; ++j) v[j] = frcp(1.0f + fexp2(-1.4426950408889634f * v[j]));
                        u32x4 o; o[0] = cvt_pk_bf16(v[0], v[1]); o[1] = cvt_pk_bf16(v[2], v[3]); o[2] = cvt_pk_bf16(v[4], v[5]); o[3] = cvt_pk_bf16(v[6], v[7]);
                        *(u32x4*)(gates + (size_t)(row0 + ai * 128 + m * 16) * 2048 + gc) = o; } }
        } else {
            const bool isk = (pn == 2) || (pn == 3);
#pragma unroll
            for (int bj = 0; bj < 2; ++bj) {
                const int g32 = pn * 256 + bj * 128 + wc * 32;
                u16* base = g32 < 1536 ? qkva + g32 : qkvb + (g32 - 1536);
                const bool rot = (g32 < 1024) && ((g32 & 63) == 0) && (fq < 2);
                f32x4 ks0 = {0.f, 0.f, 0.f, 0.f}, ks1 = {0.f, 0.f, 0.f, 0.f};
                if (rot) {
#pragma unroll
                    for (int ai = 0; ai < 2; ++ai) {
                        f32x4 cc[4], sn[4];
#pragma unroll
                        for (int m = 0; m < 4; ++m) { const int row = row0 + ai * 128 + m * 16; cc[m] = *(const f32x4*)(cs + (size_t)row * 16 + fq * 4); sn[m] = *(const f32x4*)(cs + (size_t)row * 16 + 8 + fq * 4); }
#pragma unroll
                        for (int m = 0; m < 4; ++m) { const float ri = rtab[ai * 128 + m * 16]; const int row = row0 + ai * 128 + m * 16;
                            f32x4 a = acc[ai][bj][m][0] * ri, b = acc[ai][bj][m][1] * ri;
                            f32x4 o1 = a * cc[m] - b * sn[m], o2 = b * cc[m] + a * sn[m];
                            u32x2 w1, w2; w1[0] = cvt_pk_bf16(o1[0], o1[1]); w1[1] = cvt_pk_bf16(o1[2], o1[3]); w2[0] = cvt_pk_bf16(o2[0], o2[1]); w2[1] = cvt_pk_bf16(o2[2], o2[3]);
                            *(u32x2*)(base + (size_t)row * LDA_ + fq * 4) = w1; *(u32x2*)(base + (size_t)row * LDA_ + 8 + fq * 4) = w2;
                            ks0 += o1; ks1 += o2; } }
                } else {
#pragma unroll
                    for (int ai = 0; ai < 2; ++ai)
#pragma unroll
                        for (int m = 0; m < 4; ++m) { const float ri = rtab[ai * 128 + m * 16]; const int row = row0 + ai * 128 + m * 16;
                            f32x4 a = acc[ai][bj][m][0] * ri, b = acc[ai][bj][m][1] * ri;
                            u32x4 o; o[0] = cvt_pk_bf16(a[0], a[1]); o[1] = cvt_pk_bf16(a[2], a[3]); o[2] = cvt_pk_bf16(b[0], b[1]); o[3] = cvt_pk_bf16(b[2], b[3]);
                            *(u32x4*)(base + (size_t)row * LDA_ + fq * 8) = o;
                            ks0 += a; ks1 += b; }
                }
                if (isk) {
#pragma unroll
                    for (int j = 0; j < 4; ++j) {
#pragma unroll
                        for (int o = 1; o < 16; o <<= 1) { ks0[j] += __shfl_xor(ks0[j], o); ks1[j] += __shfl_xor(ks1[j], o); } }
                    if (fr == 0) { float* kp = kmp + (size_t)u.pm * 512 + (g32 - 512);
#pragma unroll
                        for (int j = 0; j < 4; ++j) { atomicAdd(kp + (rot ? fq * 4 : fq * 8) + j, ks0[j]); atomicAdd(kp + (rot ? 8 + fq * 4 : fq * 8 + 4) + j, ks1[j]); } }
                }
            }
        }
    }
};

template <bool FIRST> struct EpiBranch {
    static constexpr bool AFTER_DRAIN = false;
    const u16* gates; u16* tmp; u16* merged;
    __device__ __forceinline__ void operator()(const Acc& acc, const Unit& u, int ui, int wr, int wc, int fr, int fq) const {
        const int row0 = u.pm * 256 + wr * 64 + fr, col0 = u.pn * 256 + wc * 32 + fq * 8;
        constexpr int NB = FIRST ? 1 : 2, AIB = FIRST ? 2 : 1;
#pragma unroll
        for (int bt = 0; bt < NB; ++bt) {
            u32x4 gw[AIB][4][2], tw[AIB][4][2];
#pragma unroll
            for (int a2 = 0; a2 < AIB; ++a2)
#pragma unroll
                for (int m = 0; m < 4; ++m)
#pragma unroll
                    for (int bj = 0; bj < 2; ++bj) { const int ai = FIRST ? a2 : bt, row = row0 + ai * 128 + m * 16, col = col0 + bj * 128;
                        gw[a2][m][bj] = *(const u32x4*)(gates + (size_t)row * 2048 + (FIRST ? 0 : 1024) + col);
                        if (!FIRST) tw[a2][m][bj] = *(const u32x4*)(tmp + (size_t)row * D_ + col); }
#pragma unroll
            for (int a2 = 0; a2 < AIB; ++a2)
#pragma unroll
                for (int m = 0; m < 4; ++m)
#pragma unroll
                    for (int bj = 0; bj < 2; ++bj) { const int ai = FIRST ? a2 : bt, row = row0 + ai * 128 + m * 16, col = col0 + bj * 128;
                        const u32x4 g2 = gw[a2][m][bj];
                        f32x4 v0 = (f32x4){bflo(g2[0]), bfhi(g2[0]), bflo(g2[1]), bfhi(g2[1])} * acc[ai][bj][m][0];
                        f32x4 v1 = (f32x4){bflo(g2[2]), bfhi(g2[2]), bflo(g2[3]), bfhi(g2[3])} * acc[ai][bj][m][1];
                        if (!FIRST) { const u32x4 t2 = tw[a2][m][bj]; v0 += (f32x4){bflo(t2[0]), bfhi(t2[0]), bflo(t2[1]), bfhi(t2[1])}; v1 += (f32x4){bflo(t2[2]), bfhi(t2[2]), bflo(t2[3]), bfhi(t2[3])}; }
                        u32x4 b; b[0] = cvt_pk_bf16(v0[0], v0[1]); b[1] = cvt_pk_bf16(v0[2], v0[3]); b[2] = cvt_pk_bf16(v1[0], v1[1]); b[3] = cvt_pk_bf16(v1[2], v1[3]);
                        *(u32x4*)((FIRST ? tmp : merged) + (size_t)row * D_ + col) = b; }
        }
    }
};

struct EpiFinal {
    static constexpr bool AFTER_DRAIN = true;
    const u16* resid; float* out; float* part; unsigned* pcnt; const float* gain; float scale;
    __device__ __forceinline__ void operator()(const Acc&, const Unit&, int, int, int, int, int) const {}
    __device__ __forceinline__ void fused(Acc& acc, const Unit& u, int wr, int wc, int fr, int fq, int lane) const {
        const int row0 = u.pm * 256 + wr * 64 + fr, col0 = u.pn * 256 + wc * 32 + fq * 8;
        u32x4 rwa[2][4][2];
#pragma unroll
        for (int ai = 0; ai < 2; ++ai)
#pragma unroll
            for (int m = 0; m < 4; ++m)
#pragma unroll
                for (int bj = 0; bj < 2; ++bj) rwa[ai][m][bj] = *(const u32x4*)(resid + (size_t)(row0 + ai * 128 + m * 16) * D_ + col0 + bj * 128);
#pragma unroll
        for (int ai = 0; ai < 2; ++ai)
#pragma unroll
            for (int m = 0; m < 4; ++m) { float ss = 0.f;
#pragma unroll
                for (int bj = 0; bj < 2; ++bj) { const u32x4 w = rwa[ai][m][bj];
                    f32x4 h0 = (f32x4){bflo(w[0]), bfhi(w[0]), bflo(w[1]), bfhi(w[1])} + acc[ai][bj][m][0] * scale;
                    f32x4 h1 = (f32x4){bflo(w[2]), bfhi(w[2]), bflo(w[3]), bfhi(w[3])} + acc[ai][bj][m][1] * scale;
                    acc[ai][bj][m][0] = h0; acc[ai][bj][m][1] = h1;
                    ss += h0[0] * h0[0] + h0[1] * h0[1] + h0[2] * h0[2] + h0[3] * h0[3] + h1[0] * h1[0] + h1[1] * h1[1] + h1[2] * h1[2] + h1[3] * h1[3]; }
                ss += __shfl_xor(ss, 16); ss += __shfl_xor(ss, 32);
                if (fq == 0) __hip_atomic_store(part + (size_t)(row0 + ai * 128 + m * 16) * 16 + u.pn * 4 + wc, ss, __ATOMIC_RELAXED, __HIP_MEMORY_SCOPE_AGENT); }
        asm volatile("s_waitcnt vmcnt(0)" ::: "memory");
        unsigned* cw = pcnt + u.pm * 16;
        if (lane == 0) {
            __hip_atomic_fetch_add(cw, 1u, __ATOMIC_RELAXED, __HIP_MEMORY_SCOPE_AGENT);
            unsigned sp = 0;
            while (__hip_atomic_load(cw, __ATOMIC_RELAXED, __HIP_MEMORY_SCOPE_AGENT) < 32u) { __builtin_amdgcn_s_sleep(1); if (++sp > (1u << 22)) break; }
        }
        float rinv[2][4];
        { float pv[2][4][4];
#pragma unroll
          for (int ai = 0; ai < 2; ++ai)
#pragma unroll
            for (int m = 0; m < 4; ++m)
#pragma unroll
              for (int k = 0; k < 4; ++k) pv[ai][m][k] = __hip_atomic_load(part + (size_t)(row0 + ai * 128 + m * 16) * 16 + fq * 4 + k, __ATOMIC_RELAXED, __HIP_MEMORY_SCOPE_AGENT);
#pragma unroll
          for (int ai = 0; ai < 2; ++ai)
#pragma unroll
            for (int m = 0; m < 4; ++m) { float sv = (pv[ai][m][0] + pv[ai][m][1]) + (pv[ai][m][2] + pv[ai][m][3]);
                sv += __shfl_xor(sv, 16); sv += __shfl_xor(sv, 32); rinv[ai][m] = __builtin_amdgcn_rsqf(sv * (1.0f / D_) + EPS); } }
        f32x4 gv[2][2];
#pragma unroll
        for (int bj = 0; bj < 2; ++bj)
#pragma unroll
            for (int n = 0; n < 2; ++n) gv[bj][n] = *(const f32x4*)(gain + col0 + bj * 128 + n * 4);
#pragma unroll
        for (int ai = 0; ai < 2; ++ai)
#pragma unroll
            for (int m = 0; m < 4; ++m)
#pragma unroll
                for (int bj = 0; bj < 2; ++bj)
#pragma unroll
                    for (int n = 0; n < 2; ++n)
                        *(f32x4*)(out + (size_t)(row0 + ai * 128 + m * 16) * D_ + col0 + bj * 128 + n * 4) = acc[ai][bj][m][n] * rinv[ai][m] * gv[bj][n];
    }
};

__device__ __forceinline__ int map_gu(int c, int up) { const int pn = c >> 7, w = c & 127, wc = w >> 5, r = w & 31; return pn * 256 + up * 128 + wc * 32 + ((r >> 2) & 1) * 16 + (r >> 3) * 4 + (r & 3); }
__device__ __forceinline__ int map_perm8(int c) { const int r = c & 31; return (c & ~31) + ((r >> 2) & 1) * 16 + (r >> 3) * 4 + (r & 3); }
__device__ __forceinline__ int map_win(int c) { if (c < 1024 && (c & 63) < 16) { const int r = c & 15, x2 = r >> 3, i = r & 7; return (c & ~63) + x2 * 16 + (i >> 2) * 4 + (i & 3); } return map_perm8(c); }

struct TileDesc { const float* W; u16* Wt; const float* gain; int K, N, mode, tile; };
struct TileRegs { f32x4 v[2]; float gk[2]; };
__device__ __forceinline__ void tile_load(TileRegs& r, const TileDesc& d) {
    const int ntn = d.N >> 6, tk = d.tile / ntn, tn = d.tile - tk * ntn, k0 = tk * 64, n0 = tn * 64, tid = threadIdx.x;
    const float cscale = d.mode == 3 ? (n0 < 512 ? 0.125f * 1.4426950408889634f : (n0 >= 1536 && n0 < 2048) ? 0.125f : 1.0f) : 1.0f;
#pragma unroll
    for (int i = 0; i < 2; ++i) { const int e = tid + i * 512, k = e >> 4, c4 = (e & 15) * 4;
        r.v[i] = *(const f32x4*)(d.W + (size_t)(k0 + k) * d.N + n0 + c4); r.gk[i] = (d.gain ? d.gain[k0 + k] : 1.0f) * cscale; }
}
__device__ __forceinline__ void tile_store(LAS float* tl, const TileRegs& r, const TileDesc& d) {
    const int ntn = d.N >> 6, tk = d.tile / ntn, tn = d.tile - tk * ntn, k0 = tk * 64, n0 = tn * 64, tid = threadIdx.x;
    __syncthreads();
#pragma unroll
    for (int i = 0; i < 2; ++i) { const int e = tid + i * 512, k = e >> 4, c4 = (e & 15) * 4; const f32x4 v = r.v[i] * r.gk[i];
        tl[k * 65 + c4] = v[0]; tl[k * 65 + c4 + 1] = v[1]; tl[k * 65 + c4 + 2] = v[2]; tl[k * 65 + c4 + 3] = v[3]; }
    __syncthreads();
    const int n = tid & 63, kg = tid >> 6; float v[8];
#pragma unroll
    for (int i = 0; i < 8; ++i) v[i] = tl[(kg * 8 + i) * 65 + n];
    const int c = n0 + n; const int rr = d.mode == 0 ? c : d.mode == 1 ? map_gu(c, 0) : d.mode == 2 ? map_gu(c, 1) : d.mode == 3 ? map_win(c) : map_perm8(c);
    u32x4 o; o[0] = cvt_pk_bf16(v[0], v[1]); o[1] = cvt_pk_bf16(v[2], v[3]); o[2] = cvt_pk_bf16(v[4], v[5]); o[3] = cvt_pk_bf16(v[6], v[7]);
    *(u32x4*)(d.Wt + (size_t)rr * d.K + k0 + kg * 8) = o;
}

__device__ __forceinline__ void prep_phase(const Params& p, LAS unsigned char* lds) {
    unsigned char* ws = p.ws; LAS float* tl = (LAS float*)lds;
    const int tid = threadIdx.x, lane = tid & 63, wid = tid >> 6, G = gridDim.x;
    if (blockIdx.x == 0) { ((int*)(ws + WS_CNT))[tid] = 0; }
    if (blockIdx.x < 64) ((float*)(ws + WS_KMEAN))[blockIdx.x * 512 + tid] = 0.f;
    constexpr int T_GU = 16 * 44, T_DN = 44 * 16, T_IN = 16 * 80, T_BR = 8 * 16, T_WO = 16 * 16;
    constexpr int o1 = T_GU, o2 = o1 + T_GU, o3 = o2 + T_DN, o4 = o3 + T_IN, o5 = o4 + T_BR, o6 = o5 + T_BR, o7 = o6 + T_WO, o8 = o7 + T_GU, o9 = o8 + T_GU, o10 = o9 + T_DN;
    auto desc = [&](int t) -> TileDesc {
        if (t < o1) return TileDesc{p.g1, (u16*)(ws + WS_GU1), p.n1, D_, DFF, 1, t};
        if (t < o2) return TileDesc{p.u1, (u16*)(ws + WS_GU1), p.n1, D_, DFF, 2, t - o1};
        if (t < o3) return TileDesc{p.d1, (u16*)(ws + WS_DN1), nullptr, DFF, D_, 4, t - o2};
        if (t < o4) return TileDesc{p.win, (u16*)(ws + WS_IN), p.nm, D_, DIN, 3, t - o3};
        if (t < o5) return TileDesc{p.wba, (u16*)(ws + WS_BA), nullptr, 512, D_, 4, t - o4};
        if (t < o6) return TileDesc{p.wbb, (u16*)(ws + WS_BB), nullptr, 512, D_, 4, t - o5};
        if (t < o7) return TileDesc{p.wo, (u16*)(ws + WS_WO), nullptr, D_, D_, 4, t - o6};
        if (t < o8) return TileDesc{p.g2, (u16*)(ws + WS_GU2), p.n2, D_, DFF, 1, t - o7};
        if (t < o9) return TileDesc{p.u2, (u16*)(ws + WS_GU2), p.n2, D_, DFF, 2, t - o8};
        return TileDesc{p.d2, (u16*)(ws + WS_DN2), nullptr, DFF, D_, 4, t - o9};
    };
    const int NPREP = (int)gridDim.x == 256 ? 2 * T_GU : 2 * T_GU + 2 * T_GU + T_DN;
    auto pdesc = [&](int t) -> TileDesc { return t < 2 * T_GU ? desc(t) : desc(t - 2 * T_GU + o7); };
    { int t = blockIdx.x;
      if (t < NPREP) { TileDesc d = pdesc(t); TileRegs ra; tile_load(ra, d);
        for (;;) { const int tn = t + G; const bool more = tn < NPREP; TileDesc dn = d; TileRegs rb = ra;
            if (more) { dn = pdesc(tn); tile_load(rb, dn); }
            tile_store(tl, ra, d);
            if (!more) break;
            d = dn; ra = rb; t = tn; } } }
    u16* xb = (u16*)(ws + WS_AB); float* part0 = (float*)(ws + WS_P0); float* cs = (float*)(ws + WS_CS);
    f32x4 xv[4];
    { const int row0_ = blockIdx.x * 8 + wid; if (row0_ < T_) {
#pragma unroll
        for (int i = 0; i < 4; ++i) xv[i] = *(const f32x4*)(p.x + (size_t)row0_ * D_ + i * 256 + lane * 4); } }
    for (int row = blockIdx.x * 8 + wid; row < T_; row += G * 8) {
        float ss = 0.f; f32x4 cur[4];
#pragma unroll
        for (int i = 0; i < 4; ++i) cur[i] = xv[i];
        if (row + G * 8 < T_) {
#pragma unroll
            for (int i = 0; i < 4; ++i) xv[i] = *(const f32x4*)(p.x + (size_t)(row + G * 8) * D_ + i * 256 + lane * 4); }
#pragma unroll
        for (int i = 0; i < 4; ++i) { const f32x4 v = cur[i]; ss += v[0] * v[0] + v[1] * v[1] + v[2] * v[2] + v[3] * v[3];
            u32x2 b; b[0] = cvt_pk_bf16(v[0], v[1]); b[1] = cvt_pk_bf16(v[2], v[3]); *(u32x2*)(xb + (size_t)row * D_ + i * 256 + lane * 4) = b; }
#pragma unroll
        for (int o = 32; o >= 1; o >>= 1) ss += __shfl_xor(ss, o);
        if (lane < 16) part0[(size_t)row * 16 + lane] = lane == 0 ? ss : 0.f;
        if (lane >= 16 && lane < 24) {
            const int i = lane - 16;
            const float invf = i == 0 ? 1.0f : i == 1 ? 0.1939227432012558f : i == 2 ? 0.03760603070259094f : i == 3 ? 0.007292664609849453f : i == 4 ? 0.0014142135623842478f
                             : i == 5 ? 0.00027424818836152554f : i == 6 ? 5.318296098266728e-05f : 1.0313386155758053e-05f;
            const float ang = (float)p.pos[row] * invf;
            const double a = (double)ang, kk = __builtin_rint(a * 0.15915494309189535), r = a - kk * 6.283185307179586;
            const float rf = (float)r;
            cs[(size_t)row * 16 + i] = __cosf(rf); cs[(size_t)row * 16 + 8 + i] = __sinf(rf);
        }
    }
}


__device__ __forceinline__ void deferred_weights(const Params& p, LAS unsigned char* lds, int j, int nidle, int lo, int hi) {
    unsigned char* ws = p.ws; LAS float* tl = (LAS float*)lds;
    constexpr int T_GU = 16 * 44, T_DN = 44 * 16, T_IN = 16 * 80, T_BR = 8 * 16, T_WO = 16 * 16;
    constexpr int o2 = 2 * T_GU, o3 = o2 + T_DN, o4 = o3 + T_IN, o5 = o4 + T_BR, o6 = o5 + T_BR, o7 = o6 + T_WO, o8 = o7 + T_GU, o9 = o8 + T_GU;
    auto desc = [&](int t) -> TileDesc {
        if (t < o3) return TileDesc{p.d1, (u16*)(ws + WS_DN1), nullptr, DFF, D_, 4, t - o2};
        if (t < o4) return TileDesc{p.win, (u16*)(ws + WS_IN), p.nm, D_, DIN, 3, t - o3};
        if (t < o5) return TileDesc{p.wba, (u16*)(ws + WS_BA), nullptr, 512, D_, 4, t - o4};
        if (t < o6) return TileDesc{p.wbb, (u16*)(ws + WS_BB), nullptr, 512, D_, 4, t - o5};
        if (t < o7) return TileDesc{p.wo, (u16*)(ws + WS_WO), nullptr, D_, D_, 4, t - o6};
        if (t < o8) return TileDesc{p.g2, (u16*)(ws + WS_GU2), p.n2, D_, DFF, 1, t - o7};
        if (t < o9) return TileDesc{p.u2, (u16*)(ws + WS_GU2), p.n2, D_, DFF, 2, t - o8};
        return TileDesc{p.d2, (u16*)(ws + WS_DN2), nullptr, DFF, D_, 4, t - o9};
    };
    int t = lo + j;
    if (t < hi) { TileDesc d = desc(t); TileRegs ra; tile_load(ra, d);
        for (;;) { const int tn = t + nidle; const bool more = tn < hi; TileDesc dn = d; TileRegs rb = ra;
            if (more) { dn = desc(tn); tile_load(rb, dn); }
            tile_store(tl, ra, d);
            if (!more) break;
            d = dn; ra = rb; t = tn; } }
}

__device__ __forceinline__ s16x4 vtr(LAS const unsigned char* p) { typedef short v4i16_t __attribute__((ext_vector_type(4))); return __builtin_bit_cast(s16x4, __builtin_amdgcn_ds_read_tr16_b64_v4i16((LAS v4i16_t*)p)); }

__device__ __forceinline__ void pv_tile(f32x4 (&o)[4], LAS const unsigned char* vs, const bf16x8 (&pf)[2], int lane) {
    const int li = lane & 15, g = lane >> 4, q_ = li >> 2, pp = li & 3;
    LAS const unsigned char* b0 = vs + (4 * g + q_) * 144 + pp * 8;
#pragma unroll
    for (int ks = 0; ks < 2; ++ks) {
        bf16x8 va[4];
#pragma unroll
        for (int dt = 0; dt < 4; ++dt) { s16x4 lo = vtr(b0 + (32 * ks) * 144 + dt * 32), hi = vtr(b0 + (32 * ks + 16) * 144 + dt * 32);
            va[dt] = (bf16x8){lo[0], lo[1], lo[2], lo[3], hi[0], hi[1], hi[2], hi[3]}; }
        __builtin_amdgcn_s_setprio(1);
#pragma unroll
        for (int dt = 0; dt < 4; ++dt) o[dt] = __builtin_amdgcn_mfma_f32_16x16x32_bf16(va[dt], pf[ks], o[dt], 0, 0, 0);
        __builtin_amdgcn_s_setprio(0);
    }
}
__device__ __forceinline__ void pack_p(bf16x8 (&pf)[2], const float (&w)[4][4]) {
#pragma unroll
    for (int ks = 0; ks < 2; ++ks) { u32x4 t; t[0] = cvt_pk_bf16(w[2 * ks][0], w[2 * ks][1]); t[1] = cvt_pk_bf16(w[2 * ks][2], w[2 * ks][3]);
        t[2] = cvt_pk_bf16(w[2 * ks + 1][0], w[2 * ks + 1][1]); t[3] = cvt_pk_bf16(w[2 * ks + 1][2], w[2 * ks + 1][3]); pf[ks] = __builtin_bit_cast(bf16x8, t); }
}
__device__ __forceinline__ void load_qf(bf16x8 (&qf)[2], const u16* qrow, int lane) { const int g = lane >> 4; qf[0] = *(const bf16x8*)(qrow + 8 * g); qf[1] = *(const bf16x8*)(qrow + 32 + 8 * g); }

__device__ __forceinline__ int list_off(int n) { return 256 * (63 * n - (n * (n - 1)) / 2); }

struct Top3 { float v1, v2, v3; int i1, i2, i3; };
__device__ __forceinline__ void top3_insert(Top3& t, float v, int i) {
    const bool b1 = v > t.v1 || (v == t.v1 && i < t.i1), b2 = v > t.v2 || (v == t.v2 && i < t.i2), b3 = v > t.v3 || (v == t.v3 && i < t.i3);
    if (b1) { t.v3 = t.v2; t.i3 = t.i2; t.v2 = t.v1; t.i2 = t.i1; t.v1 = v; t.i1 = i; }
    else if (b2) { t.v3 = t.v2; t.i3 = t.i2; t.v2 = v; t.i2 = i; }
    else if (b3) { t.v3 = v; t.i3 = i; }
}
__device__ __forceinline__ void topk_item(const Params& p, int item, int lane) {
    const u16* qkva = (const u16*)(p.ws + WS_QKVA); const float* km = (const float*)(p.ws + WS_KMEAN);
    int* cnt = (int*)(p.ws + WS_CNT); u16* list = (u16*)(p.ws + WS_LIST);
    const int h = item & 7, qc = item >> 3, q0 = qc * 64, own = qc >> 2, r = lane & 15, g = lane >> 4;
    if (own == 0) return;
    Top3 tp[4];
#pragma unroll
    for (int qt = 0; qt < 4; ++qt) { tp[qt].v1 = tp[qt].v2 = tp[qt].v3 = -INFINITY; tp[qt].i1 = 0; tp[qt].i2 = 1; tp[qt].i3 = 2; }
    if (own > 3) {
#pragma unroll
        for (int qt = 0; qt < 4; ++qt) { tp[qt].i1 = 1000; tp[qt].i2 = 1001; tp[qt].i3 = 1002; }
        bf16x8 qfr[4][2];
#pragma unroll
        for (int qt = 0; qt < 4; ++qt) load_qf(qfr[qt], qkva + (size_t)(q0 + 16 * qt + r) * LDA_ + h * 64, lane);
        const int ntile = (own + 15) >> 4;
        for (int nt = 0; nt < ntile; ++nt) {
            const int nrow = 16 * nt + r; const bool nv = nrow < own;
            bf16x8 ahi[2], alo[2];
#pragma unroll
            for (int ks = 0; ks < 2; ++ks) { const float* kp = km + (size_t)(nv ? nrow : 0) * 512 + h * 64 + 32 * ks + 8 * g;
                f32x4 a = *(const f32x4*)kp, b = *(const f32x4*)(kp + 4);
                u32x4 hi; hi[0] = cvt_pk_bf16(a[0], a[1]); hi[1] = cvt_pk_bf16(a[2], a[3]); hi[2] = cvt_pk_bf16(b[0], b[1]); hi[3] = cvt_pk_bf16(b[2], b[3]);
                f32x4 ra = {a[0] - bflo(hi[0]), a[1] - bfhi(hi[0]), a[2] - bflo(hi[1]), a[3] - bfhi(hi[1])}, rb = {b[0] - bflo(hi[2]), b[1] - bfhi(hi[2]), b[2] - bflo(hi[3]), b[3] - bfhi(hi[3])};
                u32x4 lo; lo[0] = cvt_pk_bf16(ra[0], ra[1]); lo[1] = cvt_pk_bf16(ra[2], ra[3]); lo[2] = cvt_pk_bf16(rb[0], rb[1]); lo[3] = cvt_pk_bf16(rb[2], rb[3]);
                ahi[ks] = __builtin_bit_cast(bf16x8, hi); alo[ks] = __builtin_bit_cast(bf16x8, lo); }
#pragma unroll
            for (int qt = 0; qt < 4; ++qt) { f32x4 acc = {0.f, 0.f, 0.f, 0.f};
#pragma unroll
                for (int ks = 0; ks < 2; ++ks) { acc = __builtin_amdgcn_mfma_f32_16x16x32_bf16(ahi[ks], qfr[qt][ks], acc, 0, 0, 0); acc = __builtin_amdgcn_mfma_f32_16x16x32_bf16(alo[ks], qfr[qt][ks], acc, 0, 0, 0); }
#pragma unroll
                for (int j = 0; j < 4; ++j) { const int n = 16 * nt + 4 * g + j; if (n < own) top3_insert(tp[qt], acc[j], n); } }
        }
#pragma unroll
        for (int step = 16; step <= 32; step <<= 1)
#pragma unroll
            for (int qt = 0; qt < 4; ++qt) { const float pv1 = __shfl_xor(tp[qt].v1, step), pv2 = __shfl_xor(tp[qt].v2, step), pv3 = __shfl_xor(tp[qt].v3, step);
                const int pi1 = __shfl_xor(tp[qt].i1, step), pi2 = __shfl_xor(tp[qt].i2, step), pi3 = __shfl_xor(tp[qt].i3, step);
                if (pi1 < 1000) top3_insert(tp[qt], pv1, pi1); if (pi2 < 1000) top3_insert(tp[qt], pv2, pi2); if (pi3 < 1000) top3_insert(tp[qt], pv3, pi3); }
    }
    const int nsel = own < 3 ? own : 3;
    if (g == 0) {
#pragma unroll
        for (int qt = 0; qt < 4; ++qt) { const int q = q0 + 16 * qt + r;
            for (int s2 = 0; s2 < nsel; ++s2) { const int n = s2 == 0 ? tp[qt].i1 : s2 == 1 ? tp[qt].i2 : tp[qt].i3;
                const int pos = atomicAdd(cnt + h * 64 + n, 1);
                list[(size_t)h * LISTH + list_off(n) + pos] = (u16)(q | (s2 << 14)); } }
    }
}

struct CoopKV { u32x4 k, v; };
#define KB_OFF(b) ((b) * 18432)
#define VB_OFF(b) ((b) * 18432 + 9216)
__device__ __forceinline__ void coop_load(CoopKV& c, const u16* kbase, int tid) { const u16* p = kbase + (size_t)(tid >> 3) * LDA_ + 8 * (tid & 7); c.k = *(const u32x4*)p; c.v = *(const u32x4*)(p + 512); }
__device__ __forceinline__ void qk_lds(f32x4 (&acc)[4], LAS const unsigned char* kb, const bf16x8 (&qf)[2], int lane) {
    const int r = lane & 15, g = lane >> 4;
    bf16x8 k0[4], k1[4];
#pragma unroll
    for (int kt = 0; kt < 4; ++kt) { LAS const unsigned char* kp = kb + (16 * kt + r) * 144 + 16 * g; k0[kt] = *(LAS const bf16x8*)kp; k1[kt] = *(LAS const bf16x8*)(kp + 64); }
    __builtin_amdgcn_s_setprio(1);
#pragma unroll
    for (int kt = 0; kt < 4; ++kt) { f32x4 z = {0.f, 0.f, 0.f, 0.f}; acc[kt] = __builtin_amdgcn_mfma_f32_16x16x32_bf16(k0[kt], qf[0], z, 0, 0, 0); }
#pragma unroll
    for (int kt = 0; kt < 4; ++kt) acc[kt] = __builtin_amdgcn_mfma_f32_16x16x32_bf16(k1[kt], qf[1], acc[kt], 0, 0, 0);
    __builtin_amdgcn_s_setprio(0);
}
template <bool CAUSAL>
__device__ __forceinline__ void sm_tile_l(LAS const unsigned char* kb, LAS const unsigned char* vb, int key0, int t, const bf16x8 (&qf)[2], float& m, float& l, f32x4 (&o)[4], int lane) {
    const int g = lane >> 4;
    f32x4 acc[4]; qk_lds(acc, kb, qf, lane);
    float s[4][4]; float lm = -INFINITY;
#pragma unroll
    for (int kt = 0; kt < 4; ++kt)
#pragma unroll
        for (int j = 0; j < 4; ++j) { float v = acc[kt][j]; if (CAUSAL && (key0 + 16 * kt + 4 * g + j) > t) v = -INFINITY; s[kt][j] = v; lm = fmaxf(lm, v); }
    lm = fmaxf(lm, __shfl_xor(lm, 16)); lm = fmaxf(lm, __shfl_xor(lm, 32));
    const float mn = fmaxf(m, lm), al = fexp2(m - mn);
    float sum = 0.f;
#pragma unroll
    for (int kt = 0; kt < 4; ++kt)
#pragma unroll
        for (int j = 0; j < 4; ++j) { s[kt][j] = fexp2(s[kt][j] - mn); sum += s[kt][j]; }
    l = l * al + sum; m = mn;
#pragma unroll
    for (int dt = 0; dt < 4; ++dt) o[dt] *= al;
    bf16x8 pf[2]; pack_p(pf, s);
    pv_tile(o, vb, pf, lane);
}

__device__ __forceinline__ void sel_block_stream(const Params& p, LAS unsigned char* lds, LAS const int* sched, int total, int tid, int wid, int lane) {
    const u16* qkva = (const u16*)(p.ws + WS_QKVA); const u16* list = (const u16*)(p.ws + WS_LIST);
    u16* po = (u16*)(p.ws + WS_PO); float* pml = (float*)(p.ws + WS_PML);
    const int r = lane & 15, g = lane >> 4, G = gridDim.x;
    int i = (G & 7) == 0 ? (int)(blockIdx.x & 7) * (G >> 3) + (int)(blockIdx.x >> 3) : (int)blockIdx.x; if (i >= total) return;
#define SELB_DECODE(kk_, H, N, E, OK, ACT) do { const int hn_ = __builtin_amdgcn_readfirstlane(sched[(kk_) * 4]), grp_ = __builtin_amdgcn_readfirstlane(sched[(kk_) * 4 + 1]), c_ = __builtin_amdgcn_readfirstlane(sched[(kk_) * 4 + 2]); \
        H = hn_ >> 6; N = hn_ & 63; const int e0_ = grp_ * 128 + wid * 16; ACT = e0_ < c_; int ei_ = e0_ + r; OK = ei_ < c_; if (!OK) ei_ = ACT ? e0_ : 0; \
        E = list[(size_t)H * LISTH + list_off(N) + ei_]; } while (0)
    int kq = 0; int h, n; unsigned e; bool ok, act; SELB_DECODE(kq, h, n, e, ok, act);
    bf16x8 qf[2]; load_qf(qf, qkva + (size_t)(e & 0x3FFF) * LDA_ + h * 64, lane);
#define KBIG(b_) ((b_) * 73728)
#define VBIG(b_) ((b_) * 73728 + 36864)
    CoopKV cN[4];
    { const u16* kb0 = qkva + (size_t)(n * 256) * LDA_ + 512 + h * 64;
#pragma unroll
      for (int t4 = 0; t4 < 4; ++t4) coop_load(cN[t4], kb0 + (size_t)t4 * 64 * LDA_, tid);
      const int o_ = (tid >> 3) * 144 + (tid & 7) * 16;
#pragma unroll
      for (int t4 = 0; t4 < 4; ++t4) { *(LAS u32x4*)(lds + KBIG(0) + t4 * 9216 + o_) = cN[t4].k; *(LAS u32x4*)(lds + VBIG(0) + t4 * 9216 + o_) = cN[t4].v; } }
    __syncthreads();
    int buf = 0;
    for (;;) {
        const int i2 = i + G; const bool has_next = i2 < total;
        int h2 = 0, n2 = 0; unsigned e2 = 0; bool ok2 = false, act2 = false;
        if (has_next) { SELB_DECODE(kq + 1, h2, n2, e2, ok2, act2);
            const u16* kb2 = qkva + (size_t)(n2 * 256) * LDA_ + 512 + h2 * 64;
#pragma unroll
            for (int t4 = 0; t4 < 4; ++t4) coop_load(cN[t4], kb2 + (size_t)t4 * 64 * LDA_, tid); }
        f32x4 o[4];
#pragma unroll
        for (int q_ = 0; q_ < 4; ++q_) o[q_] = (f32x4){0.f, 0.f, 0.f, 0.f};
        float m = -INFINITY, l = 0.f; bf16x8 qn[2] = {qf[0], qf[1]};
        if (has_next) load_qf(qn, qkva + (size_t)(e2 & 0x3FFF) * LDA_ + h2 * 64, lane);
        if (act) {
#pragma unroll 1
            for (int tile = 0; tile < 4; ++tile) sm_tile_l<false>(lds + KBIG(buf) + tile * 9216, lds + VBIG(buf) + tile * 9216, 0, 0, qf, m, l, o, lane);
            l += __shfl_xor(l, 16); l += __shfl_xor(l, 32);
            const float inv = frcp(l);
            if (ok) { const size_t sidx = ((size_t)(e & 0x3FFF) * NH + h) * 3 + (e >> 14);
#pragma unroll
                for (int dt = 0; dt < 4; ++dt) { u32x2 b; b[0] = cvt_pk_bf16(o[dt][0] * inv, o[dt][1] * inv); b[1] = cvt_pk_bf16(o[dt][2] * inv, o[dt][3] * inv);
                    *(u32x2*)(po + sidx * 64 + 16 * dt + 4 * g) = b; }
                if (g == 0) { pml[sidx * 2] = m; pml[sidx * 2 + 1] = l; } } }
        if (!has_next) break;
        { const int o_ = (tid >> 3) * 144 + (tid & 7) * 16;
#pragma unroll
          for (int t4 = 0; t4 < 4; ++t4) { *(LAS u32x4*)(lds + KBIG(buf ^ 1) + t4 * 9216 + o_) = cN[t4].k; *(LAS u32x4*)(lds + VBIG(buf ^ 1) + t4 * 9216 + o_) = cN[t4].v; } }
        __syncthreads(); buf ^= 1;
        i = i2; ++kq; h = h2; n = n2; e = e2; ok = ok2; act = act2; qf[0] = qn[0]; qf[1] = qn[1];
    }
#undef KBIG
#undef VBIG
#undef SELB_DECODE
}

__device__ __forceinline__ void own_block_stream(const Params& p, LAS unsigned char* lds, int tid, int wid, int lane) {
    const u16* qkva = (const u16*)(p.ws + WS_QKVA); const u16* po = (const u16*)(p.ws + WS_PO); const float* pml = (const float*)(p.ws + WS_PML);
    u16* ya = (u16*)(p.ws + WS_AB);
    const int r = lane & 15, g = lane >> 4, G = gridDim.x, total = (T_ / 128) * NH;
    int i = (G & 7) == 0 ? (int)(blockIdx.x & 7) * (G >> 3) + (int)(blockIdx.x >> 3) : (int)blockIdx.x, kk = 0; if (i >= total) return;
#define OWN_DEC(ii, k_, C, H) do { C = ((ii) >> 3) ^ ((k_) & 1); H = (ii) & 7; } while (0)
    int cch, h; OWN_DEC(i, kk, cch, h);
    bf16x8 qf[2]; load_qf(qf, qkva + (size_t)(cch * 128 + wid * 16 + r) * LDA_ + h * 64, lane);
#define KBIG(b_) ((b_) * 73728)
#define VBIG(b_) ((b_) * 73728 + 36864)
    CoopKV cN[4]; const int o_ = (tid >> 3) * 144 + (tid & 7) * 16;
    { const u16* kb0 = qkva + (size_t)((cch >> 1) * 256) * LDA_ + 512 + h * 64; const int nt0 = (cch & 1) ? 4 : 2;
#pragma unroll
      for (int t4 = 0; t4 < 4; ++t4) if (t4 < nt0) coop_load(cN[t4], kb0 + (size_t)t4 * 64 * LDA_, tid);
#pragma unroll
      for (int t4 = 0; t4 < 4; ++t4) if (t4 < nt0) { *(LAS u32x4*)(lds + KBIG(0) + t4 * 9216 + o_) = cN[t4].k; *(LAS u32x4*)(lds + VBIG(0) + t4 * 9216 + o_) = cN[t4].v; } }
    __syncthreads();
    int buf = 0;
    for (;;) {
        const int i2 = i + G; const bool has_next = i2 < total; int c2 = 0, h2 = 0; OWN_DEC(i2, kk + 1, c2, h2);
        const int own = cch >> 1, q0 = cch * 128 + wid * 16, t = q0 + r, wmax = ((cch & 1) * 128 + wid * 16 + 15) >> 6;
        const int nt2 = (c2 & 1) ? 4 : 2;
        f32x4 o[4];
#pragma unroll
        for (int q_ = 0; q_ < 4; ++q_) o[q_] = (f32x4){0.f, 0.f, 0.f, 0.f};
        float m = -INFINITY, l = 0.f; bf16x8 qn[2] = {qf[0], qf[1]};
        if (has_next) { const u16* kb2 = qkva + (size_t)((c2 >> 1) * 256) * LDA_ + 512 + h2 * 64;
#pragma unroll
            for (int t4 = 0; t4 < 4; ++t4) if (t4 < nt2) coop_load(cN[t4], kb2 + (size_t)t4 * 64 * LDA_, tid);
            load_qf(qn, qkva + (size_t)(c2 * 128 + wid * 16 + r) * LDA_ + h2 * 64, lane); }
        const int nsel = own < 3 ? own : 3;
        const size_t sidx = ((size_t)t * NH + h) * 3;
        float ms[3], lsv[3]; u32x2 pw[3][4];
#pragma unroll
        for (int s2 = 0; s2 < 3; ++s2) { ms[s2] = -INFINITY; lsv[s2] = 0.f;
#pragma unroll
            for (int dt = 0; dt < 4; ++dt) pw[s2][dt] = (u32x2){0u, 0u};
            if (s2 < nsel) { ms[s2] = pml[(sidx + s2) * 2]; lsv[s2] = pml[(sidx + s2) * 2 + 1];
#pragma unroll
                for (int dt = 0; dt < 4; ++dt) pw[s2][dt] = *(const u32x2*)(po + (sidx + s2) * 64 + 16 * dt + 4 * g); } }
#pragma unroll 1
        for (int tile = 0; tile <= wmax; ++tile) sm_tile_l<true>(lds + KBIG(buf) + tile * 9216, lds + VBIG(buf) + tile * 9216, own * 256 + tile * 64, t, qf, m, l, o, lane);
        l += __shfl_xor(l, 16); l += __shfl_xor(l, 32);
        float M = m;
#pragma unroll
        for (int s2 = 0; s2 < 3; ++s2) M = fmaxf(M, ms[s2]);
        const float a0 = fexp2(m - M); float den = l * a0;
#pragma unroll
        for (int dt = 0; dt < 4; ++dt) o[dt] *= a0;
#pragma unroll
        for (int s2 = 0; s2 < 3; ++s2) { const float a = lsv[s2] * fexp2(ms[s2] - M); den += a;
#pragma unroll
            for (int dt = 0; dt < 4; ++dt) { const u32x2 w = pw[s2][dt];
                o[dt][0] += a * bflo(w[0]); o[dt][1] += a * bfhi(w[0]); o[dt][2] += a * bflo(w[1]); o[dt][3] += a * bfhi(w[1]); } }
        const float inv = frcp(den);
#pragma unroll
        for (int dt = 0; dt < 4; ++dt) { u32x2 b; b[0] = cvt_pk_bf16(o[dt][0] * inv, o[dt][1] * inv); b[1] = cvt_pk_bf16(o[dt][2] * inv, o[dt][3] * inv);
            *(u32x2*)(ya + (size_t)t * 512 + h * 64 + 16 * dt + 4 * g) = b; }
        if (!has_next) break;
#pragma unroll
        for (int t4 = 0; t4 < 4; ++t4) if (t4 < nt2) { *(LAS u32x4*)(lds + KBIG(buf ^ 1) + t4 * 9216 + o_) = cN[t4].k; *(LAS u32x4*)(lds + VBIG(buf ^ 1) + t4 * 9216 + o_) = cN[t4].v; }
        __syncthreads(); buf ^= 1;
        i = i2; ++kk; cch = c2; h = h2; qf[0] = qn[0]; qf[1] = qn[1];
    }
#undef KBIG
#undef VBIG
#undef OWN_DEC
}

__device__ __forceinline__ void sb_tile_l(LAS const unsigned char* kb, LAS const unsigned char* vb, int key0, int t, const bf16x8 (&qf)[2], float& R, f32x4 (&o)[4], int lane) {
    const int g = lane >> 4;
    f32x4 acc[4]; qk_lds(acc, kb, qf, lane);
    float lf[4][4], Tk[4], ex[4];
#pragma unroll
    for (int kt = 0; kt < 4; ++kt) { float c = 0.f;
#pragma unroll
        for (int j = 0; j < 4; ++j) { const bool valid = (key0 + 16 * kt + 4 * g + j) < t; const float z = acc[kt][j];
            const float sp = fmaxf(z, 0.f) + __logf(1.0f + __expf(-fabsf(z)));
            acc[kt][j] = z; lf[kt][j] = valid ? -sp : 0.f; c += lf[kt][j]; }
        const float b = __shfl_xor(c, 16), s2 = c + b, d = __shfl_xor(s2, 32);
        Tk[kt] = s2 + d; ex[kt] = ((g & 1) ? 0.f : b) + ((g & 2) ? 0.f : d); }
    float w[4][4]; float run = R;
#pragma unroll
    for (int kt = 3; kt >= 0; --kt) { const float E = run + ex[kt]; float suf = 0.f;
#pragma unroll
        for (int j = 3; j >= 0; --j) { const bool valid = (key0 + 16 * kt + 4 * g + j) < t; w[kt][j] = valid ? __expf(acc[kt][j] + lf[kt][j] + E + suf) : 0.f; suf += lf[kt][j]; }
        run += Tk[kt]; }
    R = run;
    bf16x8 pf[2]; pack_p(pf, w);
    pv_tile(o, vb, pf, lane);
}

__device__ __forceinline__ void sb_block_stream(const Params& p, LAS unsigned char* lds, int tid, int wid, int lane) {
    const u16* qkvb = (const u16*)(p.ws + WS_QKVB); u16* yb = (u16*)(p.ws + WS_AB) + (size_t)T_ * 512;
    const int r = lane & 15, g = lane >> 4, G = gridDim.x, total = (T_ / 128) * NH;
    int i = (G & 7) == 0 ? (int)(blockIdx.x & 7) * (G >> 3) + (int)(blockIdx.x >> 3) : (int)blockIdx.x; if (i >= total) return;
    int cch = i >> 3, h = i & 7;
    bf16x8 qf[2]; load_qf(qf, qkvb + (size_t)(cch * 128 + wid * 16 + r) * LDA_ + h * 64, lane);
#define KBIG(b_) ((b_) * 73728)
#define VBIG(b_) ((b_) * 73728 + 36864)
    CoopKV cN[3]; const int o_ = (tid >> 3) * 144 + (tid & 7) * 16;
    { const int ns0 = cch == 0 ? 2 : 3;
#pragma unroll
      for (int s4 = 0; s4 < 3; ++s4) if (s4 < ns0) coop_load(cN[s4], qkvb + (size_t)((2 * cch + 1 - s4) * 64) * LDA_ + 512 + h * 64, tid);
#pragma unroll
      for (int s4 = 0; s4 < 3; ++s4) if (s4 < ns0) { *(LAS u32x4*)(lds + KBIG(0) + s4 * 9216 + o_) = cN[s4].k; *(LAS u32x4*)(lds + VBIG(0) + s4 * 9216 + o_) = cN[s4].v; } }
    __syncthreads();
    int buf = 0;
    for (;;) {
        const int i2 = i + G; const bool has_next = i2 < total; const int c2 = i2 >> 3, h2 = i2 & 7;
        const int q0 = cch * 128 + wid * 16, t = q0 + r, dw = 2 * cch + (wid >> 2);
        const int nstep = cch == 0 ? 2 : 3, ns2 = c2 == 0 ? 2 : 3;
        const u16* kb = qkvb + 512 + h * 64;
        f32x4 o[4];
#pragma unroll
        for (int q_ = 0; q_ < 4; ++q_) o[q_] = (f32x4){0.f, 0.f, 0.f, 0.f};
        float R = 0.f; bool done = false; bf16x8 qn[2] = {qf[0], qf[1]};
        if (has_next) {
#pragma unroll
            for (int s4 = 0; s4 < 3; ++s4) if (s4 < ns2) coop_load(cN[s4], qkvb + (size_t)((2 * c2 + 1 - s4) * 64) * LDA_ + 512 + h2 * 64, tid);
            load_qf(qn, qkvb + (size_t)(c2 * 128 + wid * 16 + r) * LDA_ + h2 * 64, lane); }
        int tile = 2 * cch + 1;
#pragma unroll 1
        for (int s4 = 0; s4 < nstep; ++s4, --tile)
            if (tile <= dw && !done) { sb_tile_l(lds + KBIG(buf) + s4 * 9216, lds + VBIG(buf) + s4 * 9216, tile * 64, t, qf, R, o, lane);
                done = (tile == 0) || (__builtin_amdgcn_ballot_w64(R > -40.f) == 0ull); }
        if (has_next) {
#pragma unroll
            for (int s4 = 0; s4 < 3; ++s4) if (s4 < ns2) { *(LAS u32x4*)(lds + KBIG(buf ^ 1) + s4 * 9216 + o_) = cN[s4].k; *(LAS u32x4*)(lds + VBIG(buf ^ 1) + s4 * 9216 + o_) = cN[s4].v; } }
        int any = __syncthreads_or(done ? 0 : 1);
        while (any && tile >= 0) {
            CoopKV c3; coop_load(c3, kb + (size_t)(tile * 64) * LDA_, tid);
            *(LAS u32x4*)(lds + KBIG(buf) + o_) = c3.k; *(LAS u32x4*)(lds + VBIG(buf) + o_) = c3.v; __syncthreads();
            if (!done) { sb_tile_l(lds + KBIG(buf), lds + VBIG(buf), tile * 64, t, qf, R, o, lane);
                done = (tile == 0) || (__builtin_amdgcn_ballot_w64(R > -40.f) == 0ull); }
            any = __syncthreads_or(done ? 0 : 1); --tile;
        }
#pragma unroll
        for (int dt = 0; dt < 4; ++dt) { u32x2 b; b[0] = cvt_pk_bf16(o[dt][0], o[dt][1]); b[1] = cvt_pk_bf16(o[dt][2], o[dt][3]);
            *(u32x2*)(yb + (size_t)t * 512 + h * 64 + 16 * dt + 4 * g) = b; }
        if (!has_next) break;
        buf ^= 1;
        i = i2; cch = c2; h = h2; qf[0] = qn[0]; qf[1] = qn[1];
    }
#undef KBIG
#undef VBIG
}

#define XB_TMO      128
#define XB_XCNT(j)  (256  + 64 * (j))
#define XB_XSUB(j)  (1280 + 64 * (j))
#define XB_XGEN(j)  (2304 + 64 * (j))
#define XB_TOP      3328
#define XB_TOPGEN   3392
#define XCD_BAR_WORDS 3456
#define XB_SPIN_CAP (1u << 22)
__device__ __forceinline__ unsigned xb_ld(unsigned* p)              { return __hip_atomic_load(p, __ATOMIC_RELAXED, __HIP_MEMORY_SCOPE_AGENT); }
__device__ __forceinline__ unsigned xb_add(unsigned* p, unsigned v) { return __hip_atomic_fetch_add(p, v, __ATOMIC_RELAXED, __HIP_MEMORY_SCOPE_AGENT); }
__device__ __forceinline__ unsigned xb_xcc_id() { return (unsigned)__builtin_amdgcn_s_getreg((3 << 11) | 20) & 0xFu; }
#define XB_SPIN(cond, bar) do { unsigned _sp = 0; while (cond) { __builtin_amdgcn_s_sleep(1); \
    if ((++_sp & 255u) == 0u) { if (xb_ld(&(bar)[XB_TMO])) break; if (_sp > XB_SPIN_CAP) { atomicAdd(&(bar)[XB_TMO], 1u); break; } } } } while (0)
struct XcdBarrier { unsigned* bar; unsigned x; volatile LAS unsigned* st; };
__device__ __forceinline__ XcdBarrier xcd_barrier_post(unsigned* bar, volatile LAS unsigned* st) {
    XcdBarrier b; b.bar = bar; b.x = xb_xcc_id(); b.st = st;
    if (threadIdx.x == 0) (void)xb_add(&bar[XB_XCNT(b.x)], 1u);
    return b;
}
__device__ __forceinline__ void xcd_barrier_complete(unsigned* bar, unsigned x, unsigned& nloc, unsigned& nx) {
    const unsigned G = gridDim.x * gridDim.y * gridDim.z;
    unsigned sum, cnt, mine, sp = 0u;
    for (;;) {
        sum = 0u; cnt = 0u; mine = 0u;
#pragma unroll
        for (unsigned j = 0; j < 16; ++j) { const unsigned c = xb_ld(&bar[XB_XCNT(j)]); sum += c; cnt += (c > 0u) ? 1u : 0u; mine = (j == x) ? c : mine; }
        if (sum == G) break;
        __builtin_amdgcn_s_sleep(1);
        if ((++sp & 255u) == 0u) { if (xb_ld(&bar[XB_TMO])) break; if (sp > XB_SPIN_CAP) { atomicAdd(&bar[XB_TMO], 1u); break; } }
    }
    nloc = mine > 0u ? mine : 1u; nx = cnt > 0u ? cnt : 1u;
}
__device__ __forceinline__ void xcd_barrier_arrive(const XcdBarrier& b) {
    asm volatile("s_waitcnt vmcnt(0)" ::: "memory");
    __syncthreads();
    if (threadIdx.x == 0) {
        unsigned* bar = b.bar;
        __builtin_amdgcn_s_waitcnt(0);
        unsigned nloc = b.st[0], nx = b.st[1];
        if (nloc == 0u) { xcd_barrier_complete(bar, b.x, nloc, nx); b.st[0] = nloc; b.st[1] = nx; }
        const unsigned old = xb_add(&bar[XB_XSUB(b.x)], 1u);
        const unsigned gen = old / nloc;
        if (old + 1u == (gen + 1u) * nloc) {
            __builtin_amdgcn_fence(__ATOMIC_RELEASE, "agent");
            asm volatile("s_waitcnt vmcnt(0)" ::: "memory");
            const unsigned og = xb_add(&bar[XB_TOP], 1u);
            const unsigned tg = og / nx;
            if (og + 1u == (tg + 1u) * nx) xb_add(&bar[XB_TOPGEN], 1u);
        }
    }
}
__device__ __forceinline__ void xcd_barrier_wait(const XcdBarrier& b) {
    if (threadIdx.x == 0) {
        unsigned* bar = b.bar;
        const unsigned tgen = b.st[2]; b.st[2] = tgen + 1u;
        XB_SPIN(xb_ld(&bar[XB_TOPGEN]) <= tgen, bar);
        __builtin_amdgcn_fence(__ATOMIC_ACQUIRE, "agent");
        asm volatile("s_waitcnt vmcnt(0)" ::: "memory");
    }
    __syncthreads();
}
__device__ __forceinline__ void xcd_barrier(const XcdBarrier& b) { xcd_barrier_arrive(b); xcd_barrier_wait(b); }

#define PH_PROLOG int tid_ = threadIdx.x; asm volatile("" : "+v"(tid_)); const int tid = tid_, lane = tid & 63, wid = __builtin_amdgcn_readfirstlane(tid >> 6); \
    const int G = gridDim.x, W = blockIdx.x * 8 + wid, NW = G * 8; LAS unsigned char* vs = lds + wid * 9216; (void)vs; (void)W; (void)NW; (void)lane; (void)G;
#ifndef REP_MASK
#define REP_MASK 0
#endif
#ifndef REPN
#define REPN 2
#endif
#ifndef EXTRA_SYNCS
#define EXTRA_SYNCS 0
#endif
#define PHASE(N, ...) if constexpr ((PH_MASK >> N) & 1) { if (p.ph_lo <= N && N < p.ph_hi) { \
    for (int rep_ = 0; rep_ < (((REP_MASK >> N) & 1) ? REPN : 1); ++rep_) { if (rep_) xcd_barrier(xb); { PH_PROLOG __VA_ARGS__ } } } } if (p.ph_lo <= N && N + 1 < p.ph_hi) xcd_barrier(xb);
#define PHASE_S(N, SLOT, ...) if constexpr ((PH_MASK >> N) & 1) { if (p.ph_lo <= N && N < p.ph_hi) { { PH_PROLOG __VA_ARGS__ } } } \
    if (p.ph_lo <= N && N + 1 < p.ph_hi) { xcd_barrier_arrive(xb); \
        { constexpr int lo_ = 2 * 16 * 44 + 44 * 16 + 16 * 80 + 2 * 8 * 16 + 16 * 16 + (SLOT) * 512, end_ = 2 * 16 * 44 + 44 * 16 + 16 * 80 + 2 * 8 * 16 + 16 * 16 + 2 * 16 * 44 + 44 * 16; \
          if ((int)gridDim.x == 256) deferred_weights(p, lds, (int)blockIdx.x, 256, lo_, (lo_ + 512 < end_ ? lo_ + 512 : end_)); } \
        xcd_barrier_wait(xb); }

__global__ void __launch_bounds__(512) fwd_megakernel(Params p) {
    extern __shared__ __attribute__((aligned(16))) unsigned char shm_raw[];
    LAS unsigned char* lds = (LAS unsigned char*)shm_raw;
    cg::grid_group grid = cg::this_grid();
    unsigned char* ws = p.ws;
    volatile LAS unsigned* xst = (volatile LAS unsigned*)(lds + XST_OFF);
    if (threadIdx.x == 0) { xst[0] = 0u; xst[1] = 0u; xst[2] = 0u; }
    __syncthreads();
    XcdBarrier xb = xcd_barrier_post((unsigned*)(ws + WS_BAR), xst);
    if (p.use_cg) grid.sync();

    for (int es_ = 0; es_ < EXTRA_SYNCS; ++es_) xcd_barrier(xb);
    PHASE(0, prep_phase(p, lds);)
    PHASE(1, pg8::StaticOrder S; S.init(T_, 2 * DFF, G, blockIdx.x); pg8::Gemm g{(const u16*)(ws + WS_AB), (const u16*)(ws + WS_GU1), T_, 2 * DFF, D_};
             build_rtab(lds, S, (const float*)(ws + WS_P0)); EpiSwiglu E{(u16*)(ws + WS_ACT), lds}; pg8::gemm_phase(lds, g, S, E);
             { const int nfull = (T_ / 256) * (2 * DFF / 256) - 5 * G;
               constexpr int lo_ = 2 * 16 * 44, hi_ = lo_ + 44 * 16 + 16 * 80 + 2 * 8 * 16 + 16 * 16;
               if (nfull >= 0 && nfull < G) { if ((int)blockIdx.x >= nfull) deferred_weights(p, lds, (int)blockIdx.x - nfull, G - nfull, lo_, hi_); }
               else deferred_weights(p, lds, (int)blockIdx.x, G, lo_, hi_); })
    PHASE_S(2, 0, pg8::StaticOrder S; S.init(T_, D_, G, blockIdx.x); pg8::Gemm g{(const u16*)(ws + WS_ACT), (const u16*)(ws + WS_DN1), T_, D_, DFF};
             EpiResid<false> E{(const u16*)(ws + WS_AB), nullptr, (u16*)p.out, (float*)(ws + WS_P1), 0.5f}; pg8::gemm_phase(lds, g, S, E);)
    PHASE_S(3, 1, pg8::StaticOrder S; S.init(T_, DIN, G, blockIdx.x); pg8::Gemm g{(const u16*)p.out, (const u16*)(ws + WS_IN), T_, DIN, D_};
             build_rtab(lds, S, (const float*)(ws + WS_P1)); EpiWin E{(u16*)(ws + WS_QKVA), (u16*)(ws + WS_QKVB), (u16*)(ws + WS_GATES), lds, (const float*)(ws + WS_CS), p.bg, (float*)(ws + WS_KMEAN)}; pg8::gemm_phase(lds, g, S, E);)
    PHASE_S(4, 2, for (int i = W; i < (T_ / 64) * NH; i += NW) topk_item(p, i, lane);
             __syncthreads(); sb_block_stream(p, lds, tid, wid, lane); __syncthreads();)
    PHASE_S(6, 3, LAS int* pref = (LAS int*)(lds + 96 * 1024); const int* cnt = (const int*)(ws + WS_CNT);
             __syncthreads();
             pref[tid] = (cnt[tid] + 127) >> 7; __syncthreads();
             for (int o = 1; o < 512; o <<= 1) { const int v = tid >= o ? pref[tid - o] : 0; __syncthreads(); pref[tid] += v; __syncthreads(); }
             const int total = pref[511];
             LAS int* sched = (LAS int*)(lds + 148 * 1024);
             { const int slot0 = (G & 7) == 0 ? (int)(blockIdx.x & 7) * (G >> 3) + (int)(blockIdx.x >> 3) : (int)blockIdx.x; const int ii = slot0 + tid * G;
               if (tid < 64 && ii < total) { int lo = 0; int hi = 511; while (lo < hi) { const int mid = (lo + hi) >> 1; if (pref[mid] > ii) hi = mid; else lo = mid + 1; }
                   sched[tid * 4] = lo; sched[tid * 4 + 1] = ii - (lo ? pref[lo - 1] : 0); sched[tid * 4 + 2] = cnt[lo]; } }
             __syncthreads();
             sel_block_stream(p, lds, sched, total, tid, wid, lane);
             __syncthreads();)
    PHASE_S(7, 4, __syncthreads(); own_block_stream(p, lds, tid, wid, lane); __syncthreads();)
    PHASE(8, { pg8::StaticOrder S; S.init(T_, D_, G, blockIdx.x); pg8::Gemm g{(const u16*)(ws + WS_AB), (const u16*)(ws + WS_BA), T_, D_, 512};
               EpiBranch<true> E{(const u16*)(ws + WS_GATES), (u16*)(ws + WS_TMP), (u16*)(ws + WS_MERGED)}; pg8::gemm_phase(lds, g, S, E); }
             { pg8::StaticOrder S; S.init(T_, D_, G, blockIdx.x); pg8::Gemm g{(const u16*)(ws + WS_AB) + (size_t)T_ * 512, (const u16*)(ws + WS_BB), T_, D_, 512};
               EpiBranch<false> E{(const u16*)(ws + WS_GATES), (u16*)(ws + WS_TMP), (u16*)(ws + WS_MERGED)}; pg8::gemm_phase(lds, g, S, E); })
    PHASE(9, pg8::StaticOrder S; S.init(T_, D_, G, blockIdx.x); pg8::Gemm g{(const u16*)(ws + WS_MERGED), (const u16*)(ws + WS_WO), T_, D_, D_};
             EpiResid<false> E{(const u16*)p.out, nullptr, (u16*)(ws + WS_AB), (float*)(ws + WS_P2), 1.0f}; pg8::gemm_phase(lds, g, S, E);)
    PHASE(10, pg8::StaticOrder S; S.init(T_, 2 * DFF, G, blockIdx.x); pg8::Gemm g{(const u16*)(ws + WS_AB), (const u16*)(ws + WS_GU2), T_, 2 * DFF, D_};
              build_rtab(lds, S, (const float*)(ws + WS_P2)); EpiSwiglu E{(u16*)(ws + WS_ACT), lds}; pg8::gemm_phase(lds, g, S, E);)
    PHASE(11, pg8::StaticOrder S; S.init(T_, D_, G, blockIdx.x); pg8::Gemm g{(const u16*)(ws + WS_ACT), (const u16*)(ws + WS_DN2), T_, D_, DFF};
              EpiFinal E{(const u16*)(ws + WS_AB), p.out, (float*)(ws + WS_P3), (unsigned*)(ws + WS_BAR + 16384), p.nf, 0.5f}; pg8::gemm_phase(lds, g, S, E);)
}

extern "C" void kernel_launch(void* const* d_in, const int* in_sizes, int n_in, void* d_out, int out_size, void* d_ws, size_t ws_size, hipStream_t stream) {
    constexpr int LDS_BYTES = 152 * 1024 + 64 + 7 * 1024;
    static int grid = 0;
    if (grid == 0) {
        int dev = 0, cus = 0, per_cu = 0;
        hipGetDevice(&dev); hipDeviceGetAttribute(&cus, hipDeviceAttributeMultiprocessorCount, dev);
        hipFuncSetAttribute((const void*)fwd_megakernel, hipFuncAttributeMaxDynamicSharedMemorySize, LDS_BYTES);
        hipOccupancyMaxActiveBlocksPerMultiprocessor(&per_cu, (const void*)fwd_megakernel, 512, LDS_BYTES);
        if (per_cu < 1) { fprintf(stderr, "occupancy query says %d blocks/CU\n", per_cu); per_cu = 1; }
        (void)hipGetLastError();
        grid = cus;
        if (ws_size < WS_END) { fprintf(stderr, "workspace too small: %zu < %zu\n", ws_size, (size_t)WS_END); grid = -1; }
    }
    if (grid < 0) return;
    hipMemsetAsync((unsigned char*)d_ws + WS_BAR, 0, 32768, stream);
    Params p{};
    p.x = (const float*)d_in[0]; p.pos = (const int*)d_in[1];
    p.n1 = (const float*)d_in[2]; p.g1 = (const float*)d_in[3]; p.u1 = (const float*)d_in[4]; p.d1 = (const float*)d_in[5];
    p.nm = (const float*)d_in[6]; p.win = (const float*)d_in[7]; p.bg = (const float*)d_in[8]; p.wba = (const float*)d_in[9]; p.wbb = (const float*)d_in[10]; p.wo = (const float*)d_in[11];
    p.n2 = (const float*)d_in[12]; p.g2 = (const float*)d_in[13]; p.u2 = (const float*)d_in[14]; p.d2 = (const float*)d_in[15]; p.nf = (const float*)d_in[16];
    p.out = (float*)d_out; p.ws = (unsigned char*)d_ws;
#ifndef ONE_LAUNCH
#define ONE_LAUNCH 1
#endif
#if ONE_LAUNCH
    p.ph_lo = 0; p.ph_hi = N_PHASES;
    void* args[] = {&p};
    hipError_t e = hipLaunchCooperativeKernel((const void*)fwd_megakernel, dim3(grid), dim3(512), args, LDS_BYTES, stream);
    if (e != hipSuccess) fprintf(stderr, "cooperative launch failed: %s (grid %d)\n", hipGetErrorString(e), grid);
#else
#ifndef DBG_MASK
#define DBG_MASK 0x1fff
#endif
#ifndef DBG_FPART
#define DBG_FPART 0
#endif
    p.fpart = DBG_FPART;
    for (int ph = 0; ph < N_PHASES; ++ph) { if (!((DBG_MASK >> ph) & 1)) continue; p.ph_lo = ph; p.ph_hi = ph + 1; hipLaunchKernelGGL(fwd_megakernel, dim3(grid), dim3(512), LDS_BYTES, stream, p); }
#endif
}
```

```cpp
#include <hip/hip_runtime.h>
#include <hip/hip_cooperative_groups.h>
#include <cstdio>
namespace cg = cooperative_groups;

#define LAS __attribute__((address_space(3)))
typedef unsigned short u16;
typedef short bf16x8 __attribute__((ext_vector_type(8)));
typedef short s16x4 __attribute__((ext_vector_type(4)));
typedef float f32x4 __attribute__((ext_vector_type(4)));
typedef unsigned u32x4 __attribute__((ext_vector_type(4)));
typedef unsigned u32x2 __attribute__((ext_vector_type(2)));

constexpr int T_ = 16384, D_ = 1024, DFF = 2816, DIN = 5120, NH = 8, HD = 64;
constexpr int LDA_ = 1536;
constexpr float EPS = 1e-6f;
constexpr int LISTH = 256 * 2016;
constexpr int N_PHASES = 12;
#ifndef PH_MASK
#define PH_MASK 0x1fff
#endif

constexpr size_t SZ_GU = (size_t)2 * DFF * D_ * 2, SZ_DN = (size_t)D_ * DFF * 2, SZ_IN = (size_t)DIN * D_ * 2, SZ_BR = (size_t)D_ * 512 * 2, SZ_WO = (size_t)D_ * D_ * 2;
constexpr size_t WS_GU1 = 0, WS_DN1 = WS_GU1 + SZ_GU, WS_IN = WS_DN1 + SZ_DN, WS_BA = WS_IN + SZ_IN, WS_BB = WS_BA + SZ_BR, WS_WO = WS_BB + SZ_BR,
                 WS_GU2 = WS_WO + SZ_WO, WS_DN2 = WS_GU2 + SZ_GU, WS_CS = WS_DN2 + SZ_DN;
constexpr size_t SZ_PART = (size_t)T_ * 16 * 4;
constexpr size_t WS_P0 = WS_CS + (size_t)T_ * 16 * 4, WS_P1 = WS_P0 + SZ_PART, WS_P2 = WS_P1 + SZ_PART, WS_P3 = WS_P2 + SZ_PART;
constexpr size_t WS_KMEAN = WS_P3 + SZ_PART, WS_CNT = WS_KMEAN + (size_t)64 * 2 * 512 * 4, WS_BAR = WS_CNT + 4096, WS_PML = WS_BAR + 32768;
constexpr size_t WS_LIST = WS_PML + (size_t)T_ * NH * 3 * 2 * 4;
constexpr size_t WS_AB = WS_LIST + (size_t)NH * LISTH * 2;
constexpr size_t WS_BIG = WS_AB + (size_t)T_ * D_ * 2;
constexpr size_t SZ_QKV = (size_t)T_ * LDA_ * 2;
constexpr size_t WS_GATES = WS_BIG, WS_QKVA = WS_GATES + (size_t)T_ * 2048 * 2, WS_QKVB = WS_QKVA + SZ_QKV, WS_END = WS_QKVB + SZ_QKV;
constexpr size_t WS_ACT = WS_BIG, WS_TMP = WS_QKVA, WS_MERGED = WS_TMP + (size_t)T_ * D_ * 4, WS_PO = WS_QKVB;
static_assert(WS_END <= (size_t)256 * 1024 * 1024, "workspace");
static_assert(WS_AB % 256 == 0 && WS_BIG % 256 == 0 && WS_LIST % 16 == 0, "align");

__device__ unsigned g_sync[8192 + 64];

struct Params {
    const float* x; const int* pos;
    const float *n1, *g1, *u1, *d1, *nm, *win, *bg, *wba, *wbb, *wo, *n2, *g2, *u2, *d2, *nf;
    float* out; unsigned char* ws;
    int ph_lo, ph_hi, fpart, use_cg;
};

typedef __bf16 bf16x2_t __attribute__((ext_vector_type(2)));
typedef float f32x2_t __attribute__((ext_vector_type(2)));
__device__ __forceinline__ unsigned cvt_pk_bf16(float lo, float hi) { f32x2_t v = {lo, hi}; bf16x2_t b = __builtin_convertvector(v, bf16x2_t); return __builtin_bit_cast(unsigned, b); }
__device__ __forceinline__ float bf2f(u16 b) { return __uint_as_float(((unsigned)b) << 16); }
__device__ __forceinline__ float bflo(unsigned w) { return __uint_as_float(w << 16); }
__device__ __forceinline__ float bfhi(unsigned w) { return __uint_as_float(w & 0xffff0000u); }
__device__ __forceinline__ float fexp2(float x) { return __builtin_amdgcn_exp2f(x); }
__device__ __forceinline__ float frcp(float x) { return __builtin_amdgcn_rcpf(x); }

namespace pg8 {
constexpr int BM = 256, BK = 64, HALF = 128, HTB = HALF * BK * 2, STAGE_BYTES = 8 * HTB, NXCD = 8, WGM = 8;
__host__ __device__ __forceinline__ int lds_byte(int r, int c) { const int st = (r >> 4) * 2 + (c >> 5), rr = r & 15, cc = c & 31, ob = rr * 64 + cc * 2; return st * 1024 + (ob ^ (((ob >> 9) & 1) << 5)); }
__host__ __device__ __forceinline__ void stage_rc(int b, int& R, int& C) { const int st = b / 1024, sb = b % 1024, swz = sb ^ (((sb >> 9) & 1) << 5); R = (st >> 1) * 16 + swz / 64; C = (st & 1) * 32 + (swz % 64) / 2; }
struct Unit { int pm, pn; };
struct Gemm { const u16* A; const u16* Bt; int M, N, K; };
struct StaticOrder {
    int nM, nN, nwg, G, c;
    __host__ __device__ void init(int M, int N, int G_, int c_) { nM = M / BM; nN = N / BM; nwg = nM * nN; G = G_; c = c_; }
    __host__ __device__ bool next(int i, Unit& u) const {
        const long L = (long)i * G + c; if (L >= nwg) return false;
        int wgid = (int)L; { const int q = nwg / NXCD, r = nwg % NXCD, xcd = wgid % NXCD, off = wgid / NXCD; wgid = (xcd < r ? xcd * (q + 1) : r * (q + 1) + (xcd - r) * q) + off; }
        const int nig = WGM * nN, gid = wgid / nig, fm = gid * WGM, gsz = (nM - fm) < WGM ? (nM - fm) : WGM;
        u.pm = fm + ((wgid % nig) % gsz); u.pn = (wgid % nig) / gsz; return true;
    }
};

template <class Epi>
__device__ __forceinline__ void gemm_phase(LAS unsigned char* lds, const Gemm g, const StaticOrder& S, const Epi& E) {
    int tid_ = threadIdx.x; asm volatile("" : "+v"(tid_));
    const int tid = tid_, wid = __builtin_amdgcn_readfirstlane(tid >> 6), lane = tid & 63, wr = wid >> 2, wc = wid & 3, fr = lane & 15, fq = lane >> 4;
    const int K = g.K, nt = K / BK;
    unsigned voffA[2];
#pragma unroll
    for (int i = 0; i < 2; ++i) { int R, C; stage_rc(tid * 16 + i * 8192, R, C); voffA[i] = (unsigned)(R * K + C) * 2u; }
    const size_t kstep = (size_t)(BK * 2);
    const size_t hstep = (size_t)HALF * K * 2;
    const size_t tstep = 2 * hstep;
    const unsigned ldsw = (unsigned)wid * 1024u;
    const int aoff = lds_byte(wr * 64 + fr, fq * 8), boff = lds_byte(wc * 32 + fr, fq * 8);
#define PG8_SA(b, h) (((b) * 2 + (h)) * HTB)
#define PG8_SB(b, h) ((4 + (b) * 2 + (h)) * HTB)
#define PG8_STAGE(bufoff, gbase, voff) do { _Pragma("unroll") for (int _i = 0; _i < 2; ++_i) \
        __builtin_amdgcn_global_load_lds((const unsigned*)((const char*)(gbase) + (voff)[_i]), (LAS unsigned*)(lds + (bufoff) + ldsw + _i * 8192), 16, 0, 0); } while (0)
#define PG8_LDA(dst, b, h) do { _Pragma("unroll") for (int m = 0; m < 4; ++m) _Pragma("unroll") for (int k = 0; k < 2; ++k) dst[m][k] = *(const LAS bf16x8*)(lds + PG8_SA(b, h) + aoff + m * 2048 + k * 1024); } while (0)
#define PG8_LDB(dst, b, h) do { _Pragma("unroll") for (int n = 0; n < 2; ++n) _Pragma("unroll") for (int k = 0; k < 2; ++k) dst[n][k] = *(const LAS bf16x8*)(lds + PG8_SB(b, h) + boff + n * 2048 + k * 1024); } while (0)
#define PG8_MMA(ai, bj, At, Bt) do { __builtin_amdgcn_s_setprio(1); _Pragma("unroll") for (int m = 0; m < 4; ++m) _Pragma("unroll") for (int n = 0; n < 2; ++n) _Pragma("unroll") for (int k = 0; k < 2; ++k) \
        acc[ai][bj][m][n] = __builtin_amdgcn_mfma_f32_16x16x32_bf16(Bt[n][k], At[m][k], acc[ai][bj][m][n], 0, 0, 0); __builtin_amdgcn_s_setprio(0); } while (0)
#define PG8_WAIT_V(n) asm volatile("s_waitcnt vmcnt(" #n ")" ::: "memory")
#define PG8_WAIT_L(n) asm volatile("s_waitcnt lgkmcnt(" #n ")" ::: "memory")
#define PG8_BAR __builtin_amdgcn_s_barrier()
#define PG8_SCHED __builtin_amdgcn_sched_barrier(0)
    Unit cur, nxt; int ui = 0;
    if (!S.next(0, cur)) return;
    f32x4 acc[2][2][4][2];
#pragma unroll
    for (int a = 0; a < 2; ++a)
#pragma unroll
        for (int b = 0; b < 2; ++b)
#pragma unroll
            for (int m = 0; m < 4; ++m)
#pragma unroll
                for (int n = 0; n < 2; ++n) acc[a][b][m][n] = (f32x4){0.f, 0.f, 0.f, 0.f};
    bf16x8 At[4][2], B0[2][2], B1[2][2];
    const char* cA = (const char*)g.A + (size_t)cur.pm * tstep; const char* cB = (const char*)g.Bt + (size_t)cur.pn * tstep;
    PG8_STAGE(PG8_SB(0, 0), cB, voffA); PG8_STAGE(PG8_SA(0, 0), cA, voffA); PG8_STAGE(PG8_SB(0, 1), cB + hstep, voffA); PG8_STAGE(PG8_SA(0, 1), cA + hstep, voffA);
    if (wr == 1) PG8_BAR;
    PG8_WAIT_V(4); PG8_BAR;
    PG8_STAGE(PG8_SB(1, 0), cB + kstep, voffA); PG8_STAGE(PG8_SA(1, 0), cA + kstep, voffA); PG8_STAGE(PG8_SB(1, 1), cB + hstep + kstep, voffA);
    PG8_WAIT_V(6); PG8_BAR;
    for (;;) {
        const bool has_next = S.next(ui + 1, nxt);
        const char* nA = has_next ? (const char*)g.A + (size_t)nxt.pm * tstep : cA; const char* nB = has_next ? (const char*)g.Bt + (size_t)nxt.pn * tstep : cB;
        for (int t = 0; t < nt; t += 2) {
            const bool last = (t == nt - 2);
            const char* a1 = cA + (size_t)(t + 1) * kstep;
            const char* a2 = last ? nA : cA + (size_t)(t + 2) * kstep; const char* b2 = last ? nB : cB + (size_t)(t + 2) * kstep;
            const char* a3 = a2 + kstep; const char* b3 = b2 + kstep;
            PG8_LDB(B0, 0, 0); PG8_SCHED; PG8_LDA(At, 0, 0); PG8_STAGE(PG8_SA(1, 1), a1 + hstep, voffA);
            PG8_WAIT_L(8); PG8_BAR; PG8_WAIT_L(0); PG8_MMA(0, 0, At, B0); PG8_BAR; PG8_SCHED;
            PG8_LDB(B1, 0, 1); PG8_STAGE(PG8_SB(0, 0), b2, voffA);
            PG8_BAR; PG8_WAIT_L(0); PG8_MMA(0, 1, At, B1); PG8_BAR;
            PG8_LDA(At, 0, 1); PG8_STAGE(PG8_SA(0, 0), a2, voffA);
            PG8_BAR; PG8_WAIT_L(0); PG8_MMA(1, 0, At, B0); PG8_BAR; PG8_SCHED;
            PG8_STAGE(PG8_SB(0, 1), b2 + hstep, voffA);
            PG8_WAIT_V(6); PG8_BAR; PG8_MMA(1, 1, At, B1); PG8_BAR;
            PG8_LDB(B0, 1, 0); PG8_SCHED; PG8_LDA(At, 1, 0); PG8_STAGE(PG8_SA(0, 1), a2 + hstep, voffA);
            PG8_WAIT_L(8); PG8_BAR; PG8_WAIT_L(0); PG8_MMA(0, 0, At, B0); PG8_BAR; PG8_SCHED;
            PG8_LDB(B1, 1, 1); PG8_STAGE(PG8_SB(1, 0), b3, voffA);
            PG8_BAR; PG8_WAIT_L(0); PG8_MMA(0, 1, At, B1); PG8_BAR;
            PG8_LDA(At, 1, 1); PG8_STAGE(PG8_SA(1, 0), a3, voffA);
            PG8_BAR; PG8_WAIT_L(0); PG8_MMA(1, 0, At, B0); PG8_BAR; PG8_SCHED;
            PG8_STAGE(PG8_SB(1, 1), b3 + hstep, voffA);
            PG8_WAIT_V(6); PG8_BAR; PG8_MMA(1, 1, At, B1); PG8_BAR;
        }
        if constexpr (!Epi::AFTER_DRAIN) E(acc, cur, ui, wr, wc, fr, fq);
        if (!has_next) break;
#pragma unroll
        for (int a = 0; a < 2; ++a)
#pragma unroll
            for (int b = 0; b < 2; ++b)
#pragma unroll
                for (int m = 0; m < 4; ++m)
#pragma unroll
                    for (int n = 0; n < 2; ++n) acc[a][b][m][n] = (f32x4){0.f, 0.f, 0.f, 0.f};
        cur = nxt; cA = nA; cB = nB; ++ui;
    }
    PG8_WAIT_V(0);
    if (wr == 0) PG8_BAR;
    PG8_BAR;
    if constexpr (Epi::AFTER_DRAIN) E.fused(acc, cur, wr, wc, fr, fq, lane);
#undef PG8_SA
#undef PG8_SB
#undef PG8_STAGE
#undef PG8_LDA
#undef PG8_LDB
#undef PG8_MMA
#undef PG8_WAIT_V
#undef PG8_WAIT_L
#undef PG8_BAR
#undef PG8_SCHED
}
}
using pg8::Unit;
typedef f32x4 Acc[2][2][4][2];

constexpr int XST_OFF = 152 * 1024, RTAB_OFF = XST_OFF + 64;
__device__ __forceinline__ void build_rtab(LAS unsigned char* lds, const pg8::StaticOrder& S, const float* part) {
    LAS float* rtab = (LAS float*)(lds + RTAB_OFF);
    int nu = 0; { pg8::Unit u; while (nu < 7 && S.next(nu, u)) ++nu; }
    for (int idx = threadIdx.x; idx < nu * 256; idx += 512) { pg8::Unit u; S.next(idx >> 8, u);
        const f32x4* pp = (const f32x4*)(part + (size_t)(u.pm * 256 + (idx & 255)) * 16);
        f32x4 a = pp[0], b = pp[1], c = pp[2], d = pp[3]; f32x4 sv = (a + b) + (c + d);
        rtab[idx] = __builtin_amdgcn_rsqf((sv[0] + sv[1] + sv[2] + sv[3]) * (1.0f / D_) + EPS); }
    __syncthreads();
}
__device__ __forceinline__ void rtab_get(float (&rinv)[2][4], LAS const unsigned char* lds, int ui, int wr, int fr) {
    LAS const float* rtab = (LAS const float*)(lds + RTAB_OFF) + ui * 256 + wr * 64 + fr;
#pragma unroll
    for (int ai = 0; ai < 2; ++ai)
#pragma unroll
        for (int m = 0; m < 4; ++m) rinv[ai][m] = rtab[ai * 128 + m * 16];
}

struct EpiSwiglu {
    static constexpr bool AFTER_DRAIN = false;
    u16* act; LAS const unsigned char* lds;
    __device__ __forceinline__ void operator()(const Acc& acc, const Unit& u, int ui, int wr, int wc, int fr, int fq) const {
        const int row0 = u.pm * 256 + wr * 64 + fr, col0 = u.pn * 128 + wc * 32 + fq * 8;
        float rinv[2][4]; rtab_get(rinv, lds, ui, wr, fr);
#pragma unroll
        for (int ai = 0; ai < 2; ++ai)
#pragma unroll
            for (int m = 0; m < 4; ++m) {
                const float ri = rinv[ai][m]; float v[8];
#pragma unroll
                for (int n = 0; n < 2; ++n)
#pragma unroll
                    for (int j = 0; j < 4; ++j) { const float g = acc[ai][0][m][n][j] * ri, up = acc[ai][1][m][n][j] * ri;
                        v[n * 4 + j] = g * frcp(1.0f + fexp2(-1.4426950408889634f * g)) * up; }
                u32x4 o; o[0] = cvt_pk_bf16(v[0], v[1]); o[1] = cvt_pk_bf16(v[2], v[3]); o[2] = cvt_pk_bf16(v[4], v[5]); o[3] = cvt_pk_bf16(v[6], v[7]);
                *(u32x4*)(act + (size_t)(row0 + ai * 128 + m * 16) * DFF + col0) = o;
            }
    }
};

template <bool OF> struct EpiResid {
    static constexpr bool AFTER_DRAIN = false;
    const u16* resid; float* out; u16* hb; float* part; float scale;
    __device__ __forceinline__ void operator()(const Acc& acc, const Unit& u, int ui, int wr, int wc, int fr, int fq) const {
        const int row0 = u.pm * 256 + wr * 64 + fr, col0 = u.pn * 256 + wc * 32 + fq * 8;
        u32x4 rwa[2][4][2];
#pragma unroll
        for (int ai = 0; ai < 2; ++ai)
#pragma unroll
            for (int m = 0; m < 4; ++m)
#pragma unroll
                for (int bj = 0; bj < 2; ++bj) rwa[ai][m][bj] = *(const u32x4*)(resid + (size_t)(row0 + ai * 128 + m * 16) * D_ + col0 + bj * 128);
#pragma unroll
        for (int ai = 0; ai < 2; ++ai) {
#pragma unroll
            for (int m = 0; m < 4; ++m) {
                const int row = row0 + ai * 128 + m * 16; float ss = 0.f;
#pragma unroll
                for (int bj = 0; bj < 2; ++bj) {
                    const size_t o = (size_t)row * D_ + col0 + bj * 128;
                    const u32x4 w = rwa[ai][m][bj];
                    f32x4 h0 = (f32x4){bflo(w[0]), bfhi(w[0]), bflo(w[1]), bfhi(w[1])} + acc[ai][bj][m][0] * scale;
                    f32x4 h1 = (f32x4){bflo(w[2]), bfhi(w[2]), bflo(w[3]), bfhi(w[3])} + acc[ai][bj][m][1] * scale;
                    ss += h0[0] * h0[0] + h0[1] * h0[1] + h0[2] * h0[2] + h0[3] * h0[3] + h1[0] * h1[0] + h1[1] * h1[1] + h1[2] * h1[2] + h1[3] * h1[3];
                    if (OF) { *(f32x4*)(out + o) = h0; *(f32x4*)(out + o + 4) = h1; }
                    else { u32x4 b; b[0] = cvt_pk_bf16(h0[0], h0[1]); b[1] = cvt_pk_bf16(h0[2], h0[3]); b[2] = cvt_pk_bf16(h1[0], h1[1]); b[3] = cvt_pk_bf16(h1[2], h1[3]); *(u32x4*)(hb + o) = b; }
                }
                ss += __shfl_xor(ss, 16); ss += __shfl_xor(ss, 32);
                if (fq == 0) part[(size_t)row * 16 + u.pn * 4 + wc] = ss;
            }
        }
    }
};

struct EpiWin {
    static constexpr bool AFTER_DRAIN = false;
    u16 *qkva, *qkvb, *gates; LAS const unsigned char* lds; const float *cs, *bgate; float* kmp;
    __device__ __forceinline__ void operator()(const Acc& acc, const Unit& u, int ui, int wr, int wc, int fr, int fq) const {
        const int row0 = u.pm * 256 + wr * 64 + fr;
        const int pn = u.pn;
        LAS const float* rtab = (LAS const float*)(lds + RTAB_OFF) + ui * 256 + wr * 64 + fr;
        if (pn >= 12) {
            f32x4 bb[2][2];
#pragma unroll
            for (int bj = 0; bj < 2; ++bj) { const int gc = pn * 256 + bj * 128 + wc * 32 - 3072 + fq * 8; bb[bj][0] = *(const f32x4*)(bgate + gc); bb[bj][1] = *(const f32x4*)(bgate + gc + 4); }
#pragma unroll
            for (int bj = 0; bj < 2; ++bj) { const int gc = pn * 256 + bj * 128 + wc * 32 - 3072 + fq * 8;
#pragma unroll
                for (int ai = 0; ai < 2; ++ai)
#pragma unroll
                    for (int m = 0; m < 4; ++m) { const float ri = rtab[ai * 128 + m * 16]; float v[8];
#pragma unroll
                        for (int j = 0; j < 4; ++j) { v[j] = acc[ai][bj][m][0][j] * ri + bb[bj][0][j]; v[4 + j] = acc[ai][bj][m][1][j] * ri + bb[bj][1][j]; }
#pragma unroll
                        for (int j = 0; j < 8; ++j) v[j] = frcp(1.0f + fexp2(-1.4426950408889634f * v[j]));
                        u32x4 o; o[0] = cvt_pk_bf16(v[0], v[1]); o[1] = cvt_pk_bf16(v[2], v[3]); o[2] = cvt_pk_bf16(v[4], v[5]); o[3] = cvt_pk_bf16(v[6], v[7]);
                        *(u32x4*)(gates + (size_t)(row0 + ai * 128 + m * 16) * 2048 + gc) = o; } }
        } else {
            const bool isk = (pn == 2) || (pn == 3);
#pragma unroll
            for (int bj = 0; bj < 2; ++bj) {
                const int g32 = pn * 256 + bj * 128 + wc * 32;
                u16* base = g32 < 1536 ? qkva + g32 : qkvb + (g32 - 1536);
                const bool rot = (g32 < 1024) && ((g32 & 63) == 0) && (fq < 2);
                f32x4 ks0 = {0.f, 0.f, 0.f, 0.f}, ks1 = {0.f, 0.f, 0.f, 0.f};
                if (rot) {
#pragma unroll
                    for (int ai = 0; ai < 2; ++ai) {
                        f32x4 cc[4], sn[4];
#pragma unroll
                        for (int m = 0; m < 4; ++m) { const int row = row0 + ai * 128 + m * 16; cc[m] = *(const f32x4*)(cs + (size_t)row * 16 + fq * 4); sn[m] = *(const f32x4*)(cs + (size_t)row * 16 + 8 + fq * 4); }
#pragma unroll
                        for (int m = 0; m < 4; ++m) { const float ri = rtab[ai * 128 + m * 16]; const int row = row0 + ai * 128 + m * 16;
                            f32x4 a = acc[ai][bj][m][0] * ri, b = acc[ai][bj][m][1] * ri;
                            f32x4 o1 = a * cc[m] - b * sn[m], o2 = b * cc[m] + a * sn[m];
                            u32x2 w1, w2; w1[0] = cvt_pk_bf16(o1[0], o1[1]); w1[1] = cvt_pk_bf16(o1[2], o1[3]); w2[0] = cvt_pk_bf16(o2[0], o2[1]); w2[1] = cvt_pk_bf16(o2[2], o2[3]);
                            *(u32x2*)(base + (size_t)row * LDA_ + fq * 4) = w1; *(u32x2*)(base + (size_t)row * LDA_ + 8 + fq * 4) = w2;
                            ks0 += o1; ks1 += o2; } }
                } else {
#pragma unroll
                    for (int ai = 0; ai < 2; ++ai)
#pragma unroll
                        for (int m = 0; m < 4; ++m) { const float ri = rtab[ai * 128 + m * 16]; const int row = row0 + ai * 128 + m * 16;
                            f32x4 a = acc[ai][bj][m][0] * ri, b = acc[ai][bj][m][1] * ri;
                            u32x4 o; o[0] = cvt_pk_bf16(a[0], a[1]); o[1] = cvt_pk_bf16(a[2], a[3]); o[2] = cvt_pk_bf16(b[0], b[1]); o[3] = cvt_pk_bf16(b[2], b[3]);
                            *(u32x4*)(base + (size_t)row * LDA_ + fq * 8) = o;
                            ks0 += a; ks1 += b; }
                }
                if (isk) {
#pragma unroll
                    for (int j = 0; j < 4; ++j) {
#pragma unroll
                        for (int o = 1; o < 16; o <<= 1) { ks0[j] += __shfl_xor(ks0[j], o); ks1[j] += __shfl_xor(ks1[j], o); } }
                    if (fr == 0) { float* kp = kmp + (size_t)u.pm * 512 + (g32 - 512);
#pragma unroll
                        for (int j = 0; j < 4; ++j) { atomicAdd(kp + (rot ? fq * 4 : fq * 8) + j, ks0[j]); atomicAdd(kp + (rot ? 8 + fq * 4 : fq * 8 + 4) + j, ks1[j]); } }
                }
            }
        }
    }
};

template <bool FIRST> struct EpiBranch {
    static constexpr bool AFTER_DRAIN = false;
    const u16* gates; u16* tmp; u16* merged;
    __device__ __forceinline__ void operator()(const Acc& acc, const Unit& u, int ui, int wr, int wc, int fr, int fq) const {
        const int row0 = u.pm * 256 + wr * 64 + fr, col0 = u.pn * 256 + wc * 32 + fq * 8;
        constexpr int NB = FIRST ? 1 : 2, AIB = FIRST ? 2 : 1;
#pragma unroll
        for (int bt = 0; bt < NB; ++bt) {
            u32x4 gw[AIB][4][2], tw[AIB][4][2];
#pragma unroll
            for (int a2 = 0; a2 < AIB; ++a2)
#pragma unroll
                for (int m = 0; m < 4; ++m)
#pragma unroll
                    for (int bj = 0; bj < 2; ++bj) { const int ai = FIRST ? a2 : bt, row = row0 + ai * 128 + m * 16, col = col0 + bj * 128;
                        gw[a2][m][bj] = *(const u32x4*)(gates + (size_t)row * 2048 + (FIRST ? 0 : 1024) + col);
                        if (!FIRST) tw[a2][m][bj] = *(const u32x4*)(tmp + (size_t)row * D_ + col); }
#pragma unroll
            for (int a2 = 0; a2 < AIB; ++a2)
#pragma unroll
                for (int m = 0; m < 4; ++m)
#pragma unroll
                    for (int bj = 0; bj < 2; ++bj) { const int ai = FIRST ? a2 : bt, row = row0 + ai * 128 + m * 16, col = col0 + bj * 128;
                        const u32x4 g2 = gw[a2][m][bj];
                        f32x4 v0 = (f32x4){bflo(g2[0]), bfhi(g2[0]), bflo(g2[1]), bfhi(g2[1])} * acc[ai][bj][m][0];
                        f32x4 v1 = (f32x4){bflo(g2[2]), bfhi(g2[2]), bflo(g2[3]), bfhi(g2[3])} * acc[ai][bj][m][1];
                        if (!FIRST) { const u32x4 t2 = tw[a2][m][bj]; v0 += (f32x4){bflo(t2[0]), bfhi(t2[0]), bflo(t2[1]), bfhi(t2[1])}; v1 += (f32x4){bflo(t2[2]), bfhi(t2[2]), bflo(t2[3]), bfhi(t2[3])}; }
                        u32x4 b; b[0] = cvt_pk_bf16(v0[0], v0[1]); b[1] = cvt_pk_bf16(v0[2], v0[3]); b[2] = cvt_pk_bf16(v1[0], v1[1]); b[3] = cvt_pk_bf16(v1[2], v1[3]);
                        *(u32x4*)((FIRST ? tmp : merged) + (size_t)row * D_ + col) = b; }
        }
    }
};

struct EpiFinal {
    static constexpr bool AFTER_DRAIN = true;
    const u16* resid; float* out; float* part; unsigned* pcnt; const float* gain; float scale;
    __device__ __forceinline__ void operator()(const Acc&, const Unit&, int, int, int, int, int) const {}
    __device__ __forceinline__ void fused(Acc& acc, const Unit& u, int wr, int wc, int fr, int fq, int lane) const {
        const int row0 = u.pm * 256 + wr * 64 + fr, col0 = u.pn * 256 + wc * 32 + fq * 8;
        u32x4 rwa[2][4][2];
#pragma unroll
        for (int ai = 0; ai < 2; ++ai)
#pragma unroll
            for (int m = 0; m < 4; ++m)
#pragma unroll
                for (int bj = 0; bj < 2; ++bj) rwa[ai][m][bj] = *(const u32x4*)(resid + (size_t)(row0 + ai * 128 + m * 16) * D_ + col0 + bj * 128);
#pragma unroll
        for (int ai = 0; ai < 2; ++ai)
#pragma unroll
            for (int m = 0; m < 4; ++m) { float ss = 0.f;
#pragma unroll
                for (int bj = 0; bj < 2; ++bj) { const u32x4 w = rwa[ai][m][bj];
                    f32x4 h0 = (f32x4){bflo(w[0]), bfhi(w[0]), bflo(w[1]), bfhi(w[1])} + acc[ai][bj][m][0] * scale;
                    f32x4 h1 = (f32x4){bflo(w[2]), bfhi(w[2]), bflo(w[3]), bfhi(w[3])} + acc[ai][bj][m][1] * scale;
                    acc[ai][bj][m][0] = h0; acc[ai][bj][m][1] = h1;
                    ss += h0[0] * h0[0] + h0[1] * h0[1] + h0[2] * h0[2] + h0[3] * h0[3] + h1[0] * h1[0] + h1[1] * h1[1] + h1[2] * h1[2] + h1[3] * h1[3]; }
                ss += __shfl_xor(ss, 16); ss += __shfl_xor(ss, 32);
                if (fq == 0) __hip_atomic_store(part + (size_t)(row0 + ai * 128 + m * 16) * 16 + u.pn * 4 + wc, ss, __ATOMIC_RELAXED, __HIP_MEMORY_SCOPE_AGENT); }
        asm volatile("s_waitcnt vmcnt(0)" ::: "memory");
        unsigned* cw = pcnt + u.pm * 16;
        if (lane == 0) {
            __hip_atomic_fetch_add(cw, 1u, __ATOMIC_RELAXED, __HIP_MEMORY_SCOPE_AGENT);
            unsigned sp = 0;
            while (__hip_atomic_load(cw, __ATOMIC_RELAXED, __HIP_MEMORY_SCOPE_AGENT) < 32u) { __builtin_amdgcn_s_sleep(1); if (++sp > (1u << 22)) break; }
        }
        float rinv[2][4];
        { float pv[2][4][4];
#pragma unroll
          for (int ai = 0; ai < 2; ++ai)
#pragma unroll
            for (int m = 0; m < 4; ++m)
#pragma unroll
              for (int k = 0; k < 4; ++k) pv[ai][m][k] = __hip_atomic_load(part + (size_t)(row0 + ai * 128 + m * 16) * 16 + fq * 4 + k, __ATOMIC_RELAXED, __HIP_MEMORY_SCOPE_AGENT);
#pragma unroll
          for (int ai = 0; ai < 2; ++ai)
#pragma unroll
            for (int m = 0; m < 4; ++m) { float sv = (pv[ai][m][0] + pv[ai][m][1]) + (pv[ai][m][2] + pv[ai][m][3]);
                sv += __shfl_xor(sv, 16); sv += __shfl_xor(sv, 32); rinv[ai][m] = __builtin_amdgcn_rsqf(sv * (1.0f / D_) + EPS); } }
        f32x4 gv[2][2];
#pragma unroll
        for (int bj = 0; bj < 2; ++bj)
#pragma unroll
            for (int n = 0; n < 2; ++n) gv[bj][n] = *(const f32x4*)(gain + col0 + bj * 128 + n * 4);
#pragma unroll
        for (int ai = 0; ai < 2; ++ai)
#pragma unroll
            for (int m = 0; m < 4; ++m)
#pragma unroll
                for (int bj = 0; bj < 2; ++bj)
#pragma unroll
                    for (int n = 0; n < 2; ++n)
                        *(f32x4*)(out + (size_t)(row0 + ai * 128 + m * 16) * D_ + col0 + bj * 128 + n * 4) = acc[ai][bj][m][n] * rinv[ai][m] * gv[bj][n];
    }
};

__device__ __forceinline__ int map_gu(int c, int up) { const int pn = c >> 7, w = c & 127, wc = w >> 5, r = w & 31; return pn * 256 + up * 128 + wc * 32 + ((r >> 2) & 1) * 16 + (r >> 3) * 4 + (r & 3); }
__device__ __forceinline__ int map_perm8(int c) { const int r = c & 31; return (c & ~31) + ((r >> 2) & 1) * 16 + (r >> 3) * 4 + (r & 3); }
__device__ __forceinline__ int map_win(int c) { if (c < 1024 && (c & 63) < 16) { const int r = c & 15, x2 = r >> 3, i = r & 7; return (c & ~63) + x2 * 16 + (i >> 2) * 4 + (i & 3); } return map_perm8(c); }

struct TileDesc { const float* W; u16* Wt; const float* gain; int K, N, mode, tile; };
struct TileRegs { f32x4 v[2]; float gk[2]; };
__device__ __forceinline__ void tile_load(TileRegs& r, const TileDesc& d) {
    const int ntn = d.N >> 6, tk = d.tile / ntn, tn = d.tile - tk * ntn, k0 = tk * 64, n0 = tn * 64, tid = threadIdx.x;
    const float cscale = d.mode == 3 ? (n0 < 512 ? 0.125f * 1.4426950408889634f : (n0 >= 1536 && n0 < 2048) ? 0.125f : 1.0f) : 1.0f;
#pragma unroll
    for (int i = 0; i < 2; ++i) { const int e = tid + i * 512, k = e >> 4, c4 = (e & 15) * 4;
        r.v[i] = *(const f32x4*)(d.W + (size_t)(k0 + k) * d.N + n0 + c4); r.gk[i] = (d.gain ? d.gain[k0 + k] : 1.0f) * cscale; }
}
__device__ __forceinline__ void tile_store(LAS float* tl, const TileRegs& r, const TileDesc& d) {
    const int ntn = d.N >> 6, tk = d.tile / ntn, tn = d.tile - tk * ntn, k0 = tk * 64, n0 = tn * 64, tid = threadIdx.x;
    __syncthreads();
#pragma unroll
    for (int i = 0; i < 2; ++i) { const int e = tid + i * 512, k = e >> 4, c4 = (e & 15) * 4; const f32x4 v = r.v[i] * r.gk[i];
        tl[k * 65 + c4] = v[0]; tl[k * 65 + c4 + 1] = v[1]; tl[k * 65 + c4 + 2] = v[2]; tl[k * 65 + c4 + 3] = v[3]; }
    __syncthreads();
    const int n = tid & 63, kg = tid >> 6; float v[8];
#pragma unroll
    for (int i = 0; i < 8; ++i) v[i] = tl[(kg * 8 + i) * 65 + n];
    const int c = n0 + n; const int rr = d.mode == 0 ? c : d.mode == 1 ? map_gu(c, 0) : d.mode == 2 ? map_gu(c, 1) : d.mode == 3 ? map_win(c) : map_perm8(c);
    u32x4 o; o[0] = cvt_pk_bf16(v[0], v[1]); o[1] = cvt_pk_bf16(v[2], v[3]); o[2] = cvt_pk_bf16(v[4], v[5]); o[3] = cvt_pk_bf16(v[6], v[7]);
    *(u32x4*)(d.Wt + (size_t)rr * d.K + k0 + kg * 8) = o;
}

__device__ __forceinline__ void prep_phase(const Params& p, LAS unsigned char* lds) {
    unsigned char* ws = p.ws; LAS float* tl = (LAS float*)lds;
    const int tid = threadIdx.x, lane = tid & 63, wid = tid >> 6, G = gridDim.x;
    if (blockIdx.x == 0) { ((int*)(ws + WS_CNT))[tid] = 0; }
    if (blockIdx.x < 64) ((float*)(ws + WS_KMEAN))[blockIdx.x * 512 + tid] = 0.f;
    constexpr int T_GU = 16 * 44, T_DN = 44 * 16, T_IN = 16 * 80, T_BR = 8 * 16, T_WO = 16 * 16;
    constexpr int o1 = T_GU, o2 = o1 + T_GU, o3 = o2 + T_DN, o4 = o3 + T_IN, o5 = o4 + T_BR, o6 = o5 + T_BR, o7 = o6 + T_WO, o8 = o7 + T_GU, o9 = o8 + T_GU, o10 = o9 + T_DN;
    auto desc = [&](int t) -> TileDesc {
        if (t < o1) return TileDesc{p.g1, (u16*)(ws + WS_GU1), p.n1, D_, DFF, 1, t};
        if (t < o2) return TileDesc{p.u1, (u16*)(ws + WS_GU1), p.n1, D_, DFF, 2, t - o1};
        if (t < o3) return TileDesc{p.d1, (u16*)(ws + WS_DN1), nullptr, DFF, D_, 4, t - o2};
        if (t < o4) return TileDesc{p.win, (u16*)(ws + WS_IN), p.nm, D_, DIN, 3, t - o3};
        if (t < o5) return TileDesc{p.wba, (u16*)(ws + WS_BA), nullptr, 512, D_, 4, t - o4};
        if (t < o6) return TileDesc{p.wbb, (u16*)(ws + WS_BB), nullptr, 512, D_, 4, t - o5};
        if (t < o7) return TileDesc{p.wo, (u16*)(ws + WS_WO), nullptr, D_, D_, 4, t - o6};
        if (t < o8) return TileDesc{p.g2, (u16*)(ws + WS_GU2), p.n2, D_, DFF, 1, t - o7};
        if (t < o9) return TileDesc{p.u2, (u16*)(ws + WS_GU2), p.n2, D_, DFF, 2, t - o8};
        return TileDesc{p.d2, (u16*)(ws + WS_DN2), nullptr, DFF, D_, 4, t - o9};
    };
    const int NPREP = (int)gridDim.x == 256 ? 2 * T_GU : 2 * T_GU + 2 * T_GU + T_DN;
    auto pdesc = [&](int t) -> TileDesc { return t < 2 * T_GU ? desc(t) : desc(t - 2 * T_GU + o7); };
    { int t = blockIdx.x;
      if (t < NPREP) { TileDesc d = pdesc(t); TileRegs ra; tile_load(ra, d);
        for (;;) { const int tn = t + G; const bool more = tn < NPREP; TileDesc dn = d; TileRegs rb = ra;
            if (more) { dn = pdesc(tn); tile_load(rb, dn); }
            tile_store(tl, ra, d);
            if (!more) break;
            d = dn; ra = rb; t = tn; } } }
    u16* xb = (u16*)(ws + WS_AB); float* part0 = (float*)(ws + WS_P0); float* cs = (float*)(ws + WS_CS);
    f32x4 xv[4];
    { const int row0_ = blockIdx.x * 8 + wid; if (row0_ < T_) {
#pragma unroll
        for (int i = 0; i < 4; ++i) xv[i] = *(const f32x4*)(p.x + (size_t)row0_ * D_ + i * 256 + lane * 4); } }
    for (int row = blockIdx.x * 8 + wid; row < T_; row += G * 8) {
        float ss = 0.f; f32x4 cur[4];
#pragma unroll
        for (int i = 0; i < 4; ++i) cur[i] = xv[i];
        if (row + G * 8 < T_) {
#pragma unroll
            for (int i = 0; i < 4; ++i) xv[i] = *(const f32x4*)(p.x + (size_t)(row + G * 8) * D_ + i * 256 + lane * 4); }
#pragma unroll
        for (int i = 0; i < 4; ++i) { const f32x4 v = cur[i]; ss += v[0] * v[0] + v[1] * v[1] + v[2] * v[2] + v[3] * v[3];
            u32x2 b; b[0] = cvt_pk_bf16(v[0], v[1]); b[1] = cvt_pk_bf16(v[2], v[3]); *(u32x2*)(xb + (size_t)row * D_ + i * 256 + lane * 4) = b; }
#pragma unroll
        for (int o = 32; o >= 1; o >>= 1) ss += __shfl_xor(ss, o);
        if (lane < 16) part0[(size_t)row * 16 + lane] = lane == 0 ? ss : 0.f;
        if (lane >= 16 && lane < 24) {
            const int i = lane - 16;
            const float invf = i == 0 ? 1.0f : i == 1 ? 0.1939227432012558f : i == 2 ? 0.03760603070259094f : i == 3 ? 0.007292664609849453f : i == 4 ? 0.0014142135623842478f
                             : i == 5 ? 0.00027424818836152554f : i == 6 ? 5.318296098266728e-05f : 1.0313386155758053e-05f;
            const float ang = (float)p.pos[row] * invf;
            const double a = (double)ang, kk = __builtin_rint(a * 0.15915494309189535), r = a - kk * 6.283185307179586;
            const float rf = (float)r;
            cs[(size_t)row * 16 + i] = __cosf(rf); cs[(size_t)row * 16 + 8 + i] = __sinf(rf);
        }
    }
}


__device__ __forceinline__ void deferred_weights(const Params& p, LAS unsigned char* lds, int j, int nidle, int lo, int hi) {
    unsigned char* ws = p.ws; LAS float* tl = (LAS float*)lds;
    constexpr int T_GU = 16 * 44, T_DN = 44 * 16, T_IN = 16 * 80, T_BR = 8 * 16, T_WO = 16 * 16;
    constexpr int o2 = 2 * T_GU, o3 = o2 + T_DN, o4 = o3 + T_IN, o5 = o4 + T_BR, o6 = o5 + T_BR, o7 = o6 + T_WO, o8 = o7 + T_GU, o9 = o8 + T_GU;
    auto desc = [&](int t) -> TileDesc {
        if (t < o3) return TileDesc{p.d1, (u16*)(ws + WS_DN1), nullptr, DFF, D_, 4, t - o2};
        if (t < o4) return TileDesc{p.win, (u16*)(ws + WS_IN), p.nm, D_, DIN, 3, t - o3};
        if (t < o5) return TileDesc{p.wba, (u16*)(ws + WS_BA), nullptr, 512, D_, 4, t - o4};
        if (t < o6) return TileDesc{p.wbb, (u16*)(ws + WS_BB), nullptr, 512, D_, 4, t - o5};
        if (t < o7) return TileDesc{p.wo, (u16*)(ws + WS_WO), nullptr, D_, D_, 4, t - o6};
        if (t < o8) return TileDesc{p.g2, (u16*)(ws + WS_GU2), p.n2, D_, DFF, 1, t - o7};
        if (t < o9) return TileDesc{p.u2, (u16*)(ws + WS_GU2), p.n2, D_, DFF, 2, t - o8};
        return TileDesc{p.d2, (u16*)(ws + WS_DN2), nullptr, DFF, D_, 4, t - o9};
    };
    int t = lo + j;
    if (t < hi) { TileDesc d = desc(t); TileRegs ra; tile_load(ra, d);
        for (;;) { const int tn = t + nidle; const bool more = tn < hi; TileDesc dn = d; TileRegs rb = ra;
            if (more) { dn = desc(tn); tile_load(rb, dn); }
            tile_store(tl, ra, d);
            if (!more) break;
            d = dn; ra = rb; t = tn; } }
}

__device__ __forceinline__ s16x4 vtr(LAS const unsigned char* p) { typedef short v4i16_t __attribute__((ext_vector_type(4))); return __builtin_bit_cast(s16x4, __builtin_amdgcn_ds_read_tr16_b64_v4i16((LAS v4i16_t*)p)); }

__device__ __forceinline__ void pv_tile(f32x4 (&o)[4], LAS const unsigned char* vs, const bf16x8 (&pf)[2], int lane) {
    const int li = lane & 15, g = lane >> 4, q_ = li >> 2, pp = li & 3;
    LAS const unsigned char* b0 = vs + (4 * g + q_) * 144 + pp * 8;
#pragma unroll
    for (int ks = 0; ks < 2; ++ks)
#pragma unroll
        for (int dt = 0; dt < 4; ++dt) {
            s16x4 lo = vtr(b0 + (32 * ks) * 144 + dt * 32), hi = vtr(b0 + (32 * ks + 16) * 144 + dt * 32);
            bf16x8 va = {lo[0], lo[1], lo[2], lo[3], hi[0], hi[1], hi[2], hi[3]};
            o[dt] = __builtin_amdgcn_mfma_f32_16x16x32_bf16(va, pf[ks], o[dt], 0, 0, 0);
        }
}
__device__ __forceinline__ void pack_p(bf16x8 (&pf)[2], const float (&w)[4][4]) {
#pragma unroll
    for (int ks = 0; ks < 2; ++ks) { u32x4 t; t[0] = cvt_pk_bf16(w[2 * ks][0], w[2 * ks][1]); t[1] = cvt_pk_bf16(w[2 * ks][2], w[2 * ks][3]);
        t[2] = cvt_pk_bf16(w[2 * ks + 1][0], w[2 * ks + 1][1]); t[3] = cvt_pk_bf16(w[2 * ks + 1][2], w[2 * ks + 1][3]); pf[ks] = __builtin_bit_cast(bf16x8, t); }
}
__device__ __forceinline__ void load_qf(bf16x8 (&qf)[2], const u16* qrow, int lane) { const int g = lane >> 4; qf[0] = *(const bf16x8*)(qrow + 8 * g); qf[1] = *(const bf16x8*)(qrow + 32 + 8 * g); }

__device__ __forceinline__ int list_off(int n) { return 256 * (63 * n - (n * (n - 1)) / 2); }

struct Top3 { float v1, v2, v3; int i1, i2, i3; };
__device__ __forceinline__ void top3_insert(Top3& t, float v, int i) {
    const bool b1 = v > t.v1 || (v == t.v1 && i < t.i1), b2 = v > t.v2 || (v == t.v2 && i < t.i2), b3 = v > t.v3 || (v == t.v3 && i < t.i3);
    if (b1) { t.v3 = t.v2; t.i3 = t.i2; t.v2 = t.v1; t.i2 = t.i1; t.v1 = v; t.i1 = i; }
    else if (b2) { t.v3 = t.v2; t.i3 = t.i2; t.v2 = v; t.i2 = i; }
    else if (b3) { t.v3 = v; t.i3 = i; }
}
__device__ __forceinline__ void topk_item(const Params& p, int item, int lane) {
    const u16* qkva = (const u16*)(p.ws + WS_QKVA); const float* km = (const float*)(p.ws + WS_KMEAN);
    int* cnt = (int*)(p.ws + WS_CNT); u16* list = (u16*)(p.ws + WS_LIST);
    const int h = item & 7, qc = item >> 3, q0 = qc * 64, own = qc >> 2, r = lane & 15, g = lane >> 4;
    if (own == 0) return;
    Top3 tp[4];
#pragma unroll
    for (int qt = 0; qt < 4; ++qt) { tp[qt].v1 = tp[qt].v2 = tp[qt].v3 = -INFINITY; tp[qt].i1 = 0; tp[qt].i2 = 1; tp[qt].i3 = 2; }
    if (own > 3) {
#pragma unroll
        for (int qt = 0; qt < 4; ++qt) { tp[qt].i1 = 1000; tp[qt].i2 = 1001; tp[qt].i3 = 1002; }
        bf16x8 qfr[4][2];
#pragma unroll
        for (int qt = 0; qt < 4; ++qt) load_qf(qfr[qt], qkva + (size_t)(q0 + 16 * qt + r) * LDA_ + h * 64, lane);
        const int ntile = (own + 15) >> 4;
        for (int nt = 0; nt < ntile; ++nt) {
            const int nrow = 16 * nt + r; const bool nv = nrow < own;
            bf16x8 ahi[2], alo[2];
#pragma unroll
            for (int ks = 0; ks < 2; ++ks) { const float* kp = km + (size_t)(nv ? nrow : 0) * 512 + h * 64 + 32 * ks + 8 * g;
                f32x4 a = *(const f32x4*)kp, b = *(const f32x4*)(kp + 4);
                u32x4 hi; hi[0] = cvt_pk_bf16(a[0], a[1]); hi[1] = cvt_pk_bf16(a[2], a[3]); hi[2] = cvt_pk_bf16(b[0], b[1]); hi[3] = cvt_pk_bf16(b[2], b[3]);
                f32x4 ra = {a[0] - bflo(hi[0]), a[1] - bfhi(hi[0]), a[2] - bflo(hi[1]), a[3] - bfhi(hi[1])}, rb = {b[0] - bflo(hi[2]), b[1] - bfhi(hi[2]), b[2] - bflo(hi[3]), b[3] - bfhi(hi[3])};
                u32x4 lo; lo[0] = cvt_pk_bf16(ra[0], ra[1]); lo[1] = cvt_pk_bf16(ra[2], ra[3]); lo[2] = cvt_pk_bf16(rb[0], rb[1]); lo[3] = cvt_pk_bf16(rb[2], rb[3]);
                ahi[ks] = __builtin_bit_cast(bf16x8, hi); alo[ks] = __builtin_bit_cast(bf16x8, lo); }
#pragma unroll
            for (int qt = 0; qt < 4; ++qt) { f32x4 acc = {0.f, 0.f, 0.f, 0.f};
#pragma unroll
                for (int ks = 0; ks < 2; ++ks) { acc = __builtin_amdgcn_mfma_f32_16x16x32_bf16(ahi[ks], qfr[qt][ks], acc, 0, 0, 0); acc = __builtin_amdgcn_mfma_f32_16x16x32_bf16(alo[ks], qfr[qt][ks], acc, 0, 0, 0); }
#pragma unroll
                for (int j = 0; j < 4; ++j) { const int n = 16 * nt + 4 * g + j; if (n < own) top3_insert(tp[qt], acc[j], n); } }
        }
#pragma unroll
        for (int step = 16; step <= 32; step <<= 1)
#pragma unroll
            for (int qt = 0; qt < 4; ++qt) { const float pv1 = __shfl_xor(tp[qt].v1, step), pv2 = __shfl_xor(tp[qt].v2, step), pv3 = __shfl_xor(tp[qt].v3, step);
                const int pi1 = __shfl_xor(tp[qt].i1, step), pi2 = __shfl_xor(tp[qt].i2, step), pi3 = __shfl_xor(tp[qt].i3, step);
                if (pi1 < 1000) top3_insert(tp[qt], pv1, pi1); if (pi2 < 1000) top3_insert(tp[qt], pv2, pi2); if (pi3 < 1000) top3_insert(tp[qt], pv3, pi3); }
    }
    const int nsel = own < 3 ? own : 3;
    if (g == 0) {
#pragma unroll
        for (int qt = 0; qt < 4; ++qt) { const int q = q0 + 16 * qt + r;
            for (int s2 = 0; s2 < nsel; ++s2) { const int n = s2 == 0 ? tp[qt].i1 : s2 == 1 ? tp[qt].i2 : tp[qt].i3;
                const int pos = atomicAdd(cnt + h * 64 + n, 1);
                list[(size_t)h * LISTH + list_off(n) + pos] = (u16)(q | (s2 << 14)); } }
    }
}

struct CoopKV { u32x4 k, v; };
#define KB_OFF(b) ((b) * 18432)
#define VB_OFF(b) ((b) * 18432 + 9216)
__device__ __forceinline__ void coop_load(CoopKV& c, const u16* kbase, int tid) { const u16* p = kbase + (size_t)(tid >> 3) * LDA_ + 8 * (tid & 7); c.k = *(const u32x4*)p; c.v = *(const u32x4*)(p + 512); }
__device__ __forceinline__ void qk_lds(f32x4 (&acc)[4], LAS const unsigned char* kb, const bf16x8 (&qf)[2], int lane) {
    const int r = lane & 15, g = lane >> 4;
#pragma unroll
    for (int kt = 0; kt < 4; ++kt) { LAS const unsigned char* kp = kb + (16 * kt + r) * 144 + 16 * g;
        bf16x8 k0 = *(LAS const bf16x8*)kp, k1 = *(LAS const bf16x8*)(kp + 64);
        f32x4 z = {0.f, 0.f, 0.f, 0.f};
        z = __builtin_amdgcn_mfma_f32_16x16x32_bf16(k0, qf[0], z, 0, 0, 0);
        acc[kt] = __builtin_amdgcn_mfma_f32_16x16x32_bf16(k1, qf[1], z, 0, 0, 0); }
}
template <bool CAUSAL>
__device__ __forceinline__ void sm_tile_l(LAS const unsigned char* kb, LAS const unsigned char* vb, int key0, int t, const bf16x8 (&qf)[2], float& m, float& l, f32x4 (&o)[4], int lane) {
    const int g = lane >> 4;
    f32x4 acc[4]; qk_lds(acc, kb, qf, lane);
    float s[4][4]; float lm = -INFINITY;
#pragma unroll
    for (int kt = 0; kt < 4; ++kt)
#pragma unroll
        for (int j = 0; j < 4; ++j) { float v = acc[kt][j]; if (CAUSAL && (key0 + 16 * kt + 4 * g + j) > t) v = -INFINITY; s[kt][j] = v; lm = fmaxf(lm, v); }
    lm = fmaxf(lm, __shfl_xor(lm, 16)); lm = fmaxf(lm, __shfl_xor(lm, 32));
    const float mn = fmaxf(m, lm), al = fexp2(m - mn);
    float sum = 0.f;
#pragma unroll
    for (int kt = 0; kt < 4; ++kt)
#pragma unroll
        for (int j = 0; j < 4; ++j) { s[kt][j] = fexp2(s[kt][j] - mn); sum += s[kt][j]; }
    l = l * al + sum; m = mn;
#pragma unroll
    for (int dt = 0; dt < 4; ++dt) o[dt] *= al;
    bf16x8 pf[2]; pack_p(pf, s);
    pv_tile(o, vb, pf, lane);
}

__device__ __forceinline__ void sel_block_stream(const Params& p, LAS unsigned char* lds, LAS const int* sched, int total, int tid, int wid, int lane) {
    const u16* qkva = (const u16*)(p.ws + WS_QKVA); const u16* list = (const u16*)(p.ws + WS_LIST);
    u16* po = (u16*)(p.ws + WS_PO); float* pml = (float*)(p.ws + WS_PML);
    const int r = lane & 15, g = lane >> 4, G = gridDim.x;
    int i = (G & 7) == 0 ? (int)(blockIdx.x & 7) * (G >> 3) + (int)(blockIdx.x >> 3) : (int)blockIdx.x; if (i >= total) return;
#define SELB_DECODE(kk_, H, N, E, OK, ACT) do { const int hn_ = __builtin_amdgcn_readfirstlane(sched[(kk_) * 4]), grp_ = __builtin_amdgcn_readfirstlane(sched[(kk_) * 4 + 1]), c_ = __builtin_amdgcn_readfirstlane(sched[(kk_) * 4 + 2]); \
        H = hn_ >> 6; N = hn_ & 63; const int e0_ = grp_ * 128 + wid * 16; ACT = e0_ < c_; int ei_ = e0_ + r; OK = ei_ < c_; if (!OK) ei_ = ACT ? e0_ : 0; \
        E = list[(size_t)H * LISTH + list_off(N) + ei_]; } while (0)
    int kq = 0; int h, n; unsigned e; bool ok, act; SELB_DECODE(kq, h, n, e, ok, act);
    bf16x8 qf[2]; load_qf(qf, qkva + (size_t)(e & 0x3FFF) * LDA_ + h * 64, lane);
#define KBIG(b_) ((b_) * 73728)
#define VBIG(b_) ((b_) * 73728 + 36864)
    CoopKV cN[4];
    { const u16* kb0 = qkva + (size_t)(n * 256) * LDA_ + 512 + h * 64;
#pragma unroll
      for (int t4 = 0; t4 < 4; ++t4) coop_load(cN[t4], kb0 + (size_t)t4 * 64 * LDA_, tid);
      const int o_ = (tid >> 3) * 144 + (tid & 7) * 16;
#pragma unroll
      for (int t4 = 0; t4 < 4; ++t4) { *(LAS u32x4*)(lds + KBIG(0) + t4 * 9216 + o_) = cN[t4].k; *(LAS u32x4*)(lds + VBIG(0) + t4 * 9216 + o_) = cN[t4].v; } }
    __syncthreads();
    int buf = 0;
    for (;;) {
        const int i2 = i + G; const bool has_next = i2 < total;
        int h2 = 0, n2 = 0; unsigned e2 = 0; bool ok2 = false, act2 = false;
        if (has_next) { SELB_DECODE(kq + 1, h2, n2, e2, ok2, act2);
            const u16* kb2 = qkva + (size_t)(n2 * 256) * LDA_ + 512 + h2 * 64;
#pragma unroll
            for (int t4 = 0; t4 < 4; ++t4) coop_load(cN[t4], kb2 + (size_t)t4 * 64 * LDA_, tid); }
        f32x4 o[4];
#pragma unroll
        for (int q_ = 0; q_ < 4; ++q_) o[q_] = (f32x4){0.f, 0.f, 0.f, 0.f};
        float m = -INFINITY, l = 0.f; bf16x8 qn[2] = {qf[0], qf[1]};
        if (has_next) load_qf(qn, qkva + (size_t)(e2 & 0x3FFF) * LDA_ + h2 * 64, lane);
        if (act) {
#pragma unroll 1
            for (int tile = 0; tile < 4; ++tile) sm_tile_l<false>(lds + KBIG(buf) + tile * 9216, lds + VBIG(buf) + tile * 9216, 0, 0, qf, m, l, o, lane);
            l += __shfl_xor(l, 16); l += __shfl_xor(l, 32);
            const float inv = frcp(l);
            if (ok) { const size_t sidx = ((size_t)(e & 0x3FFF) * NH + h) * 3 + (e >> 14);
#pragma unroll
                for (int dt = 0; dt < 4; ++dt) { u32x2 b; b[0] = cvt_pk_bf16(o[dt][0] * inv, o[dt][1] * inv); b[1] = cvt_pk_bf16(o[dt][2] * inv, o[dt][3] * inv);
                    *(u32x2*)(po + sidx * 64 + 16 * dt + 4 * g) = b; }
                if (g == 0) { pml[sidx * 2] = m; pml[sidx * 2 + 1] = l; } } }
        if (!has_next) break;
        { const int o_ = (tid >> 3) * 144 + (tid & 7) * 16;
#pragma unroll
          for (int t4 = 0; t4 < 4; ++t4) { *(LAS u32x4*)(lds + KBIG(buf ^ 1) + t4 * 9216 + o_) = cN[t4].k; *(LAS u32x4*)(lds + VBIG(buf ^ 1) + t4 * 9216 + o_) = cN[t4].v; } }
        __syncthreads(); buf ^= 1;
        i = i2; ++kq; h = h2; n = n2; e = e2; ok = ok2; act = act2; qf[0] = qn[0]; qf[1] = qn[1];
    }
#undef KBIG
#undef VBIG
#undef SELB_DECODE
}

__device__ __forceinline__ void own_block_stream(const Params& p, LAS unsigned char* lds, int tid, int wid, int lane) {
    const u16* qkva = (const u16*)(p.ws + WS_QKVA); const u16* po = (const u16*)(p.ws + WS_PO); const float* pml = (const float*)(p.ws + WS_PML);
    u16* ya = (u16*)(p.ws + WS_AB);
    const int r = lane & 15, g = lane >> 4, G = gridDim.x, total = (T_ / 128) * NH;
    int i = (G & 7) == 0 ? (int)(blockIdx.x & 7) * (G >> 3) + (int)(blockIdx.x >> 3) : (int)blockIdx.x, kk = 0; if (i >= total) return;
#define OWN_DEC(ii, k_, C, H) do { C = ((ii) >> 3) ^ ((k_) & 1); H = (ii) & 7; } while (0)
    int cch, h; OWN_DEC(i, kk, cch, h);
    bf16x8 qf[2]; load_qf(qf, qkva + (size_t)(cch * 128 + wid * 16 + r) * LDA_ + h * 64, lane);
#define KBIG(b_) ((b_) * 73728)
#define VBIG(b_) ((b_) * 73728 + 36864)
    CoopKV cN[4]; const int o_ = (tid >> 3) * 144 + (tid & 7) * 16;
    { const u16* kb0 = qkva + (size_t)((cch >> 1) * 256) * LDA_ + 512 + h * 64; const int nt0 = (cch & 1) ? 4 : 2;
#pragma unroll
      for (int t4 = 0; t4 < 4; ++t4) if (t4 < nt0) coop_load(cN[t4], kb0 + (size_t)t4 * 64 * LDA_, tid);
#pragma unroll
      for (int t4 = 0; t4 < 4; ++t4) if (t4 < nt0) { *(LAS u32x4*)(lds + KBIG(0) + t4 * 9216 + o_) = cN[t4].k; *(LAS u32x4*)(lds + VBIG(0) + t4 * 9216 + o_) = cN[t4].v; } }
    __syncthreads();
    int buf = 0;
    for (;;) {
        const int i2 = i + G; const bool has_next = i2 < total; int c2 = 0, h2 = 0; OWN_DEC(i2, kk + 1, c2, h2);
        const int own = cch >> 1, q0 = cch * 128 + wid * 16, t = q0 + r, wmax = ((cch & 1) * 128 + wid * 16 + 15) >> 6;
        const int nt2 = (c2 & 1) ? 4 : 2;
        f32x4 o[4];
#pragma unroll
        for (int q_ = 0; q_ < 4; ++q_) o[q_] = (f32x4){0.f, 0.f, 0.f, 0.f};
        float m = -INFINITY, l = 0.f; bf16x8 qn[2] = {qf[0], qf[1]};
        if (has_next) { const u16* kb2 = qkva + (size_t)((c2 >> 1) * 256) * LDA_ + 512 + h2 * 64;
#pragma unroll
            for (int t4 = 0; t4 < 4; ++t4) if (t4 < nt2) coop_load(cN[t4], kb2 + (size_t)t4 * 64 * LDA_, tid);
            load_qf(qn, qkva + (size_t)(c2 * 128 + wid * 16 + r) * LDA_ + h2 * 64, lane); }
        const int nsel = own < 3 ? own : 3;
        const size_t sidx = ((size_t)t * NH + h) * 3;
        float ms[3], lsv[3]; u32x2 pw[3][4];
#pragma unroll
        for (int s2 = 0; s2 < 3; ++s2) { ms[s2] = -INFINITY; lsv[s2] = 0.f;
#pragma unroll
            for (int dt = 0; dt < 4; ++dt) pw[s2][dt] = (u32x2){0u, 0u};
            if (s2 < nsel) { ms[s2] = pml[(sidx + s2) * 2]; lsv[s2] = pml[(sidx + s2) * 2 + 1];
#pragma unroll
                for (int dt = 0; dt < 4; ++dt) pw[s2][dt] = *(const u32x2*)(po + (sidx + s2) * 64 + 16 * dt + 4 * g); } }
#pragma unroll 1
        for (int tile = 0; tile <= wmax; ++tile) sm_tile_l<true>(lds + KBIG(buf) + tile * 9216, lds + VBIG(buf) + tile * 9216, own * 256 + tile * 64, t, qf, m, l, o, lane);
        l += __shfl_xor(l, 16); l += __shfl_xor(l, 32);
        float M = m;
#pragma unroll
        for (int s2 = 0; s2 < 3; ++s2) M = fmaxf(M, ms[s2]);
        const float a0 = fexp2(m - M); float den = l * a0;
#pragma unroll
        for (int dt = 0; dt < 4; ++dt) o[dt] *= a0;
#pragma unroll
        for (int s2 = 0; s2 < 3; ++s2) { const float a = lsv[s2] * fexp2(ms[s2] - M); den += a;
#pragma unroll
            for (int dt = 0; dt < 4; ++dt) { const u32x2 w = pw[s2][dt];
                o[dt][0] += a * bflo(w[0]); o[dt][1] += a * bfhi(w[0]); o[dt][2] += a * bflo(w[1]); o[dt][3] += a * bfhi(w[1]); } }
        const float inv = frcp(den);
#pragma unroll
        for (int dt = 0; dt < 4; ++dt) { u32x2 b; b[0] = cvt_pk_bf16(o[dt][0] * inv, o[dt][1] * inv); b[1] = cvt_pk_bf16(o[dt][2] * inv, o[dt][3] * inv);
            *(u32x2*)(ya + (size_t)t * 512 + h * 64 + 16 * dt + 4 * g) = b; }
        if (!has_next) break;
#pragma unroll
        for (int t4 = 0; t4 < 4; ++t4) if (t4 < nt2) { *(LAS u32x4*)(lds + KBIG(buf ^ 1) + t4 * 9216 + o_) = cN[t4].k; *(LAS u32x4*)(lds + VBIG(buf ^ 1) + t4 * 9216 + o_) = cN[t4].v; }
        __syncthreads(); buf ^= 1;
        i = i2; ++kk; cch = c2; h = h2; qf[0] = qn[0]; qf[1] = qn[1];
    }
#undef KBIG
#undef VBIG
#undef OWN_DEC
}

__device__ __forceinline__ void sb_tile_l(LAS const unsigned char* kb, LAS const unsigned char* vb, int key0, int t, const bf16x8 (&qf)[2], float& R, f32x4 (&o)[4], int lane) {
    const int g = lane >> 4;
    f32x4 acc[4]; qk_lds(acc, kb, qf, lane);
    float lf[4][4], Tk[4], ex[4];
#pragma unroll
    for (int kt = 0; kt < 4; ++kt) { float c = 0.f;
#pragma unroll
        for (int j = 0; j < 4; ++j) { const bool valid = (key0 + 16 * kt + 4 * g + j) < t; const float z = acc[kt][j];
            const float sp = fmaxf(z, 0.f) + __logf(1.0f + __expf(-fabsf(z)));
            acc[kt][j] = z; lf[kt][j] = valid ? -sp : 0.f; c += lf[kt][j]; }
        const float b = __shfl_xor(c, 16), s2 = c + b, d = __shfl_xor(s2, 32);
        Tk[kt] = s2 + d; ex[kt] = ((g & 1) ? 0.f : b) + ((g & 2) ? 0.f : d); }
    float w[4][4]; float run = R;
#pragma unroll
    for (int kt = 3; kt >= 0; --kt) { const float E = run + ex[kt]; float suf = 0.f;
#pragma unroll
        for (int j = 3; j >= 0; --j) { const bool valid = (key0 + 16 * kt + 4 * g + j) < t; w[kt][j] = valid ? __expf(acc[kt][j] + lf[kt][j] + E + suf) : 0.f; suf += lf[kt][j]; }
        run += Tk[kt]; }
    R = run;
    bf16x8 pf[2]; pack_p(pf, w);
    pv_tile(o, vb, pf, lane);
}

__device__ __forceinline__ void sb_block_stream(const Params& p, LAS unsigned char* lds, int tid, int wid, int lane) {
    const u16* qkvb = (const u16*)(p.ws + WS_QKVB); u16* yb = (u16*)(p.ws + WS_AB) + (size_t)T_ * 512;
    const int r = lane & 15, g = lane >> 4, G = gridDim.x, total = (T_ / 128) * NH;
    int i = (G & 7) == 0 ? (int)(blockIdx.x & 7) * (G >> 3) + (int)(blockIdx.x >> 3) : (int)blockIdx.x; if (i >= total) return;
    int cch = i >> 3, h = i & 7;
    bf16x8 qf[2]; load_qf(qf, qkvb + (size_t)(cch * 128 + wid * 16 + r) * LDA_ + h * 64, lane);
#define KBIG(b_) ((b_) * 73728)
#define VBIG(b_) ((b_) * 73728 + 36864)
    CoopKV cN[3]; const int o_ = (tid >> 3) * 144 + (tid & 7) * 16;
    { const int ns0 = cch == 0 ? 2 : 3;
#pragma unroll
      for (int s4 = 0; s4 < 3; ++s4) if (s4 < ns0) coop_load(cN[s4], qkvb + (size_t)((2 * cch + 1 - s4) * 64) * LDA_ + 512 + h * 64, tid);
#pragma unroll
      for (int s4 = 0; s4 < 3; ++s4) if (s4 < ns0) { *(LAS u32x4*)(lds + KBIG(0) + s4 * 9216 + o_) = cN[s4].k; *(LAS u32x4*)(lds + VBIG(0) + s4 * 9216 + o_) = cN[s4].v; } }
    __syncthreads();
    int buf = 0;
    for (;;) {
        const int i2 = i + G; const bool has_next = i2 < total; const int c2 = i2 >> 3, h2 = i2 & 7;
        const int q0 = cch * 128 + wid * 16, t = q0 + r, dw = 2 * cch + (wid >> 2);
        const int nstep = cch == 0 ? 2 : 3, ns2 = c2 == 0 ? 2 : 3;
        const u16* kb = qkvb + 512 + h * 64;
        f32x4 o[4];
#pragma unroll
        for (int q_ = 0; q_ < 4; ++q_) o[q_] = (f32x4){0.f, 0.f, 0.f, 0.f};
        float R = 0.f; bool done = false; bf16x8 qn[2] = {qf[0], qf[1]};
        if (has_next) {
#pragma unroll
            for (int s4 = 0; s4 < 3; ++s4) if (s4 < ns2) coop_load(cN[s4], qkvb + (size_t)((2 * c2 + 1 - s4) * 64) * LDA_ + 512 + h2 * 64, tid);
            load_qf(qn, qkvb + (size_t)(c2 * 128 + wid * 16 + r) * LDA_ + h2 * 64, lane); }
        int tile = 2 * cch + 1;
#pragma unroll 1
        for (int s4 = 0; s4 < nstep; ++s4, --tile)
            if (tile <= dw && !done) { sb_tile_l(lds + KBIG(buf) + s4 * 9216, lds + VBIG(buf) + s4 * 9216, tile * 64, t, qf, R, o, lane);
                done = (tile == 0) || (__builtin_amdgcn_ballot_w64(R > -40.f) == 0ull); }
        if (has_next) {
#pragma unroll
            for (int s4 = 0; s4 < 3; ++s4) if (s4 < ns2) { *(LAS u32x4*)(lds + KBIG(buf ^ 1) + s4 * 9216 + o_) = cN[s4].k; *(LAS u32x4*)(lds + VBIG(buf ^ 1) + s4 * 9216 + o_) = cN[s4].v; } }
        int any = __syncthreads_or(done ? 0 : 1);
        while (any && tile >= 0) {
            CoopKV c3; coop_load(c3, kb + (size_t)(tile * 64) * LDA_, tid);
            *(LAS u32x4*)(lds + KBIG(buf) + o_) = c3.k; *(LAS u32x4*)(lds + VBIG(buf) + o_) = c3.v; __syncthreads();
            if (!done) { sb_tile_l(lds + KBIG(buf), lds + VBIG(buf), tile * 64, t, qf, R, o, lane);
                done = (tile == 0) || (__builtin_amdgcn_ballot_w64(R > -40.f) == 0ull); }
            any = __syncthreads_or(done ? 0 : 1); --tile;
        }
#pragma unroll
        for (int dt = 0; dt < 4; ++dt) { u32x2 b; b[0] = cvt_pk_bf16(o[dt][0], o[dt][1]); b[1] = cvt_pk_bf16(o[dt][2], o[dt][3]);
            *(u32x2*)(yb + (size_t)t * 512 + h * 64 + 16 * dt + 4 * g) = b; }
        if (!has_next) break;
        buf ^= 1;
        i = i2; cch = c2; h = h2; qf[0] = qn[0]; qf[1] = qn[1];
    }
#undef KBIG
#undef VBIG
}

#define XB_TMO      128
#define XB_XCNT(j)  (256  + 64 * (j))
#define XB_XSUB(j)  (1280 + 64 * (j))
#define XB_XGEN(j)  (2304 + 64 * (j))
#define XB_TOP      3328
#define XB_TOPGEN   3392
#define XCD_BAR_WORDS 3456
#define XB_SPIN_CAP (1u << 22)
__device__ __forceinline__ unsigned xb_ld(unsigned* p)              { return __hip_atomic_load(p, __ATOMIC_RELAXED, __HIP_MEMORY_SCOPE_AGENT); }
__device__ __forceinline__ unsigned xb_add(unsigned* p, unsigned v) { return __hip_atomic_fetch_add(p, v, __ATOMIC_RELAXED, __HIP_MEMORY_SCOPE_AGENT); }
__device__ __forceinline__ unsigned xb_xcc_id() { return (unsigned)__builtin_amdgcn_s_getreg((3 << 11) | 20) & 0xFu; }
#define XB_SPIN(cond, bar) do { unsigned _sp = 0; while (cond) { __builtin_amdgcn_s_sleep(1); \
    if ((++_sp & 255u) == 0u) { if (xb_ld(&(bar)[XB_TMO])) break; if (_sp > XB_SPIN_CAP) { atomicAdd(&(bar)[XB_TMO], 1u); break; } } } } while (0)
struct XcdBarrier { unsigned* bar; unsigned x; volatile LAS unsigned* st; };
__device__ __forceinline__ XcdBarrier xcd_barrier_post(unsigned* bar, volatile LAS unsigned* st) {
    XcdBarrier b; b.bar = bar; b.x = xb_xcc_id(); b.st = st;
    if (threadIdx.x == 0) (void)xb_add(&bar[XB_XCNT(b.x)], 1u);
    return b;
}
__device__ __forceinline__ void xcd_barrier_complete(unsigned* bar, unsigned x, unsigned& nloc, unsigned& nx) {
    const unsigned G = gridDim.x * gridDim.y * gridDim.z;
    unsigned sum, cnt, mine, sp = 0u;
    for (;;) {
        sum = 0u; cnt = 0u; mine = 0u;
#pragma unroll
        for (unsigned j = 0; j < 16; ++j) { const unsigned c = xb_ld(&bar[XB_XCNT(j)]); sum += c; cnt += (c > 0u) ? 1u : 0u; mine = (j == x) ? c : mine; }
        if (sum == G) break;
        __builtin_amdgcn_s_sleep(1);
        if ((++sp & 255u) == 0u) { if (xb_ld(&bar[XB_TMO])) break; if (sp > XB_SPIN_CAP) { atomicAdd(&bar[XB_TMO], 1u); break; } }
    }
    nloc = mine > 0u ? mine : 1u; nx = cnt > 0u ? cnt : 1u;
}
__device__ __forceinline__ void xcd_barrier_arrive(const XcdBarrier& b) {
    asm volatile("s_waitcnt vmcnt(0)" ::: "memory");
    __syncthreads();
    if (threadIdx.x == 0) {
        unsigned* bar = b.bar;
        __builtin_amdgcn_s_waitcnt(0);
        unsigned nloc = b.st[0], nx = b.st[1];
        if (nloc == 0u) { xcd_barrier_complete(bar, b.x, nloc, nx); b.st[0] = nloc; b.st[1] = nx; }
        const unsigned old = xb_add(&bar[XB_XSUB(b.x)], 1u);
        const unsigned gen = old / nloc;
        if (old + 1u == (gen + 1u) * nloc) {
            __builtin_amdgcn_fence(__ATOMIC_RELEASE, "agent");
            asm volatile("s_waitcnt vmcnt(0)" ::: "memory");
            const unsigned og = xb_add(&bar[XB_TOP], 1u);
            const unsigned tg = og / nx;
            if (og + 1u == (tg + 1u) * nx) xb_add(&bar[XB_TOPGEN], 1u);
        }
    }
}
__device__ __forceinline__ void xcd_barrier_wait(const XcdBarrier& b) {
    if (threadIdx.x == 0) {
        unsigned* bar = b.bar;
        const unsigned tgen = b.st[2]; b.st[2] = tgen + 1u;
        XB_SPIN(xb_ld(&bar[XB_TOPGEN]) <= tgen, bar);
        __builtin_amdgcn_fence(__ATOMIC_ACQUIRE, "agent");
        asm volatile("s_waitcnt vmcnt(0)" ::: "memory");
    }
    __syncthreads();
}
__device__ __forceinline__ void xcd_barrier(const XcdBarrier& b) { xcd_barrier_arrive(b); xcd_barrier_wait(b); }

#define PH_PROLOG int tid_ = threadIdx.x; asm volatile("" : "+v"(tid_)); const int tid = tid_, lane = tid & 63, wid = __builtin_amdgcn_readfirstlane(tid >> 6); \
    const int G = gridDim.x, W = blockIdx.x * 8 + wid, NW = G * 8; LAS unsigned char* vs = lds + wid * 9216; (void)vs; (void)W; (void)NW; (void)lane; (void)G;
#ifndef REP_MASK
#define REP_MASK 0
#endif
#ifndef REPN
#define REPN 2
#endif
#ifndef EXTRA_SYNCS
#define EXTRA_SYNCS 0
#endif
#define PHASE(N, ...) if constexpr ((PH_MASK >> N) & 1) { if (p.ph_lo <= N && N < p.ph_hi) { \
    for (int rep_ = 0; rep_ < (((REP_MASK >> N) & 1) ? REPN : 1); ++rep_) { if (rep_) xcd_barrier(xb); { PH_PROLOG __VA_ARGS__ } } } } if (p.ph_lo <= N && N + 1 < p.ph_hi) xcd_barrier(xb);
#define PHASE_S(N, SLOT, ...) if constexpr ((PH_MASK >> N) & 1) { if (p.ph_lo <= N && N < p.ph_hi) { { PH_PROLOG __VA_ARGS__ } } } \
    if (p.ph_lo <= N && N + 1 < p.ph_hi) { xcd_barrier_arrive(xb); \
        { constexpr int lo_ = 2 * 16 * 44 + 44 * 16 + 16 * 80 + 2 * 8 * 16 + 16 * 16 + (SLOT) * 512, end_ = 2 * 16 * 44 + 44 * 16 + 16 * 80 + 2 * 8 * 16 + 16 * 16 + 2 * 16 * 44 + 44 * 16; \
          if ((int)gridDim.x == 256) deferred_weights(p, lds, (int)blockIdx.x, 256, lo_, (lo_ + 512 < end_ ? lo_ + 512 : end_)); } \
        xcd_barrier_wait(xb); }

__global__ void __launch_bounds__(512) fwd_megakernel(Params p) {
    extern __shared__ __attribute__((aligned(16))) unsigned char shm_raw[];
    LAS unsigned char* lds = (LAS unsigned char*)shm_raw;
    cg::grid_group grid = cg::this_grid();
    unsigned char* ws = p.ws;
    volatile LAS unsigned* xst = (volatile LAS unsigned*)(lds + XST_OFF);
    if (threadIdx.x == 0) { xst[0] = 0u; xst[1] = 0u; xst[2] = 0u; }
    __syncthreads();
    XcdBarrier xb = xcd_barrier_post(g_sync, xst);
    if (p.use_cg) grid.sync();

    for (int es_ = 0; es_ < EXTRA_SYNCS; ++es_) xcd_barrier(xb);
    PHASE(0, prep_phase(p, lds);)
    PHASE(1, pg8::StaticOrder S; S.init(T_, 2 * DFF, G, blockIdx.x); pg8::Gemm g{(const u16*)(ws + WS_AB), (const u16*)(ws + WS_GU1), T_, 2 * DFF, D_};
             build_rtab(lds, S, (const float*)(ws + WS_P0)); EpiSwiglu E{(u16*)(ws + WS_ACT), lds}; pg8::gemm_phase(lds, g, S, E);
             { const int nfull = (T_ / 256) * (2 * DFF / 256) - 5 * G;
               constexpr int lo_ = 2 * 16 * 44, hi_ = lo_ + 44 * 16 + 16 * 80 + 2 * 8 * 16 + 16 * 16;
               if (nfull >= 0 && nfull < G) { if ((int)blockIdx.x >= nfull) deferred_weights(p, lds, (int)blockIdx.x - nfull, G - nfull, lo_, hi_); }
               else deferred_weights(p, lds, (int)blockIdx.x, G, lo_, hi_); })
    PHASE_S(2, 0, pg8::StaticOrder S; S.init(T_, D_, G, blockIdx.x); pg8::Gemm g{(const u16*)(ws + WS_ACT), (const u16*)(ws + WS_DN1), T_, D_, DFF};
             EpiResid<false> E{(const u16*)(ws + WS_AB), nullptr, (u16*)p.out, (float*)(ws + WS_P1), 0.5f}; pg8::gemm_phase(lds, g, S, E);)
    PHASE_S(3, 1, pg8::StaticOrder S; S.init(T_, DIN, G, blockIdx.x); pg8::Gemm g{(const u16*)p.out, (const u16*)(ws + WS_IN), T_, DIN, D_};
             build_rtab(lds, S, (const float*)(ws + WS_P1)); EpiWin E{(u16*)(ws + WS_QKVA), (u16*)(ws + WS_QKVB), (u16*)(ws + WS_GATES), lds, (const float*)(ws + WS_CS), p.bg, (float*)(ws + WS_KMEAN)}; pg8::gemm_phase(lds, g, S, E);)
    PHASE_S(4, 2, for (int i = W; i < (T_ / 64) * NH; i += NW) topk_item(p, i, lane);
             __syncthreads(); sb_block_stream(p, lds, tid, wid, lane); __syncthreads();)
    PHASE_S(6, 3, LAS int* pref = (LAS int*)(lds + 96 * 1024); const int* cnt = (const int*)(ws + WS_CNT);
             __syncthreads();
             pref[tid] = (cnt[tid] + 127) >> 7; __syncthreads();
             for (int o = 1; o < 512; o <<= 1) { const int v = tid >= o ? pref[tid - o] : 0; __syncthreads(); pref[tid] += v; __syncthreads(); }
             const int total = pref[511];
             LAS int* sched = (LAS int*)(lds + 148 * 1024);
             { const int slot0 = (G & 7) == 0 ? (int)(blockIdx.x & 7) * (G >> 3) + (int)(blockIdx.x >> 3) : (int)blockIdx.x; const int ii = slot0 + tid * G;
               if (tid < 64 && ii < total) { int lo = 0; int hi = 511; while (lo < hi) { const int mid = (lo + hi) >> 1; if (pref[mid] > ii) hi = mid; else lo = mid + 1; }
                   sched[tid * 4] = lo; sched[tid * 4 + 1] = ii - (lo ? pref[lo - 1] : 0); sched[tid * 4 + 2] = cnt[lo]; } }
             __syncthreads();
             sel_block_stream(p, lds, sched, total, tid, wid, lane);
             __syncthreads();)
    PHASE_S(7, 4, __syncthreads(); own_block_stream(p, lds, tid, wid, lane); __syncthreads();)
    PHASE(8, { pg8::StaticOrder S; S.init(T_, D_, G, blockIdx.x); pg8::Gemm g{(const u16*)(ws + WS_AB), (const u16*)(ws + WS_BA), T_, D_, 512};
               EpiBranch<true> E{(const u16*)(ws + WS_GATES), (u16*)(ws + WS_TMP), (u16*)(ws + WS_MERGED)}; pg8::gemm_phase(lds, g, S, E); }
             { pg8::StaticOrder S; S.init(T_, D_, G, blockIdx.x); pg8::Gemm g{(const u16*)(ws + WS_AB) + (size_t)T_ * 512, (const u16*)(ws + WS_BB), T_, D_, 512};
               EpiBranch<false> E{(const u16*)(ws + WS_GATES), (u16*)(ws + WS_TMP), (u16*)(ws + WS_MERGED)}; pg8::gemm_phase(lds, g, S, E); })
    PHASE(9, pg8::StaticOrder S; S.init(T_, D_, G, blockIdx.x); pg8::Gemm g{(const u16*)(ws + WS_MERGED), (const u16*)(ws + WS_WO), T_, D_, D_};
             EpiResid<false> E{(const u16*)p.out, nullptr, (u16*)(ws + WS_AB), (float*)(ws + WS_P2), 1.0f}; pg8::gemm_phase(lds, g, S, E);)
    PHASE(10, pg8::StaticOrder S; S.init(T_, 2 * DFF, G, blockIdx.x); pg8::Gemm g{(const u16*)(ws + WS_AB), (const u16*)(ws + WS_GU2), T_, 2 * DFF, D_};
              build_rtab(lds, S, (const float*)(ws + WS_P2)); EpiSwiglu E{(u16*)(ws + WS_ACT), lds}; pg8::gemm_phase(lds, g, S, E);)
    PHASE(11, pg8::StaticOrder S; S.init(T_, D_, G, blockIdx.x); pg8::Gemm g{(const u16*)(ws + WS_ACT), (const u16*)(ws + WS_DN2), T_, D_, DFF};
              EpiFinal E{(const u16*)(ws + WS_AB), p.out, (float*)(ws + WS_P3), g_sync + 4096, p.nf, 0.5f}; pg8::gemm_phase(lds, g, S, E);)
    asm volatile("s_waitcnt vmcnt(0)" ::: "memory");
    __syncthreads();
    if (threadIdx.x == 0) xst[3] = (__hip_atomic_fetch_add(&g_sync[8192], 1u, __ATOMIC_RELAXED, __HIP_MEMORY_SCOPE_AGENT) == gridDim.x - 1u) ? 1u : 0u;
    __syncthreads();
    if (xst[3]) { for (int i2 = threadIdx.x; i2 < 8192; i2 += 512) g_sync[i2] = 0u; if (threadIdx.x == 0) g_sync[8192] = 0u; }
}

extern "C" void kernel_launch(void* const* d_in, const int* in_sizes, int n_in, void* d_out, int out_size, void* d_ws, size_t ws_size, hipStream_t stream) {
    constexpr int LDS_BYTES = 152 * 1024 + 64 + 7 * 1024;
    static int grid = 0;
    if (grid == 0) {
        int dev = 0, cus = 0, per_cu = 0;
        hipGetDevice(&dev); hipDeviceGetAttribute(&cus, hipDeviceAttributeMultiprocessorCount, dev);
        hipFuncSetAttribute((const void*)fwd_megakernel, hipFuncAttributeMaxDynamicSharedMemorySize, LDS_BYTES);
        hipOccupancyMaxActiveBlocksPerMultiprocessor(&per_cu, (const void*)fwd_megakernel, 512, LDS_BYTES);
        if (per_cu < 1) { fprintf(stderr, "occupancy query says %d blocks/CU\n", per_cu); per_cu = 1; }
        (void)hipGetLastError();
        grid = cus;
        if (ws_size < WS_END) { fprintf(stderr, "workspace too small: %zu < %zu\n", ws_size, (size_t)WS_END); grid = -1; }
    }
    if (grid < 0) return;
    Params p{};
    p.x = (const float*)d_in[0]; p.pos = (const int*)d_in[1];
    p.n1 = (const float*)d_in[2]; p.g1 = (const float*)d_in[3]; p.u1 = (const float*)d_in[4]; p.d1 = (const float*)d_in[5];
    p.nm = (const float*)d_in[6]; p.win = (const float*)d_in[7]; p.bg = (const float*)d_in[8]; p.wba = (const float*)d_in[9]; p.wbb = (const float*)d_in[10]; p.wo = (const float*)d_in[11];
    p.n2 = (const float*)d_in[12]; p.g2 = (const float*)d_in[13]; p.u2 = (const float*)d_in[14]; p.d2 = (const float*)d_in[15]; p.nf = (const float*)d_in[16];
    p.out = (float*)d_out; p.ws = (unsigned char*)d_ws;
#ifndef ONE_LAUNCH
#define ONE_LAUNCH 1
#endif
#if ONE_LAUNCH
    p.ph_lo = 0; p.ph_hi = N_PHASES;
    void* args[] = {&p};
    hipError_t e = hipLaunchCooperativeKernel((const void*)fwd_megakernel, dim3(grid), dim3(512), args, LDS_BYTES, stream);
    if (e != hipSuccess) fprintf(stderr, "cooperative launch failed: %s (grid %d)\n", hipGetErrorString(e), grid);
#else
#ifndef DBG_MASK
#define DBG_MASK 0x1fff
#endif
#ifndef DBG_FPART
#define DBG_FPART 0
#endif
    p.fpart = DBG_FPART;
    for (int ph = 0; ph < N_PHASES; ++ph) { if (!((DBG_MASK >> ph) & 1)) continue; p.ph_lo = ph; p.ph_hi = ph + 1; hipLaunchKernelGGL(fwd_megakernel, dim3(grid), dim3(512), LDS_BYTES, stream, p); }
#endif
}
```

```cpp
#include <hip/hip_runtime.h>
#include <hip/hip_cooperative_groups.h>
#include <cstdio>
namespace cg = cooperative_groups;

#define LAS __attribute__((address_space(3)))
typedef unsigned short u16;
typedef short bf16x8 __attribute__((ext_vector_type(8)));
typedef short s16x4 __attribute__((ext_vector_type(4)));
typedef float f32x4 __attribute__((ext_vector_type(4)));
typedef unsigned u32x4 __attribute__((ext_vector_type(4)));
typedef unsigned u32x2 __attribute__((ext_vector_type(2)));

constexpr int T_ = 16384, D_ = 1024, DFF = 2816, DIN = 5120, NH = 8, HD = 64;
constexpr int LDA_ = 1536;
constexpr float EPS = 1e-6f;
constexpr int LISTH = 256 * 2016;
constexpr int N_PHASES = 12;
#ifndef PH_MASK
#define PH_MASK 0x1fff
#endif

constexpr size_t SZ_GU = (size_t)2 * DFF * D_ * 2, SZ_DN = (size_t)D_ * DFF * 2, SZ_IN = (size_t)DIN * D_ * 2, SZ_BR = (size_t)D_ * 512 * 2, SZ_WO = (size_t)D_ * D_ * 2;
constexpr size_t WS_GU1 = 0, WS_DN1 = WS_GU1 + SZ_GU, WS_IN = WS_DN1 + SZ_DN, WS_BA = WS_IN + SZ_IN, WS_BB = WS_BA + SZ_BR, WS_WO = WS_BB + SZ_BR,
                 WS_GU2 = WS_WO + SZ_WO, WS_DN2 = WS_GU2 + SZ_GU, WS_CS = WS_DN2 + SZ_DN;
constexpr size_t SZ_PART = (size_t)T_ * 16 * 4;
constexpr size_t WS_P0 = WS_CS + (size_t)T_ * 16 * 4, WS_P1 = WS_P0 + SZ_PART, WS_P2 = WS_P1 + SZ_PART, WS_P3 = WS_P2 + SZ_PART;
constexpr size_t WS_KMEAN = WS_P3 + SZ_PART, WS_CNT = WS_KMEAN + (size_t)64 * 2 * 512 * 4, WS_BAR = WS_CNT + 4096, WS_PML = WS_BAR + 32768;
constexpr size_t WS_LIST = WS_PML + (size_t)T_ * NH * 3 * 2 * 4;
constexpr size_t WS_AB = WS_LIST + (size_t)NH * LISTH * 2;
constexpr size_t WS_BIG = WS_AB + (size_t)T_ * D_ * 2;
constexpr size_t SZ_QKV = (size_t)T_ * LDA_ * 2;
constexpr size_t WS_GATES = WS_BIG, WS_QKVA = WS_GATES + (size_t)T_ * 2048 * 2, WS_QKVB = WS_QKVA + SZ_QKV, WS_END = WS_QKVB + SZ_QKV;
constexpr size_t WS_ACT = WS_BIG, WS_TMP = WS_QKVA, WS_MERGED = WS_TMP + (size_t)T_ * D_ * 4, WS_PO = WS_QKVB;
static_assert(WS_END <= (size_t)256 * 1024 * 1024, "workspace");
static_assert(WS_AB % 256 == 0 && WS_BIG % 256 == 0 && WS_LIST % 16 == 0, "align");

__device__ unsigned g_sync[8192 + 64];

struct Params {
    const float* x; const int* pos;
    const float *n1, *g1, *u1, *d1, *nm, *win, *bg, *wba, *wbb, *wo, *n2, *g2, *u2, *d2, *nf;
    float* out; unsigned char* ws;
    int ph_lo, ph_hi, fpart, use_cg;
};

typedef __bf16 bf16x2_t __attribute__((ext_vector_type(2)));
typedef float f32x2_t __attribute__((ext_vector_type(2)));
__device__ __forceinline__ unsigned cvt_pk_bf16(float lo, float hi) { f32x2_t v = {lo, hi}; bf16x2_t b = __builtin_convertvector(v, bf16x2_t); return __builtin_bit_cast(unsigned, b); }
__device__ __forceinline__ float bf2f(u16 b) { return __uint_as_float(((unsigned)b) << 16); }
__device__ __forceinline__ float bflo(unsigned w) { return __uint_as_float(w << 16); }
__device__ __forceinline__ float bfhi(unsigned w) { return __uint_as_float(w & 0xffff0000u); }
__device__ __forceinline__ float fexp2(float x) { return __builtin_amdgcn_exp2f(x); }
__device__ __forceinline__ float frcp(float x) { return __builtin_amdgcn_rcpf(x); }

namespace pg8 {
constexpr int BM = 256, BK = 64, HALF = 128, HTB = HALF * BK * 2, STAGE_BYTES = 8 * HTB, NXCD = 8, WGM = 8;
__host__ __device__ __forceinline__ int lds_byte(int r, int c) { const int st = (r >> 4) * 2 + (c >> 5), rr = r & 15, cc = c & 31, ob = rr * 64 + cc * 2; return st * 1024 + (ob ^ (((ob >> 9) & 1) << 5)); }
__host__ __device__ __forceinline__ void stage_rc(int b, int& R, int& C) { const int st = b / 1024, sb = b % 1024, swz = sb ^ (((sb >> 9) & 1) << 5); R = (st >> 1) * 16 + swz / 64; C = (st & 1) * 32 + (swz % 64) / 2; }
struct Unit { int pm, pn; };
struct Gemm { const u16* A; const u16* Bt; int M, N, K; };
struct StaticOrder {
    int nM, nN, nwg, G, c;
    __host__ __device__ void init(int M, int N, int G_, int c_) { nM = M / BM; nN = N / BM; nwg = nM * nN; G = G_; c = c_; }
    __host__ __device__ bool next(int i, Unit& u) const {
        const long L = (long)i * G + c; if (L >= nwg) return false;
        int wgid = (int)L; { const int q = nwg / NXCD, r = nwg % NXCD, xcd = wgid % NXCD, off = wgid / NXCD; wgid = (xcd < r ? xcd * (q + 1) : r * (q + 1) + (xcd - r) * q) + off; }
        const int nig = WGM * nN, gid = wgid / nig, fm = gid * WGM, gsz = (nM - fm) < WGM ? (nM - fm) : WGM;
        u.pm = fm + ((wgid % nig) % gsz); u.pn = (wgid % nig) / gsz; return true;
    }
};

template <class Epi>
__device__ __forceinline__ void gemm_phase(LAS unsigned char* lds, const Gemm g, const StaticOrder& S, const Epi& E) {
    int tid_ = threadIdx.x; asm volatile("" : "+v"(tid_));
    const int tid = tid_, wid = __builtin_amdgcn_readfirstlane(tid >> 6), lane = tid & 63, wr = wid >> 2, wc = wid & 3, fr = lane & 15, fq = lane >> 4;
    const int K = g.K, nt = K / BK;
    unsigned voffA[2];
#pragma unroll
    for (int i = 0; i < 2; ++i) { int R, C; stage_rc(tid * 16 + i * 8192, R, C); voffA[i] = (unsigned)(R * K + C) * 2u; }
    const size_t kstep = (size_t)(BK * 2);
    const size_t hstep = (size_t)HALF * K * 2;
    const size_t tstep = 2 * hstep;
    const unsigned ldsw = (unsigned)wid * 1024u;
    const int aoff = lds_byte(wr * 64 + fr, fq * 8), boff = lds_byte(wc * 32 + fr, fq * 8);
#define PG8_SA(b, h) (((b) * 2 + (h)) * HTB)
#define PG8_SB(b, h) ((4 + (b) * 2 + (h)) * HTB)
#define PG8_STAGE(bufoff, gbase, voff) do { _Pragma("unroll") for (int _i = 0; _i < 2; ++_i) \
        __builtin_amdgcn_global_load_lds((const unsigned*)((const char*)(gbase) + (voff)[_i]), (LAS unsigned*)(lds + (bufoff) + ldsw + _i * 8192), 16, 0, 0); } while (0)
#define PG8_LDA(dst, b, h) do { _Pragma("unroll") for (int m = 0; m < 4; ++m) _Pragma("unroll") for (int k = 0; k < 2; ++k) dst[m][k] = *(const LAS bf16x8*)(lds + PG8_SA(b, h) + aoff + m * 2048 + k * 1024); } while (0)
#define PG8_LDB(dst, b, h) do { _Pragma("unroll") for (int n = 0; n < 2; ++n) _Pragma("unroll") for (int k = 0; k < 2; ++k) dst[n][k] = *(const LAS bf16x8*)(lds + PG8_SB(b, h) + boff + n * 2048 + k * 1024); } while (0)
#define PG8_MMA(ai, bj, At, Bt) do { __builtin_amdgcn_s_setprio(1); _Pragma("unroll") for (int m = 0; m < 4; ++m) _Pragma("unroll") for (int n = 0; n < 2; ++n) _Pragma("unroll") for (int k = 0; k < 2; ++k) \
        acc[ai][bj][m][n] = __builtin_amdgcn_mfma_f32_16x16x32_bf16(Bt[n][k], At[m][k], acc[ai][bj][m][n], 0, 0, 0); __builtin_amdgcn_s_setprio(0); } while (0)
#define PG8_WAIT_V(n) asm volatile("s_waitcnt vmcnt(" #n ")" ::: "memory")
#define PG8_WAIT_L(n) asm volatile("s_waitcnt lgkmcnt(" #n ")" ::: "memory")
#define PG8_BAR __builtin_amdgcn_s_barrier()
#define PG8_SCHED __builtin_amdgcn_sched_barrier(0)
    Unit cur, nxt; int ui = 0;
    if (!S.next(0, cur)) return;
    f32x4 acc[2][2][4][2];
#pragma unroll
    for (int a = 0; a < 2; ++a)
#pragma unroll
        for (int b = 0; b < 2; ++b)
#pragma unroll
            for (int m = 0; m < 4; ++m)
#pragma unroll
                for (int n = 0; n < 2; ++n) acc[a][b][m][n] = (f32x4){0.f, 0.f, 0.f, 0.f};
    bf16x8 At[4][2], B0[2][2], B1[2][2];
    const char* cA = (const char*)g.A + (size_t)cur.pm * tstep; const char* cB = (const char*)g.Bt + (size_t)cur.pn * tstep;
    PG8_STAGE(PG8_SB(0, 0), cB, voffA); PG8_STAGE(PG8_SA(0, 0), cA, voffA); PG8_STAGE(PG8_SB(0, 1), cB + hstep, voffA); PG8_STAGE(PG8_SA(0, 1), cA + hstep, voffA);
    if (wr == 1) PG8_BAR;
    PG8_WAIT_V(4); PG8_BAR;
    PG8_STAGE(PG8_SB(1, 0), cB + kstep, voffA); PG8_STAGE(PG8_SA(1, 0), cA + kstep, voffA); PG8_STAGE(PG8_SB(1, 1), cB + hstep + kstep, voffA);
    PG8_WAIT_V(6); PG8_BAR;
    for (;;) {
        const bool has_next = S.next(ui + 1, nxt);
        const char* nA = has_next ? (const char*)g.A + (size_t)nxt.pm * tstep : cA; const char* nB = has_next ? (const char*)g.Bt + (size_t)nxt.pn * tstep : cB;
        for (int t = 0; t < nt; t += 2) {
            const bool last = (t == nt - 2);
            const char* a1 = cA + (size_t)(t + 1) * kstep;
            const char* a2 = last ? nA : cA + (size_t)(t + 2) * kstep; const char* b2 = last ? nB : cB + (size_t)(t + 2) * kstep;
            const char* a3 = a2 + kstep; const char* b3 = b2 + kstep;
            PG8_LDB(B0, 0, 0); PG8_SCHED; PG8_LDA(At, 0, 0); PG8_STAGE(PG8_SA(1, 1), a1 + hstep, voffA);
            PG8_WAIT_L(8); PG8_BAR; PG8_WAIT_L(0); PG8_MMA(0, 0, At, B0); PG8_BAR; PG8_SCHED;
            PG8_LDB(B1, 0, 1); PG8_STAGE(PG8_SB(0, 0), b2, voffA);
            PG8_BAR; PG8_WAIT_L(0); PG8_MMA(0, 1, At, B1); PG8_BAR;
            PG8_LDA(At, 0, 1); PG8_STAGE(PG8_SA(0, 0), a2, voffA);
            PG8_BAR; PG8_WAIT_L(0); PG8_MMA(1, 0, At, B0); PG8_BAR; PG8_SCHED;
            PG8_STAGE(PG8_SB(0, 1), b2 + hstep, voffA);
            PG8_WAIT_V(6); PG8_BAR; PG8_MMA(1, 1, At, B1); PG8_BAR;
            PG8_LDB(B0, 1, 0); PG8_SCHED; PG8_LDA(At, 1, 0); PG8_STAGE(PG8_SA(0, 1), a2 + hstep, voffA);
            PG8_WAIT_L(8); PG8_BAR; PG8_WAIT_L(0); PG8_MMA(0, 0, At, B0); PG8_BAR; PG8_SCHED;
            PG8_LDB(B1, 1, 1); PG8_STAGE(PG8_SB(1, 0), b3, voffA);
            PG8_BAR; PG8_WAIT_L(0); PG8_MMA(0, 1, At, B1); PG8_BAR;
            PG8_LDA(At, 1, 1); PG8_STAGE(PG8_SA(1, 0), a3, voffA);
            PG8_BAR; PG8_WAIT_L(0); PG8_MMA(1, 0, At, B0); PG8_BAR; PG8_SCHED;
            PG8_STAGE(PG8_SB(1, 1), b3 + hstep, voffA);
            PG8_WAIT_V(6); PG8_BAR; PG8_MMA(1, 1, At, B1); PG8_BAR;
        }
        if constexpr (!Epi::AFTER_DRAIN) E(acc, cur, ui, wr, wc, fr, fq);
        if (!has_next) break;
#pragma unroll
        for (int a = 0; a < 2; ++a)
#pragma unroll
            for (int b = 0; b < 2; ++b)
#pragma unroll
                for (int m = 0; m < 4; ++m)
#pragma unroll
                    for (int n = 0; n < 2; ++n) acc[a][b][m][n] = (f32x4){0.f, 0.f, 0.f, 0.f};
        cur = nxt; cA = nA; cB = nB; ++ui;
    }
    PG8_WAIT_V(0);
    if (wr == 0) PG8_BAR;
    PG8_BAR;
    if constexpr (Epi::AFTER_DRAIN) E.fused(acc, cur, wr, wc, fr, fq, lane);
#undef PG8_SA
#undef PG8_SB
#undef PG8_STAGE
#undef PG8_LDA
#undef PG8_LDB
#undef PG8_MMA
#undef PG8_WAIT_V
#undef PG8_WAIT_L
#undef PG8_BAR
#undef PG8_SCHED
}
}
using pg8::Unit;
typedef f32x4 Acc[2][2][4][2];

constexpr int XST_OFF = 152 * 1024, RTAB_OFF = XST_OFF + 64;
__device__ __forceinline__ void build_rtab(LAS unsigned char* lds, const pg8::StaticOrder& S, const float* part) {
    LAS float* rtab = (LAS float*)(lds + RTAB_OFF);
    int nu = 0; { pg8::Unit u; while (nu < 7 && S.next(nu, u)) ++nu; }
    for (int idx = threadIdx.x; idx < nu * 256; idx += 512) { pg8::Unit u; S.next(idx >> 8, u);
        const f32x4* pp = (const f32x4*)(part + (size_t)(u.pm * 256 + (idx & 255)) * 16);
        f32x4 a = pp[0], b = pp[1], c = pp[2], d = pp[3]; f32x4 sv = (a + b) + (c + d);
        rtab[idx] = __builtin_amdgcn_rsqf((sv[0] + sv[1] + sv[2] + sv[3]) * (1.0f / D_) + EPS); }
    __syncthreads();
}
__device__ __forceinline__ void rtab_get(float (&rinv)[2][4], LAS const unsigned char* lds, int ui, int wr, int fr) {
    LAS const float* rtab = (LAS const float*)(lds + RTAB_OFF) + ui * 256 + wr * 64 + fr;
#pragma unroll
    for (int ai = 0; ai < 2; ++ai)
#pragma unroll
        for (int m = 0; m < 4; ++m) rinv[ai][m] = rtab[ai * 128 + m * 16];
}

struct EpiSwiglu {
    static constexpr bool AFTER_DRAIN = false;
    u16* act; LAS const unsigned char* lds;
    __device__ __forceinline__ void operator()(const Acc& acc, const Unit& u, int ui, int wr, int wc, int fr, int fq) const {
        const int row0 = u.pm * 256 + wr * 64 + fr, col0 = u.pn * 128 + wc * 32 + fq * 8;
        float rinv[2][4]; rtab_get(rinv, lds, ui, wr, fr);
#pragma unroll
        for (int ai = 0; ai < 2; ++ai)
#pragma unroll
            for (int m = 0; m < 4; ++m) {
                const float ri = rinv[ai][m]; float v[8];
#pragma unroll
                for (int n = 0; n < 2; ++n)
#pragma unroll
                    for (int j = 0; j < 4; ++j) { const float g = acc[ai][0][m][n][j] * ri, up = acc[ai][1][m][n][j] * ri;
                        v[n * 4 + j] = g * frcp(1.0f + fexp2(-1.4426950408889634f * g)) * up; }
                u32x4 o; o[0] = cvt_pk_bf16(v[0], v[1]); o[1] = cvt_pk_bf16(v[2], v[3]); o[2] = cvt_pk_bf16(v[4], v[5]); o[3] = cvt_pk_bf16(v[6], v[7]);
                *(u32x4*)(act + (size_t)(row0 + ai * 128 + m * 16) * DFF + col0) = o;
            }
    }
};

template <bool OF> struct EpiResid {
    static constexpr bool AFTER_DRAIN = false;
    const u16* resid; float* out; u16* hb; float* part; float scale;
    __device__ __forceinline__ void operator()(const Acc& acc, const Unit& u, int ui, int wr, int wc, int fr, int fq) const {
        const int row0 = u.pm * 256 + wr * 64 + fr, col0 = u.pn * 256 + wc * 32 + fq * 8;
        u32x4 rwa[2][4][2];
#pragma unroll
        for (int ai = 0; ai < 2; ++ai)
#pragma unroll
            for (int m = 0; m < 4; ++m)
#pragma unroll
                for (int bj = 0; bj < 2; ++bj) rwa[ai][m][bj] = *(const u32x4*)(resid + (size_t)(row0 + ai * 128 + m * 16) * D_ + col0 + bj * 128);
#pragma unroll
        for (int ai = 0; ai < 2; ++ai) {
#pragma unroll
            for (int m = 0; m < 4; ++m) {
                const int row = row0 + ai * 128 + m * 16; float ss = 0.f;
#pragma unroll
                for (int bj = 0; bj < 2; ++bj) {
                    const size_t o = (size_t)row * D_ + col0 + bj * 128;
                    const u32x4 w = rwa[ai][m][bj];
                    f32x4 h0 = (f32x4){bflo(w[0]), bfhi(w[0]), bflo(w[1]), bfhi(w[1])} + acc[ai][bj][m][0] * scale;
                    f32x4 h1 = (f32x4){bflo(w[2]), bfhi(w[2]), bflo(w[3]), bfhi(w[3])} + acc[ai][bj][m][1] * scale;
                    ss += h0[0] * h0[0] + h0[1] * h0[1] + h0[2] * h0[2] + h0[3] * h0[3] + h1[0] * h1[0] + h1[1] * h1[1] + h1[2] * h1[2] + h1[3] * h1[3];
                    if (OF) { *(f32x4*)(out + o) = h0; *(f32x4*)(out + o + 4) = h1; }
                    else { u32x4 b; b[0] = cvt_pk_bf16(h0[0], h0[1]); b[1] = cvt_pk_bf16(h0[2], h0[3]); b[2] = cvt_pk_bf16(h1[0], h1[1]); b[3] = cvt_pk_bf16(h1[2], h1[3]); *(u32x4*)(hb + o) = b; }
                }
                ss += __shfl_xor(ss, 16); ss += __shfl_xor(ss, 32);
                if (fq == 0) part[(size_t)row * 16 + u.pn * 4 + wc] = ss;
            }
        }
    }
};

struct EpiWin {
    static constexpr bool AFTER_DRAIN = false;
    u16 *qkva, *qkvb, *gates; LAS const unsigned char* lds; const float *cs, *bgate; float* kmp;
    __device__ __forceinline__ void operator()(const Acc& acc, const Unit& u, int ui, int wr, int wc, int fr, int fq) const {
        const int row0 = u.pm * 256 + wr * 64 + fr;
        const int pn = u.pn;
        LAS const float* rtab = (LAS const float*)(lds + RTAB_OFF) + ui * 256 + wr * 64 + fr;
        if (pn >= 12) {
            f32x4 bb[2][2];
#pragma unroll
            for (int bj = 0; bj < 2; ++bj) { const int gc = pn * 256 + bj * 128 + wc * 32 - 3072 + fq * 8; bb[bj][0] = *(const f32x4*)(bgate + gc); bb[bj][1] = *(const f32x4*)(bgate + gc + 4); }
#pragma unroll
            for (int bj = 0; bj < 2; ++bj) { const int gc = pn * 256 + bj * 128 + wc * 32 - 3072 + fq * 8;
#pragma unroll
                for (int ai = 0; ai < 2; ++ai)
#pragma unroll
                    for (int m = 0; m < 4; ++m) { const float ri = rtab[ai * 128 + m * 16]; float v[8];
#pragma unroll
                        for (int j = 0; j < 4; ++j) { v[j] = acc[ai][bj][m][0][j] * ri + bb[bj][0][j]; v[4 + j] = acc[ai][bj][m][1][j] * ri + bb[bj][1][j]; }
#pragma unroll
                        for (int j = 0; j < 8; ++j) v[j] = frcp(1.0f + fexp2(-1.4426950408889634f * v[j]));
                        u32x4 o; o[0] = cvt_pk_bf16(v[0], v[1]); o[1] = cvt_pk_bf16(v[2], v[3]); o[2] = cvt_pk_bf16(v[4], v[5]); o[3] = cvt_pk_bf16(v[6], v[7]);
                        *(u32x4*)(gates + (size_t)(row0 + ai * 128 + m * 16) * 2048 + gc) = o; } }
        } else {
            const bool isk = (pn == 2) || (pn == 3);
#pragma unroll
            for (int bj = 0; bj < 2; ++bj) {
                const int g32 = pn * 256 + bj * 128 + wc * 32;
                u16* base = g32 < 1536 ? qkva + g32 : qkvb + (g32 - 1536);
                const bool rot = (g32 < 1024) && ((g32 & 63) == 0) && (fq < 2);
                f32x4 ks0 = {0.f, 0.f, 0.f, 0.f}, ks1 = {0.f, 0.f, 0.f, 0.f};
                if (rot) {
#pragma unroll
                    for (int ai = 0; ai < 2; ++ai) {
                        f32x4 cc[4], sn[4];
#pragma unroll
                        for (int m = 0; m < 4; ++m) { const int row = row0 + ai * 128 + m * 16; cc[m] = *(const f32x4*)(cs + (size_t)row * 16 + fq * 4); sn[m] = *(const f32x4*)(cs + (size_t)row * 16 + 8 + fq * 4); }
#pragma unroll
                        for (int m = 0; m < 4; ++m) { const float ri = rtab[ai * 128 + m * 16]; const int row = row0 + ai * 128 + m * 16;
                            f32x4 a = acc[ai][bj][m][0] * ri, b = acc[ai][bj][m][1] * ri;
                            f32x4 o1 = a * cc[m] - b * sn[m], o2 = b * cc[m] + a * sn[m];
                            u32x2 w1, w2; w1[0] = cvt_pk_bf16(o1[0], o1[1]); w1[1] = cvt_pk_bf16(o1[2], o1[3]); w2[0] = cvt_pk_bf16(o2[0], o2[1]); w2[1] = cvt_pk_bf16(o2[2], o2[3]);
                            *(u32x2*)(base + (size_t)row * LDA_ + fq * 4) = w1; *(u32x2*)(base + (size_t)row * LDA_ + 8 + fq * 4) = w2;
                            ks0 += o1; ks1 += o2; } }
                } else {
#pragma unroll
                    for (int ai = 0; ai < 2; ++ai)
#pragma unroll
                        for (int m = 0; m < 4; ++m) { const float ri = rtab[ai * 128 + m * 16]; const int row = row0 + ai * 128 + m * 16;
                            f32x4 a = acc[ai][bj][m][0] * ri, b = acc[ai][bj][m][1] * ri;
                            u32x4 o; o[0] = cvt_pk_bf16(a[0], a[1]); o[1] = cvt_pk_bf16(a[2], a[3]); o[2] = cvt_pk_bf16(b[0], b[1]); o[3] = cvt_pk_bf16(b[2], b[3]);
                            *(u32x4*)(base + (size_t)row * LDA_ + fq * 8) = o;
                            ks0 += a; ks1 += b; }
                }
                if (isk) {
#pragma unroll
                    for (int j = 0; j < 4; ++j) {
#pragma unroll
                        for (int o = 1; o < 16; o <<= 1) { ks0[j] += __shfl_xor(ks0[j], o); ks1[j] += __shfl_xor(ks1[j], o); } }
                    if (fr == 0) { float* kp = kmp + (size_t)u.pm * 512 + (g32 - 512);
#pragma unroll
                        for (int j = 0; j < 4; ++j) { atomicAdd(kp + (rot ? fq * 4 : fq * 8) + j, ks0[j]); atomicAdd(kp + (rot ? 8 + fq * 4 : fq * 8 + 4) + j, ks1[j]); } }
                }
            }
        }
    }
};

template <bool FIRST> struct EpiBranch {
    static constexpr bool AFTER_DRAIN = false;
    const u16* gates; u16* tmp; u16* merged;
    __device__ __forceinline__ void operator()(const Acc& acc, const Unit& u, int ui, int wr, int wc, int fr, int fq) const {
        const int row0 = u.pm * 256 + wr * 64 + fr, col0 = u.pn * 256 + wc * 32 + fq * 8;
        constexpr int NB = FIRST ? 1 : 2, AIB = FIRST ? 2 : 1;
#pragma unroll
        for (int bt = 0; bt < NB; ++bt) {
            u32x4 gw[AIB][4][2], tw[AIB][4][2];
#pragma unroll
            for (int a2 = 0; a2 < AIB; ++a2)
#pragma unroll
                for (int m = 0; m < 4; ++m)
#pragma unroll
                    for (int bj = 0; bj < 2; ++bj) { const int ai = FIRST ? a2 : bt, row = row0 + ai * 128 + m * 16, col = col0 + bj * 128;
                        gw[a2][m][bj] = *(const u32x4*)(gates + (size_t)row * 2048 + (FIRST ? 0 : 1024) + col);
                        if (!FIRST) tw[a2][m][bj] = *(const u32x4*)(tmp + (size_t)row * D_ + col); }
#pragma unroll
            for (int a2 = 0; a2 < AIB; ++a2)
#pragma unroll
                for (int m = 0; m < 4; ++m)
#pragma unroll
                    for (int bj = 0; bj < 2; ++bj) { const int ai = FIRST ? a2 : bt, row = row0 + ai * 128 + m * 16, col = col0 + bj * 128;
                        const u32x4 g2 = gw[a2][m][bj];
                        f32x4 v0 = (f32x4){bflo(g2[0]), bfhi(g2[0]), bflo(g2[1]), bfhi(g2[1])} * acc[ai][bj][m][0];
                        f32x4 v1 = (f32x4){bflo(g2[2]), bfhi(g2[2]), bflo(g2[3]), bfhi(g2[3])} * acc[ai][bj][m][1];
                        if (!FIRST) { const u32x4 t2 = tw[a2][m][bj]; v0 += (f32x4){bflo(t2[0]), bfhi(t2[0]), bflo(t2[1]), bfhi(t2[1])}; v1 += (f32x4){bflo(t2[2]), bfhi(t2[2]), bflo(t2[3]), bfhi(t2[3])}; }
                        u32x4 b; b[0] = cvt_pk_bf16(v0[0], v0[1]); b[1] = cvt_pk_bf16(v0[2], v0[3]); b[2] = cvt_pk_bf16(v1[0], v1[1]); b[3] = cvt_pk_bf16(v1[2], v1[3]);
                        *(u32x4*)((FIRST ? tmp : merged) + (size_t)row * D_ + col) = b; }
        }
    }
};

struct EpiFinal {
    static constexpr bool AFTER_DRAIN = true;
    const u16* resid; float* out; float* part; unsigned* pcnt; const float* gain; float scale;
    __device__ __forceinline__ void operator()(const Acc&, const Unit&, int, int, int, int, int) const {}
    __device__ __forceinline__ void fused(Acc& acc, const Unit& u, int wr, int wc, int fr, int fq, int lane) const {
        const int row0 = u.pm * 256 + wr * 64 + fr, col0 = u.pn * 256 + wc * 32 + fq * 8;
        u32x4 rwa[2][4][2];
#pragma unroll
        for (int ai = 0; ai < 2; ++ai)
#pragma unroll
            for (int m = 0; m < 4; ++m)
#pragma unroll
                for (int bj = 0; bj < 2; ++bj) rwa[ai][m][bj] = *(const u32x4*)(resid + (size_t)(row0 + ai * 128 + m * 16) * D_ + col0 + bj * 128);
#pragma unroll
        for (int ai = 0; ai < 2; ++ai)
#pragma unroll
            for (int m = 0; m < 4; ++m) { float ss = 0.f;
#pragma unroll
                for (int bj = 0; bj < 2; ++bj) { const u32x4 w = rwa[ai][m][bj];
                    f32x4 h0 = (f32x4){bflo(w[0]), bfhi(w[0]), bflo(w[1]), bfhi(w[1])} + acc[ai][bj][m][0] * scale;
                    f32x4 h1 = (f32x4){bflo(w[2]), bfhi(w[2]), bflo(w[3]), bfhi(w[3])} + acc[ai][bj][m][1] * scale;
                    acc[ai][bj][m][0] = h0; acc[ai][bj][m][1] = h1;
                    ss += h0[0] * h0[0] + h0[1] * h0[1] + h0[2] * h0[2] + h0[3] * h0[3] + h1[0] * h1[0] + h1[1] * h1[1] + h1[2] * h1[2] + h1[3] * h1[3]; }
                ss += __shfl_xor(ss, 16); ss += __shfl_xor(ss, 32);
                if (fq == 0) __hip_atomic_store(part + (size_t)(row0 + ai * 128 + m * 16) * 16 + u.pn * 4 + wc, ss, __ATOMIC_RELAXED, __HIP_MEMORY_SCOPE_AGENT); }
        asm volatile("s_waitcnt vmcnt(0)" ::: "memory");
        unsigned* cw = pcnt + u.pm * 16;
        if (lane == 0) {
            __hip_atomic_fetch_add(cw, 1u, __ATOMIC_RELAXED, __HIP_MEMORY_SCOPE_AGENT);
            unsigned sp = 0;
            while (__hip_atomic_load(cw, __ATOMIC_RELAXED, __HIP_MEMORY_SCOPE_AGENT) < 32u) { __builtin_amdgcn_s_sleep(1); if (++sp > (1u << 22)) break; }
        }
        float rinv[2][4];
        { float pv[2][4][4];
#pragma unroll
          for (int ai = 0; ai < 2; ++ai)
#pragma unroll
            for (int m = 0; m < 4; ++m)
#pragma unroll
              for (int k = 0; k < 4; ++k) pv[ai][m][k] = __hip_atomic_load(part + (size_t)(row0 + ai * 128 + m * 16) * 16 + fq * 4 + k, __ATOMIC_RELAXED, __HIP_MEMORY_SCOPE_AGENT);
#pragma unroll
          for (int ai = 0; ai < 2; ++ai)
#pragma unroll
            for (int m = 0; m < 4; ++m) { float sv = (pv[ai][m][0] + pv[ai][m][1]) + (pv[ai][m][2] + pv[ai][m][3]);
                sv += __shfl_xor(sv, 16); sv += __shfl_xor(sv, 32); rinv[ai][m] = __builtin_amdgcn_rsqf(sv * (1.0f / D_) + EPS); } }
        f32x4 gv[2][2];
#pragma unroll
        for (int bj = 0; bj < 2; ++bj)
#pragma unroll
            for (int n = 0; n < 2; ++n) gv[bj][n] = *(const f32x4*)(gain + col0 + bj * 128 + n * 4);
#pragma unroll
        for (int ai = 0; ai < 2; ++ai)
#pragma unroll
            for (int m = 0; m < 4; ++m)
#pragma unroll
                for (int bj = 0; bj < 2; ++bj)
#pragma unroll
                    for (int n = 0; n < 2; ++n)
                        *(f32x4*)(out + (size_t)(row0 + ai * 128 + m * 16) * D_ + col0 + bj * 128 + n * 4) = acc[ai][bj][m][n] * rinv[ai][m] * gv[bj][n];
    }
};

__device__ __forceinline__ int map_gu(int c, int up) { const int pn = c >> 7, w = c & 127, wc = w >> 5, r = w & 31; return pn * 256 + up * 128 + wc * 32 + ((r >> 2) & 1) * 16 + (r >> 3) * 4 + (r & 3); }
__device__ __forceinline__ int map_perm8(int c) { const int r = c & 31; return (c & ~31) + ((r >> 2) & 1) * 16 + (r >> 3) * 4 + (r & 3); }
__device__ __forceinline__ int map_win(int c) { if (c < 1024 && (c & 63) < 16) { const int r = c & 15, x2 = r >> 3, i = r & 7; return (c & ~63) + x2 * 16 + (i >> 2) * 4 + (i & 3); } return map_perm8(c); }

struct TileDesc { const float* W; u16* Wt; const float* gain; int K, N, mode, tile; };
struct TileRegs { f32x4 v[2]; float gk[2]; };
__device__ __forceinline__ void tile_load(TileRegs& r, const TileDesc& d) {
    const int ntn = d.N >> 6, tk = d.tile / ntn, tn = d.tile - tk * ntn, k0 = tk * 64, n0 = tn * 64, tid = threadIdx.x;
    const float cscale = d.mode == 3 ? (n0 < 512 ? 0.125f * 1.4426950408889634f : (n0 >= 1536 && n0 < 2048) ? 0.125f : 1.0f) : 1.0f;
#pragma unroll
    for (int i = 0; i < 2; ++i) { const int e = tid + i * 512, k = e >> 4, c4 = (e & 15) * 4;
        r.v[i] = *(const f32x4*)(d.W + (size_t)(k0 + k) * d.N + n0 + c4); r.gk[i] = (d.gain ? d.gain[k0 + k] : 1.0f) * cscale; }
}
__device__ __forceinline__ void tile_store(LAS float* tl, const TileRegs& r, const TileDesc& d) {
    const int ntn = d.N >> 6, tk = d.tile / ntn, tn = d.tile - tk * ntn, k0 = tk * 64, n0 = tn * 64, tid = threadIdx.x;
    __syncthreads();
#pragma unroll
    for (int i = 0; i < 2; ++i) { const int e = tid + i * 512, k = e >> 4, c4 = (e & 15) * 4; const f32x4 v = r.v[i] * r.gk[i];
        tl[k * 65 + c4] = v[0]; tl[k * 65 + c4 + 1] = v[1]; tl[k * 65 + c4 + 2] = v[2]; tl[k * 65 + c4 + 3] = v[3]; }
    __syncthreads();
    const int n = tid & 63, kg = tid >> 6; float v[8];
#pragma unroll
    for (int i = 0; i < 8; ++i) v[i] = tl[(kg * 8 + i) * 65 + n];
    const int c = n0 + n; const int rr = d.mode == 0 ? c : d.mode == 1 ? map_gu(c, 0) : d.mode == 2 ? map_gu(c, 1) : d.mode == 3 ? map_win(c) : map_perm8(c);
    u32x4 o; o[0] = cvt_pk_bf16(v[0], v[1]); o[1] = cvt_pk_bf16(v[2], v[3]); o[2] = cvt_pk_bf16(v[4], v[5]); o[3] = cvt_pk_bf16(v[6], v[7]);
    *(u32x4*)(d.Wt + (size_t)rr * d.K + k0 + kg * 8) = o;
}

__device__ __forceinline__ void prep_phase(const Params& p, LAS unsigned char* lds) {
    unsigned char* ws = p.ws; LAS float* tl = (LAS float*)lds;
    const int tid = threadIdx.x, lane = tid & 63, wid = tid >> 6, G = gridDim.x;
    if (blockIdx.x == 0) { ((int*)(ws + WS_CNT))[tid] = 0; }
    if (blockIdx.x < 64) ((float*)(ws + WS_KMEAN))[blockIdx.x * 512 + tid] = 0.f;
    constexpr int T_GU = 16 * 44, T_DN = 44 * 16, T_IN = 16 * 80, T_BR = 8 * 16, T_WO = 16 * 16;
    constexpr int o1 = T_GU, o2 = o1 + T_GU, o3 = o2 + T_DN, o4 = o3 + T_IN, o5 = o4 + T_BR, o6 = o5 + T_BR, o7 = o6 + T_WO, o8 = o7 + T_GU, o9 = o8 + T_GU, o10 = o9 + T_DN;
    auto desc = [&](int t) -> TileDesc {
        if (t < o1) return TileDesc{p.g1, (u16*)(ws + WS_GU1), p.n1, D_, DFF, 1, t};
        if (t < o2) return TileDesc{p.u1, (u16*)(ws + WS_GU1), p.n1, D_, DFF, 2, t - o1};
        if (t < o3) return TileDesc{p.d1, (u16*)(ws + WS_DN1), nullptr, DFF, D_, 4, t - o2};
        if (t < o4) return TileDesc{p.win, (u16*)(ws + WS_IN), p.nm, D_, DIN, 3, t - o3};
        if (t < o5) return TileDesc{p.wba, (u16*)(ws + WS_BA), nullptr, 512, D_, 4, t - o4};
        if (t < o6) return TileDesc{p.wbb, (u16*)(ws + WS_BB), nullptr, 512, D_, 4, t - o5};
        if (t < o7) return TileDesc{p.wo, (u16*)(ws + WS_WO), nullptr, D_, D_, 4, t - o6};
        if (t < o8) return TileDesc{p.g2, (u16*)(ws + WS_GU2), p.n2, D_, DFF, 1, t - o7};
        if (t < o9) return TileDesc{p.u2, (u16*)(ws + WS_GU2), p.n2, D_, DFF, 2, t - o8};
        return TileDesc{p.d2, (u16*)(ws + WS_DN2), nullptr, DFF, D_, 4, t - o9};
    };
    const int NPREP = (int)gridDim.x == 256 ? 2 * T_GU : 2 * T_GU + 2 * T_GU + T_DN;
    auto pdesc = [&](int t) -> TileDesc { return t < 2 * T_GU ? desc(t) : desc(t - 2 * T_GU + o7); };
    { int t = blockIdx.x;
      if (t < NPREP) { TileDesc d = pdesc(t); TileRegs ra; tile_load(ra, d);
        for (;;) { const int tn = t + G; const bool more = tn < NPREP; TileDesc dn = d; TileRegs rb = ra;
            if (more) { dn = pdesc(tn); tile_load(rb, dn); }
            tile_store(tl, ra, d);
            if (!more) break;
            d = dn; ra = rb; t = tn; } } }
    u16* xb = (u16*)(ws + WS_AB); float* part0 = (float*)(ws + WS_P0); float* cs = (float*)(ws + WS_CS);
    f32x4 xv[4];
    { const int row0_ = blockIdx.x * 8 + wid; if (row0_ < T_) {
#pragma unroll
        for (int i = 0; i < 4; ++i) xv[i] = *(const f32x4*)(p.x + (size_t)row0_ * D_ + i * 256 + lane * 4); } }
    for (int row = blockIdx.x * 8 + wid; row < T_; row += G * 8) {
        float ss = 0.f; f32x4 cur[4];
#pragma unroll
        for (int i = 0; i < 4; ++i) cur[i] = xv[i];
        if (row + G * 8 < T_) {
#pragma unroll
            for (int i = 0; i < 4; ++i) xv[i] = *(const f32x4*)(p.x + (size_t)(row + G * 8) * D_ + i * 256 + lane * 4); }
#pragma unroll
        for (int i = 0; i < 4; ++i) { const f32x4 v = cur[i]; ss += v[0] * v[0] + v[1] * v[1] + v[2] * v[2] + v[3] * v[3];
            u32x2 b; b[0] = cvt_pk_bf16(v[0], v[1]); b[1] = cvt_pk_bf16(v[2], v[3]); *(u32x2*)(xb + (size_t)row * D_ + i * 256 + lane * 4) = b; }
#pragma unroll
        for (int o = 32; o >= 1; o >>= 1) ss += __shfl_xor(ss, o);
        if (lane < 16) part0[(size_t)row * 16 + lane] = lane == 0 ? ss : 0.f;
        if (lane >= 16 && lane < 24) {
            const int i = lane - 16;
            const float invf = i == 0 ? 1.0f : i == 1 ? 0.1939227432012558f : i == 2 ? 0.03760603070259094f : i == 3 ? 0.007292664609849453f : i == 4 ? 0.0014142135623842478f
                             : i == 5 ? 0.00027424818836152554f : i == 6 ? 5.318296098266728e-05f : 1.0313386155758053e-05f;
            const float ang = (float)p.pos[row] * invf;
            const double a = (double)ang, kk = __builtin_rint(a * 0.15915494309189535), r = a - kk * 6.283185307179586;
            const float rf = (float)r;
            cs[(size_t)row * 16 + i] = __cosf(rf); cs[(size_t)row * 16 + 8 + i] = __sinf(rf);
        }
    }
}


__device__ __forceinline__ void deferred_weights(const Params& p, LAS unsigned char* lds, int j, int nidle, int lo, int hi) {
    unsigned char* ws = p.ws; LAS float* tl = (LAS float*)lds;
    constexpr int T_GU = 16 * 44, T_DN = 44 * 16, T_IN = 16 * 80, T_BR = 8 * 16, T_WO = 16 * 16;
    constexpr int o2 = 2 * T_GU, o3 = o2 + T_DN, o4 = o3 + T_IN, o5 = o4 + T_BR, o6 = o5 + T_BR, o7 = o6 + T_WO, o8 = o7 + T_GU, o9 = o8 + T_GU;
    auto desc = [&](int t) -> TileDesc {
        if (t < o3) return TileDesc{p.d1, (u16*)(ws + WS_DN1), nullptr, DFF, D_, 4, t - o2};
        if (t < o4) return TileDesc{p.win, (u16*)(ws + WS_IN), p.nm, D_, DIN, 3, t - o3};
        if (t < o5) return TileDesc{p.wba, (u16*)(ws + WS_BA), nullptr, 512, D_, 4, t - o4};
        if (t < o6) return TileDesc{p.wbb, (u16*)(ws + WS_BB), nullptr, 512, D_, 4, t - o5};
        if (t < o7) return TileDesc{p.wo, (u16*)(ws + WS_WO), nullptr, D_, D_, 4, t - o6};
        if (t < o8) return TileDesc{p.g2, (u16*)(ws + WS_GU2), p.n2, D_, DFF, 1, t - o7};
        if (t < o9) return TileDesc{p.u2, (u16*)(ws + WS_GU2), p.n2, D_, DFF, 2, t - o8};
        return TileDesc{p.d2, (u16*)(ws + WS_DN2), nullptr, DFF, D_, 4, t - o9};
    };
    int t = lo + j;
    if (t < hi) { TileDesc d = desc(t); TileRegs ra; tile_load(ra, d);
        for (;;) { const int tn = t + nidle; const bool more = tn < hi; TileDesc dn = d; TileRegs rb = ra;
            if (more) { dn = desc(tn); tile_load(rb, dn); }
            tile_store(tl, ra, d);
            if (!more) break;
            d = dn; ra = rb; t = tn; } }
}

__device__ __forceinline__ s16x4 vtr(LAS const unsigned char* p) { typedef short v4i16_t __attribute__((ext_vector_type(4))); return __builtin_bit_cast(s16x4, __builtin_amdgcn_ds_read_tr16_b64_v4i16((LAS v4i16_t*)p)); }

__device__ __forceinline__ void pv_tile(f32x4 (&o)[4], LAS const unsigned char* vs, const bf16x8 (&pf)[2], int lane) {
    const int li = lane & 15, g = lane >> 4, q_ = li >> 2, pp = li & 3;
    LAS const unsigned char* b0 = vs + (4 * g + q_) * 144 + pp * 8;
#pragma unroll
    for (int ks = 0; ks < 2; ++ks)
#pragma unroll
        for (int dt = 0; dt < 4; ++dt) {
            s16x4 lo = vtr(b0 + (32 * ks) * 144 + dt * 32), hi = vtr(b0 + (32 * ks + 16) * 144 + dt * 32);
            bf16x8 va = {lo[0], lo[1], lo[2], lo[3], hi[0], hi[1], hi[2], hi[3]};
            o[dt] = __builtin_amdgcn_mfma_f32_16x16x32_bf16(va, pf[ks], o[dt], 0, 0, 0);
        }
}
__device__ __forceinline__ void pack_p(bf16x8 (&pf)[2], const float (&w)[4][4]) {
#pragma unroll
    for (int ks = 0; ks < 2; ++ks) { u32x4 t; t[0] = cvt_pk_bf16(w[2 * ks][0], w[2 * ks][1]); t[1] = cvt_pk_bf16(w[2 * ks][2], w[2 * ks][3]);
        t[2] = cvt_pk_bf16(w[2 * ks + 1][0], w[2 * ks + 1][1]); t[3] = cvt_pk_bf16(w[2 * ks + 1][2], w[2 * ks + 1][3]); pf[ks] = __builtin_bit_cast(bf16x8, t); }
}
__device__ __forceinline__ void load_qf(bf16x8 (&qf)[2], const u16* qrow, int lane) { const int g = lane >> 4; qf[0] = *(const bf16x8*)(qrow + 8 * g); qf[1] = *(const bf16x8*)(qrow + 32 + 8 * g); }

__device__ __forceinline__ int list_off(int n) { return 256 * (63 * n - (n * (n - 1)) / 2); }

struct Top3 { float v1, v2, v3; int i1, i2, i3; };
__device__ __forceinline__ void top3_insert(Top3& t, float v, int i) {
    const bool b1 = v > t.v1 || (v == t.v1 && i < t.i1), b2 = v > t.v2 || (v == t.v2 && i < t.i2), b3 = v > t.v3 || (v == t.v3 && i < t.i3);
    if (b1) { t.v3 = t.v2; t.i3 = t.i2; t.v2 = t.v1; t.i2 = t.i1; t.v1 = v; t.i1 = i; }
    else if (b2) { t.v3 = t.v2; t.i3 = t.i2; t.v2 = v; t.i2 = i; }
    else if (b3) { t.v3 = v; t.i3 = i; }
}
__device__ __forceinline__ void topk_item(const Params& p, int item, int lane, LAS int* hist  ) {
    const u16* qkva = (const u16*)(p.ws + WS_QKVA); const float* km = (const float*)(p.ws + WS_KMEAN);
    int* cnt = (int*)(p.ws + WS_CNT); u16* list = (u16*)(p.ws + WS_LIST);
    const int h = item & 7, qc = item >> 3, q0 = qc * 64, own = qc >> 2, r = lane & 15, g = lane >> 4;
    if (own == 0) return;
    Top3 tp[4];
#pragma unroll
    for (int qt = 0; qt < 4; ++qt) { tp[qt].v1 = tp[qt].v2 = tp[qt].v3 = -INFINITY; tp[qt].i1 = 0; tp[qt].i2 = 1; tp[qt].i3 = 2; }
    if (own > 3) {
#pragma unroll
        for (int qt = 0; qt < 4; ++qt) { tp[qt].i1 = 1000; tp[qt].i2 = 1001; tp[qt].i3 = 1002; }
        bf16x8 qfr[4][2];
#pragma unroll
        for (int qt = 0; qt < 4; ++qt) load_qf(qfr[qt], qkva + (size_t)(q0 + 16 * qt + r) * LDA_ + h * 64, lane);
        const int ntile = (own + 15) >> 4;
        for (int nt = 0; nt < ntile; ++nt) {
            const int nrow = 16 * nt + r; const bool nv = nrow < own;
            bf16x8 ahi[2], alo[2];
#pragma unroll
            for (int ks = 0; ks < 2; ++ks) { const float* kp = km + (size_t)(nv ? nrow : 0) * 512 + h * 64 + 32 * ks + 8 * g;
                f32x4 a = *(const f32x4*)kp, b = *(const f32x4*)(kp + 4);
                u32x4 hi; hi[0] = cvt_pk_bf16(a[0], a[1]); hi[1] = cvt_pk_bf16(a[2], a[3]); hi[2] = cvt_pk_bf16(b[0], b[1]); hi[3] = cvt_pk_bf16(b[2], b[3]);
                f32x4 ra = {a[0] - bflo(hi[0]), a[1] - bfhi(hi[0]), a[2] - bflo(hi[1]), a[3] - bfhi(hi[1])}, rb = {b[0] - bflo(hi[2]), b[1] - bfhi(hi[2]), b[2] - bflo(hi[3]), b[3] - bfhi(hi[3])};
                u32x4 lo; lo[0] = cvt_pk_bf16(ra[0], ra[1]); lo[1] = cvt_pk_bf16(ra[2], ra[3]); lo[2] = cvt_pk_bf16(rb[0], rb[1]); lo[3] = cvt_pk_bf16(rb[2], rb[3]);
                ahi[ks] = __builtin_bit_cast(bf16x8, hi); alo[ks] = __builtin_bit_cast(bf16x8, lo); }
#pragma unroll
            for (int qt = 0; qt < 4; ++qt) { f32x4 acc = {0.f, 0.f, 0.f, 0.f};
#pragma unroll
                for (int ks = 0; ks < 2; ++ks) { acc = __builtin_amdgcn_mfma_f32_16x16x32_bf16(ahi[ks], qfr[qt][ks], acc, 0, 0, 0); acc = __builtin_amdgcn_mfma_f32_16x16x32_bf16(alo[ks], qfr[qt][ks], acc, 0, 0, 0); }
#pragma unroll
                for (int j = 0; j < 4; ++j) { const int n = 16 * nt + 4 * g + j; if (n < own) top3_insert(tp[qt], acc[j], n); } }
        }
#pragma unroll
        for (int step = 16; step <= 32; step <<= 1)
#pragma unroll
            for (int qt = 0; qt < 4; ++qt) { const float pv1 = __shfl_xor(tp[qt].v1, step), pv2 = __shfl_xor(tp[qt].v2, step), pv3 = __shfl_xor(tp[qt].v3, step);
                const int pi1 = __shfl_xor(tp[qt].i1, step), pi2 = __shfl_xor(tp[qt].i2, step), pi3 = __shfl_xor(tp[qt].i3, step);
                if (pi1 < 1000) top3_insert(tp[qt], pv1, pi1); if (pi2 < 1000) top3_insert(tp[qt], pv2, pi2); if (pi3 < 1000) top3_insert(tp[qt], pv3, pi3); }
    }
    const int nsel = own < 3 ? own : 3;
    volatile LAS int* vh = (volatile LAS int*)hist;
    vh[lane] = 0;
    __builtin_amdgcn_fence(__ATOMIC_RELEASE, "wavefront"); __builtin_amdgcn_wave_barrier();
    int rank[4][3];
    if (g == 0) {
#pragma unroll
        for (int qt = 0; qt < 4; ++qt)
#pragma unroll
            for (int s2 = 0; s2 < 3; ++s2) { const int n = s2 == 0 ? tp[qt].i1 : s2 == 1 ? tp[qt].i2 : tp[qt].i3;
                rank[qt][s2] = s2 < nsel ? __hip_atomic_fetch_add(hist + n, 1, __ATOMIC_RELAXED, __HIP_MEMORY_SCOPE_WORKGROUP) : 0; }
    }
    __builtin_amdgcn_fence(__ATOMIC_ACQ_REL, "wavefront"); __builtin_amdgcn_wave_barrier();
    { const int c = vh[lane]; vh[64 + lane] = c > 0 ? atomicAdd(cnt + h * 64 + lane, c) : 0; }
    __builtin_amdgcn_fence(__ATOMIC_ACQ_REL, "wavefront"); __builtin_amdgcn_wave_barrier();
    if (g == 0) {
#pragma unroll
        for (int qt = 0; qt < 4; ++qt) { const int q = q0 + 16 * qt + r;
#pragma unroll
            for (int s2 = 0; s2 < 3; ++s2) if (s2 < nsel) { const int n = s2 == 0 ? tp[qt].i1 : s2 == 1 ? tp[qt].i2 : tp[qt].i3;
                list[(size_t)h * LISTH + list_off(n) + vh[64 + n] + rank[qt][s2]] = (u16)(q | (s2 << 14)); } }
    }
}

struct CoopKV { u32x4 k, v; };
#define KB_OFF(b) ((b) * 18432)
#define VB_OFF(b) ((b) * 18432 + 9216)
__device__ __forceinline__ void coop_load(CoopKV& c, const u16* kbase, int tid) { const u16* p = kbase + (size_t)(tid >> 3) * LDA_ + 8 * (tid & 7); c.k = *(const u32x4*)p; c.v = *(const u32x4*)(p + 512); }
__device__ __forceinline__ void qk_lds(f32x4 (&acc)[4], LAS const unsigned char* kb, const bf16x8 (&qf)[2], int lane) {
    const int r = lane & 15, g = lane >> 4;
#pragma unroll
    for (int kt = 0; kt < 4; ++kt) { LAS const unsigned char* kp = kb + (16 * kt + r) * 144 + 16 * g;
        bf16x8 k0 = *(LAS const bf16x8*)kp, k1 = *(LAS const bf16x8*)(kp + 64);
        f32x4 z = {0.f, 0.f, 0.f, 0.f};
        z = __builtin_amdgcn_mfma_f32_16x16x32_bf16(k0, qf[0], z, 0, 0, 0);
        acc[kt] = __builtin_amdgcn_mfma_f32_16x16x32_bf16(k1, qf[1], z, 0, 0, 0); }
}
template <bool CAUSAL>
__device__ __forceinline__ void sm_tile_l(LAS const unsigned char* kb, LAS const unsigned char* vb, int key0, int t, const bf16x8 (&qf)[2], float& m, float& l, f32x4 (&o)[4], int lane) {
    const int g = lane >> 4;
    f32x4 acc[4]; qk_lds(acc, kb, qf, lane);
    float s[4][4]; float lm = -INFINITY;
#pragma unroll
    for (int kt = 0; kt < 4; ++kt)
#pragma unroll
        for (int j = 0; j < 4; ++j) { float v = acc[kt][j]; if (CAUSAL && (key0 + 16 * kt + 4 * g + j) > t) v = -INFINITY; s[kt][j] = v; lm = fmaxf(lm, v); }
    lm = fmaxf(lm, __shfl_xor(lm, 16)); lm = fmaxf(lm, __shfl_xor(lm, 32));
    const float mn = fmaxf(m, lm), al = fexp2(m - mn);
    float sum = 0.f;
#pragma unroll
    for (int kt = 0; kt < 4; ++kt)
#pragma unroll
        for (int j = 0; j < 4; ++j) { s[kt][j] = fexp2(s[kt][j] - mn); sum += s[kt][j]; }
    l = l * al + sum; m = mn;
#pragma unroll
    for (int dt = 0; dt < 4; ++dt) o[dt] *= al;
    bf16x8 pf[2]; pack_p(pf, s);
    pv_tile(o, vb, pf, lane);
}

__device__ __forceinline__ void sel_block_stream(const Params& p, LAS unsigned char* lds, LAS const int* sched, int total, int tid, int wid, int lane) {
    const u16* qkva = (const u16*)(p.ws + WS_QKVA); const u16* list = (const u16*)(p.ws + WS_LIST);
    u16* po = (u16*)(p.ws + WS_PO); float* pml = (float*)(p.ws + WS_PML);
    const int r = lane & 15, g = lane >> 4, G = gridDim.x;
    int i = (G & 7) == 0 ? (int)(blockIdx.x & 7) * (G >> 3) + (int)(blockIdx.x >> 3) : (int)blockIdx.x; if (i >= total) return;
#define SELB_DECODE(kk_, H, N, E, OK, ACT) do { const int hn_ = __builtin_amdgcn_readfirstlane(sched[(kk_) * 4]), grp_ = __builtin_amdgcn_readfirstlane(sched[(kk_) * 4 + 1]), c_ = __builtin_amdgcn_readfirstlane(sched[(kk_) * 4 + 2]); \
        H = hn_ >> 6; N = hn_ & 63; const int e0_ = grp_ * 128 + wid * 16; ACT = e0_ < c_; int ei_ = e0_ + r; OK = ei_ < c_; if (!OK) ei_ = ACT ? e0_ : 0; \
        E = list[(size_t)H * LISTH + list_off(N) + ei_]; } while (0)
    int kq = 0; int h, n; unsigned e; bool ok, act; SELB_DECODE(kq, h, n, e, ok, act);
    bf16x8 qf[2]; load_qf(qf, qkva + (size_t)(e & 0x3FFF) * LDA_ + h * 64, lane);
#define KBIG(b_) ((b_) * 73728)
#define VBIG(b_) ((b_) * 73728 + 36864)
    CoopKV cN[4];
    { const u16* kb0 = qkva + (size_t)(n * 256) * LDA_ + 512 + h * 64;
#pragma unroll
      for (int t4 = 0; t4 < 4; ++t4) coop_load(cN[t4], kb0 + (size_t)t4 * 64 * LDA_, tid);
      const int o_ = (tid >> 3) * 144 + (tid & 7) * 16;
#pragma unroll
      for (int t4 = 0; t4 < 4; ++t4) { *(LAS u32x4*)(lds + KBIG(0) + t4 * 9216 + o_) = cN[t4].k; *(LAS u32x4*)(lds + VBIG(0) + t4 * 9216 + o_) = cN[t4].v; } }
    __syncthreads();
    int buf = 0;
    for (;;) {
        const int i2 = i + G; const bool has_next = i2 < total;
        int h2 = 0, n2 = 0; unsigned e2 = 0; bool ok2 = false, act2 = false;
        if (has_next) { SELB_DECODE(kq + 1, h2, n2, e2, ok2, act2);
            const u16* kb2 = qkva + (size_t)(n2 * 256) * LDA_ + 512 + h2 * 64;
#pragma unroll
            for (int t4 = 0; t4 < 4; ++t4) coop_load(cN[t4], kb2 + (size_t)t4 * 64 * LDA_, tid); }
        f32x4 o[4];
#pragma unroll
        for (int q_ = 0; q_ < 4; ++q_) o[q_] = (f32x4){0.f, 0.f, 0.f, 0.f};
        float m = -INFINITY, l = 0.f; bf16x8 qn[2] = {qf[0], qf[1]};
        if (has_next) load_qf(qn, qkva + (size_t)(e2 & 0x3FFF) * LDA_ + h2 * 64, lane);
        if (act) {
#pragma unroll 1
            for (int tile = 0; tile < 4; ++tile) sm_tile_l<false>(lds + KBIG(buf) + tile * 9216, lds + VBIG(buf) + tile * 9216, 0, 0, qf, m, l, o, lane);
            l += __shfl_xor(l, 16); l += __shfl_xor(l, 32);
            const float inv = frcp(l);
            if (ok) { const size_t sidx = ((size_t)(e & 0x3FFF) * NH + h) * 3 + (e >> 14);
#pragma unroll
                for (int dt = 0; dt < 4; ++dt) { u32x2 b; b[0] = cvt_pk_bf16(o[dt][0] * inv, o[dt][1] * inv); b[1] = cvt_pk_bf16(o[dt][2] * inv, o[dt][3] * inv);
                    *(u32x2*)(po + sidx * 64 + 16 * dt + 4 * g) = b; }
                if (g == 0) { pml[sidx * 2] = m; pml[sidx * 2 + 1] = l; } } }
        if (!has_next) break;
        { const int o_ = (tid >> 3) * 144 + (tid & 7) * 16;
#pragma unroll
          for (int t4 = 0; t4 < 4; ++t4) { *(LAS u32x4*)(lds + KBIG(buf ^ 1) + t4 * 9216 + o_) = cN[t4].k; *(LAS u32x4*)(lds + VBIG(buf ^ 1) + t4 * 9216 + o_) = cN[t4].v; } }
        __syncthreads(); buf ^= 1;
        i = i2; ++kq; h = h2; n = n2; e = e2; ok = ok2; act = act2; qf[0] = qn[0]; qf[1] = qn[1];
    }
#undef KBIG
#undef VBIG
#undef SELB_DECODE
}

__device__ __forceinline__ void own_block_stream(const Params& p, LAS unsigned char* lds, int tid, int wid, int lane) {
    const u16* qkva = (const u16*)(p.ws + WS_QKVA); const u16* po = (const u16*)(p.ws + WS_PO); const float* pml = (const float*)(p.ws + WS_PML);
    u16* ya = (u16*)(p.ws + WS_AB);
    const int r = lane & 15, g = lane >> 4, G = gridDim.x, total = (T_ / 128) * NH;
    int i = (G & 7) == 0 ? (int)(blockIdx.x & 7) * (G >> 3) + (int)(blockIdx.x >> 3) : (int)blockIdx.x, kk = 0; if (i >= total) return;
#define OWN_DEC(ii, k_, C, H) do { C = ((ii) >> 3) ^ ((k_) & 1); H = (ii) & 7; } while (0)
    int cch, h; OWN_DEC(i, kk, cch, h);
    bf16x8 qf[2]; load_qf(qf, qkva + (size_t)(cch * 128 + wid * 16 + r) * LDA_ + h * 64, lane);
#define KBIG(b_) ((b_) * 73728)
#define VBIG(b_) ((b_) * 73728 + 36864)
    CoopKV cN[4]; const int o_ = (tid >> 3) * 144 + (tid & 7) * 16;
    { const u16* kb0 = qkva + (size_t)((cch >> 1) * 256) * LDA_ + 512 + h * 64; const int nt0 = (cch & 1) ? 4 : 2;
#pragma unroll
      for (int t4 = 0; t4 < 4; ++t4) if (t4 < nt0) coop_load(cN[t4], kb0 + (size_t)t4 * 64 * LDA_, tid);
#pragma unroll
      for (int t4 = 0; t4 < 4; ++t4) if (t4 < nt0) { *(LAS u32x4*)(lds + KBIG(0) + t4 * 9216 + o_) = cN[t4].k; *(LAS u32x4*)(lds + VBIG(0) + t4 * 9216 + o_) = cN[t4].v; } }
    __syncthreads();
    int buf = 0;
    for (;;) {
        const int i2 = i + G; const bool has_next = i2 < total; int c2 = 0, h2 = 0; OWN_DEC(i2, kk + 1, c2, h2);
        const int own = cch >> 1, q0 = cch * 128 + wid * 16, t = q0 + r, wmax = ((cch & 1) * 128 + wid * 16 + 15) >> 6;
        const int nt2 = (c2 & 1) ? 4 : 2;
        f32x4 o[4];
#pragma unroll
        for (int q_ = 0; q_ < 4; ++q_) o[q_] = (f32x4){0.f, 0.f, 0.f, 0.f};
        float m = -INFINITY, l = 0.f; bf16x8 qn[2] = {qf[0], qf[1]};
        if (has_next) { const u16* kb2 = qkva + (size_t)((c2 >> 1) * 256) * LDA_ + 512 + h2 * 64;
#pragma unroll
            for (int t4 = 0; t4 < 4; ++t4) if (t4 < nt2) coop_load(cN[t4], kb2 + (size_t)t4 * 64 * LDA_, tid);
            load_qf(qn, qkva + (size_t)(c2 * 128 + wid * 16 + r) * LDA_ + h2 * 64, lane); }
        const int nsel = own < 3 ? own : 3;
        const size_t sidx = ((size_t)t * NH + h) * 3;
        float ms[3], lsv[3]; u32x2 pw[3][4];
#pragma unroll
        for (int s2 = 0; s2 < 3; ++s2) { ms[s2] = -INFINITY; lsv[s2] = 0.f;
#pragma unroll
            for (int dt = 0; dt < 4; ++dt) pw[s2][dt] = (u32x2){0u, 0u};
            if (s2 < nsel) { ms[s2] = pml[(sidx + s2) * 2]; lsv[s2] = pml[(sidx + s2) * 2 + 1];
#pragma unroll
                for (int dt = 0; dt < 4; ++dt) pw[s2][dt] = *(const u32x2*)(po + (sidx + s2) * 64 + 16 * dt + 4 * g); } }
#pragma unroll 1
        for (int tile = 0; tile <= wmax; ++tile) sm_tile_l<true>(lds + KBIG(buf) + tile * 9216, lds + VBIG(buf) + tile * 9216, own * 256 + tile * 64, t, qf, m, l, o, lane);
        l += __shfl_xor(l, 16); l += __shfl_xor(l, 32);
        float M = m;
#pragma unroll
        for (int s2 = 0; s2 < 3; ++s2) M = fmaxf(M, ms[s2]);
        const float a0 = fexp2(m - M); float den = l * a0;
#pragma unroll
        for (int dt = 0; dt < 4; ++dt) o[dt] *= a0;
#pragma unroll
        for (int s2 = 0; s2 < 3; ++s2) { const float a = lsv[s2] * fexp2(ms[s2] - M); den += a;
#pragma unroll
            for (int dt = 0; dt < 4; ++dt) { const u32x2 w = pw[s2][dt];
                o[dt][0] += a * bflo(w[0]); o[dt][1] += a * bfhi(w[0]); o[dt][2] += a * bflo(w[1]); o[dt][3] += a * bfhi(w[1]); } }
        const float inv = frcp(den);
#pragma unroll
        for (int dt = 0; dt < 4; ++dt) { u32x2 b; b[0] = cvt_pk_bf16(o[dt][0] * inv, o[dt][1] * inv); b[1] = cvt_pk_bf16(o[dt][2] * inv, o[dt][3] * inv);
            *(u32x2*)(ya + (size_t)t * 512 + h * 64 + 16 * dt + 4 * g) = b; }
        if (!has_next) break;
#pragma unroll
        for (int t4 = 0; t4 < 4; ++t4) if (t4 < nt2) { *(LAS u32x4*)(lds + KBIG(buf ^ 1) + t4 * 9216 + o_) = cN[t4].k; *(LAS u32x4*)(lds + VBIG(buf ^ 1) + t4 * 9216 + o_) = cN[t4].v; }
        __syncthreads(); buf ^= 1;
        i = i2; ++kk; cch = c2; h = h2; qf[0] = qn[0]; qf[1] = qn[1];
    }
#undef KBIG
#undef VBIG
#undef OWN_DEC
}

__device__ __forceinline__ void sb_tile_l(LAS const unsigned char* kb, LAS const unsigned char* vb, int key0, int t, const bf16x8 (&qf)[2], float& R, f32x4 (&o)[4], int lane) {
    const int g = lane >> 4;
    f32x4 acc[4]; qk_lds(acc, kb, qf, lane);
    float lf[4][4], Tk[4], ex[4];
#pragma unroll
    for (int kt = 0; kt < 4; ++kt) { float c = 0.f;
#pragma unroll
        for (int j = 0; j < 4; ++j) { const bool valid = (key0 + 16 * kt + 4 * g + j) < t; const float z = acc[kt][j];
            const float sp = fmaxf(z, 0.f) + __logf(1.0f + __expf(-fabsf(z)));
            acc[kt][j] = z; lf[kt][j] = valid ? -sp : 0.f; c += lf[kt][j]; }
        const float b = __shfl_xor(c, 16), s2 = c + b, d = __shfl_xor(s2, 32);
        Tk[kt] = s2 + d; ex[kt] = ((g & 1) ? 0.f : b) + ((g & 2) ? 0.f : d); }
    float w[4][4]; float run = R;
#pragma unroll
    for (int kt = 3; kt >= 0; --kt) { const float E = run + ex[kt]; float suf = 0.f;
#pragma unroll
        for (int j = 3; j >= 0; --j) { const bool valid = (key0 + 16 * kt + 4 * g + j) < t; w[kt][j] = valid ? __expf(acc[kt][j] + lf[kt][j] + E + suf) : 0.f; suf += lf[kt][j]; }
        run += Tk[kt]; }
    R = run;
    bf16x8 pf[2]; pack_p(pf, w);
    pv_tile(o, vb, pf, lane);
}

__device__ __forceinline__ void sb_block_stream(const Params& p, LAS unsigned char* lds, int tid, int wid, int lane) {
    const u16* qkvb = (const u16*)(p.ws + WS_QKVB); u16* yb = (u16*)(p.ws + WS_AB) + (size_t)T_ * 512;
    const int r = lane & 15, g = lane >> 4, G = gridDim.x, total = (T_ / 128) * NH;
    int i = (G & 7) == 0 ? (int)(blockIdx.x & 7) * (G >> 3) + (int)(blockIdx.x >> 3) : (int)blockIdx.x; if (i >= total) return;
    int cch = i >> 3, h = i & 7;
    bf16x8 qf[2]; load_qf(qf, qkvb + (size_t)(cch * 128 + wid * 16 + r) * LDA_ + h * 64, lane);
#define KBIG(b_) ((b_) * 73728)
#define VBIG(b_) ((b_) * 73728 + 36864)
    CoopKV cN[3]; const int o_ = (tid >> 3) * 144 + (tid & 7) * 16;
    { const int ns0 = cch == 0 ? 2 : 3;
#pragma unroll
      for (int s4 = 0; s4 < 3; ++s4) if (s4 < ns0) coop_load(cN[s4], qkvb + (size_t)((2 * cch + 1 - s4) * 64) * LDA_ + 512 + h * 64, tid);
#pragma unroll
      for (int s4 = 0; s4 < 3; ++s4) if (s4 < ns0) { *(LAS u32x4*)(lds + KBIG(0) + s4 * 9216 + o_) = cN[s4].k; *(LAS u32x4*)(lds + VBIG(0) + s4 * 9216 + o_) = cN[s4].v; } }
    __syncthreads();
    int buf = 0;
    for (;;) {
        const int i2 = i + G; const bool has_next = i2 < total; const int c2 = i2 >> 3, h2 = i2 & 7;
        const int q0 = cch * 128 + wid * 16, t = q0 + r, dw = 2 * cch + (wid >> 2);
        const int nstep = cch == 0 ? 2 : 3, ns2 = c2 == 0 ? 2 : 3;
        const u16* kb = qkvb + 512 + h * 64;
        f32x4 o[4];
#pragma unroll
        for (int q_ = 0; q_ < 4; ++q_) o[q_] = (f32x4){0.f, 0.f, 0.f, 0.f};
        float R = 0.f; bool done = false; bf16x8 qn[2] = {qf[0], qf[1]};
        if (has_next) {
#pragma unroll
            for (int s4 = 0; s4 < 3; ++s4) if (s4 < ns2) coop_load(cN[s4], qkvb + (size_t)((2 * c2 + 1 - s4) * 64) * LDA_ + 512 + h2 * 64, tid);
            load_qf(qn, qkvb + (size_t)(c2 * 128 + wid * 16 + r) * LDA_ + h2 * 64, lane); }
        int tile = 2 * cch + 1;
#pragma unroll 1
        for (int s4 = 0; s4 < nstep; ++s4, --tile)
            if (tile <= dw && !done) { sb_tile_l(lds + KBIG(buf) + s4 * 9216, lds + VBIG(buf) + s4 * 9216, tile * 64, t, qf, R, o, lane);
                done = (tile == 0) || (__builtin_amdgcn_ballot_w64(R > -40.f) == 0ull); }
        if (has_next) {
#pragma unroll
            for (int s4 = 0; s4 < 3; ++s4) if (s4 < ns2) { *(LAS u32x4*)(lds + KBIG(buf ^ 1) + s4 * 9216 + o_) = cN[s4].k; *(LAS u32x4*)(lds + VBIG(buf ^ 1) + s4 * 9216 + o_) = cN[s4].v; } }
        int any = __syncthreads_or(done ? 0 : 1);
        while (any && tile >= 0) {
            CoopKV c3; coop_load(c3, kb + (size_t)(tile * 64) * LDA_, tid);
            *(LAS u32x4*)(lds + KBIG(buf) + o_) = c3.k; *(LAS u32x4*)(lds + VBIG(buf) + o_) = c3.v; __syncthreads();
            if (!done) { sb_tile_l(lds + KBIG(buf), lds + VBIG(buf), tile * 64, t, qf, R, o, lane);
                done = (tile == 0) || (__builtin_amdgcn_ballot_w64(R > -40.f) == 0ull); }
            any = __syncthreads_or(done ? 0 : 1); --tile;
        }
#pragma unroll
        for (int dt = 0; dt < 4; ++dt) { u32x2 b; b[0] = cvt_pk_bf16(o[dt][0], o[dt][1]); b[1] = cvt_pk_bf16(o[dt][2], o[dt][3]);
            *(u32x2*)(yb + (size_t)t * 512 + h * 64 + 16 * dt + 4 * g) = b; }
        if (!has_next) break;
        buf ^= 1;
        i = i2; cch = c2; h = h2; qf[0] = qn[0]; qf[1] = qn[1];
    }
#undef KBIG
#undef VBIG
}

#define XB_TMO      128
#define XB_XCNT(j)  (256  + 64 * (j))
#define XB_XSUB(j)  (1280 + 64 * (j))
#define XB_XGEN(j)  (2304 + 64 * (j))
#define XB_TOP      3328
#define XB_TOPGEN   3392
#define XCD_BAR_WORDS 3456
#define XB_SPIN_CAP (1u << 22)
__device__ __forceinline__ unsigned xb_ld(unsigned* p)              { return __hip_atomic_load(p, __ATOMIC_RELAXED, __HIP_MEMORY_SCOPE_AGENT); }
__device__ __forceinline__ unsigned xb_add(unsigned* p, unsigned v) { return __hip_atomic_fetch_add(p, v, __ATOMIC_RELAXED, __HIP_MEMORY_SCOPE_AGENT); }
__device__ __forceinline__ unsigned xb_xcc_id() { return (unsigned)__builtin_amdgcn_s_getreg((3 << 11) | 20) & 0xFu; }
#define XB_SPIN(cond, bar) do { unsigned _sp = 0; while (cond) { __builtin_amdgcn_s_sleep(1); \
    if ((++_sp & 255u) == 0u) { if (xb_ld(&(bar)[XB_TMO])) break; if (_sp > XB_SPIN_CAP) { atomicAdd(&(bar)[XB_TMO], 1u); break; } } } } while (0)
struct XcdBarrier { unsigned* bar; unsigned x; volatile LAS unsigned* st; };
__device__ __forceinline__ XcdBarrier xcd_barrier_post(unsigned* bar, volatile LAS unsigned* st) {
    XcdBarrier b; b.bar = bar; b.x = xb_xcc_id(); b.st = st;
    if (threadIdx.x == 0) (void)xb_add(&bar[XB_XCNT(b.x)], 1u);
    return b;
}
__device__ __forceinline__ void xcd_barrier_complete(unsigned* bar, unsigned x, unsigned& nloc, unsigned& nx) {
    const unsigned G = gridDim.x * gridDim.y * gridDim.z;
    unsigned sum, cnt, mine, sp = 0u;
    for (;;) {
        sum = 0u; cnt = 0u; mine = 0u;
#pragma unroll
        for (unsigned j = 0; j < 16; ++j) { const unsigned c = xb_ld(&bar[XB_XCNT(j)]); sum += c; cnt += (c > 0u) ? 1u : 0u; mine = (j == x) ? c : mine; }
        if (sum == G) break;
        __builtin_amdgcn_s_sleep(1);
        if ((++sp & 255u) == 0u) { if (xb_ld(&bar[XB_TMO])) break; if (sp > XB_SPIN_CAP) { atomicAdd(&bar[XB_TMO], 1u); break; } }
    }
    nloc = mine > 0u ? mine : 1u; nx = cnt > 0u ? cnt : 1u;
}
__device__ __forceinline__ void xcd_barrier_arrive(const XcdBarrier& b) {
    asm volatile("s_waitcnt vmcnt(0)" ::: "memory");
    __syncthreads();
    if (threadIdx.x == 0) {
        unsigned* bar = b.bar;
        __builtin_amdgcn_s_waitcnt(0);
        unsigned nloc = b.st[0], nx = b.st[1];
        if (nloc == 0u) { xcd_barrier_complete(bar, b.x, nloc, nx); b.st[0] = nloc; b.st[1] = nx; }
        const unsigned old = xb_add(&bar[XB_XSUB(b.x)], 1u);
        const unsigned gen = old / nloc;
        if (old + 1u == (gen + 1u) * nloc) {
            __builtin_amdgcn_fence(__ATOMIC_RELEASE, "agent");
            asm volatile("s_waitcnt vmcnt(0)" ::: "memory");
            const unsigned og = xb_add(&bar[XB_TOP], 1u);
            const unsigned tg = og / nx;
            if (og + 1u == (tg + 1u) * nx) xb_add(&bar[XB_TOPGEN], 1u);
        }
    }
}
__device__ __forceinline__ void xcd_barrier_wait(const XcdBarrier& b) {
    if (threadIdx.x == 0) {
        unsigned* bar = b.bar;
        const unsigned tgen = b.st[2]; b.st[2] = tgen + 1u;
        XB_SPIN(xb_ld(&bar[XB_TOPGEN]) <= tgen, bar);
        __builtin_amdgcn_fence(__ATOMIC_ACQUIRE, "agent");
        asm volatile("s_waitcnt vmcnt(0)" ::: "memory");
    }
    __syncthreads();
}
__device__ __forceinline__ void xcd_barrier(const XcdBarrier& b) { xcd_barrier_arrive(b); xcd_barrier_wait(b); }

#define PH_PROLOG int tid_ = threadIdx.x; asm volatile("" : "+v"(tid_)); const int tid = tid_, lane = tid & 63, wid = __builtin_amdgcn_readfirstlane(tid >> 6); \
    const int G = gridDim.x, W = blockIdx.x * 8 + wid, NW = G * 8; LAS unsigned char* vs = lds + wid * 9216; (void)vs; (void)W; (void)NW; (void)lane; (void)G;
#ifndef REP_MASK
#define REP_MASK 0
#endif
#ifndef REPN
#define REPN 2
#endif
#ifndef EXTRA_SYNCS
#define EXTRA_SYNCS 0
#endif
#define PHASE(N, ...) if constexpr ((PH_MASK >> N) & 1) { if (p.ph_lo <= N && N < p.ph_hi) { \
    for (int rep_ = 0; rep_ < (((REP_MASK >> N) & 1) ? REPN : 1); ++rep_) { if (rep_) xcd_barrier(xb); { PH_PROLOG __VA_ARGS__ } } } } if (p.ph_lo <= N && N + 1 < p.ph_hi) xcd_barrier(xb);
#define PHASE_S(N, SLOT, ...) if constexpr ((PH_MASK >> N) & 1) { if (p.ph_lo <= N && N < p.ph_hi) { { PH_PROLOG __VA_ARGS__ } } } \
    if (p.ph_lo <= N && N + 1 < p.ph_hi) { xcd_barrier_arrive(xb); \
        { constexpr int lo_ = 2 * 16 * 44 + 44 * 16 + 16 * 80 + 2 * 8 * 16 + 16 * 16 + (SLOT) * 512, end_ = 2 * 16 * 44 + 44 * 16 + 16 * 80 + 2 * 8 * 16 + 16 * 16 + 2 * 16 * 44 + 44 * 16; \
          if ((int)gridDim.x == 256) deferred_weights(p, lds, (int)blockIdx.x, 256, lo_, (lo_ + 512 < end_ ? lo_ + 512 : end_)); } \
        xcd_barrier_wait(xb); }

__global__ void __launch_bounds__(512) fwd_megakernel(Params p) {
    extern __shared__ __attribute__((aligned(16))) unsigned char shm_raw[];
    LAS unsigned char* lds = (LAS unsigned char*)shm_raw;
    cg::grid_group grid = cg::this_grid();
    unsigned char* ws = p.ws;
    volatile LAS unsigned* xst = (volatile LAS unsigned*)(lds + XST_OFF);
    if (threadIdx.x == 0) { xst[0] = 0u; xst[1] = 0u; xst[2] = 0u; }
    __syncthreads();
    XcdBarrier xb = xcd_barrier_post(g_sync, xst);
    if (p.use_cg) grid.sync();

    for (int es_ = 0; es_ < EXTRA_SYNCS; ++es_) xcd_barrier(xb);
    PHASE(0, prep_phase(p, lds);)
    PHASE(1, pg8::StaticOrder S; S.init(T_, 2 * DFF, G, blockIdx.x); pg8::Gemm g{(const u16*)(ws + WS_AB), (const u16*)(ws + WS_GU1), T_, 2 * DFF, D_};
             build_rtab(lds, S, (const float*)(ws + WS_P0)); EpiSwiglu E{(u16*)(ws + WS_ACT), lds}; pg8::gemm_phase(lds, g, S, E);
             { const int nfull = (T_ / 256) * (2 * DFF / 256) - 5 * G;
               constexpr int lo_ = 2 * 16 * 44, hi_ = lo_ + 44 * 16 + 16 * 80 + 2 * 8 * 16 + 16 * 16;
               if (nfull >= 0 && nfull < G) { if ((int)blockIdx.x >= nfull) deferred_weights(p, lds, (int)blockIdx.x - nfull, G - nfull, lo_, hi_); }
               else deferred_weights(p, lds, (int)blockIdx.x, G, lo_, hi_); })
    PHASE_S(2, 0, pg8::StaticOrder S; S.init(T_, D_, G, blockIdx.x); pg8::Gemm g{(const u16*)(ws + WS_ACT), (const u16*)(ws + WS_DN1), T_, D_, DFF};
             EpiResid<false> E{(const u16*)(ws + WS_AB), nullptr, (u16*)p.out, (float*)(ws + WS_P1), 0.5f}; pg8::gemm_phase(lds, g, S, E);)
    PHASE_S(3, 1, pg8::StaticOrder S; S.init(T_, DIN, G, blockIdx.x); pg8::Gemm g{(const u16*)p.out, (const u16*)(ws + WS_IN), T_, DIN, D_};
             build_rtab(lds, S, (const float*)(ws + WS_P1)); EpiWin E{(u16*)(ws + WS_QKVA), (u16*)(ws + WS_QKVB), (u16*)(ws + WS_GATES), lds, (const float*)(ws + WS_CS), p.bg, (float*)(ws + WS_KMEAN)}; pg8::gemm_phase(lds, g, S, E);)
    PHASE_S(4, 2, for (int i = W; i < (T_ / 64) * NH; i += NW) topk_item(p, i, lane, (LAS int*)(lds + wid * 512));
             __syncthreads(); sb_block_stream(p, lds, tid, wid, lane); __syncthreads();)
    PHASE_S(6, 3, LAS int* pref = (LAS int*)(lds + 96 * 1024); const int* cnt = (const int*)(ws + WS_CNT);
             __syncthreads();
             pref[tid] = (cnt[tid] + 127) >> 7; __syncthreads();
             for (int o = 1; o < 512; o <<= 1) { const int v = tid >= o ? pref[tid - o] : 0; __syncthreads(); pref[tid] += v; __syncthreads(); }
             const int total = pref[511];
             LAS int* sched = (LAS int*)(lds + 148 * 1024);
             { const int slot0 = (G & 7) == 0 ? (int)(blockIdx.x & 7) * (G >> 3) + (int)(blockIdx.x >> 3) : (int)blockIdx.x; const int ii = slot0 + tid * G;
               if (tid < 64 && ii < total) { int lo = 0; int hi = 511; while (lo < hi) { const int mid = (lo + hi) >> 1; if (pref[mid] > ii) hi = mid; else lo = mid + 1; }
                   sched[tid * 4] = lo; sched[tid * 4 + 1] = ii - (lo ? pref[lo - 1] : 0); sched[tid * 4 + 2] = cnt[lo]; } }
             __syncthreads();
             sel_block_stream(p, lds, sched, total, tid, wid, lane);
             __syncthreads();)
    PHASE_S(7, 4, __syncthreads(); own_block_stream(p, lds, tid, wid, lane); __syncthreads();)
    PHASE(8, { pg8::StaticOrder S; S.init(T_, D_, G, blockIdx.x); pg8::Gemm g{(const u16*)(ws + WS_AB), (const u16*)(ws + WS_BA), T_, D_, 512};
               EpiBranch<true> E{(const u16*)(ws + WS_GATES), (u16*)(ws + WS_TMP), (u16*)(ws + WS_MERGED)}; pg8::gemm_phase(lds, g, S, E); }
             { pg8::StaticOrder S; S.init(T_, D_, G, blockIdx.x); pg8::Gemm g{(const u16*)(ws + WS_AB) + (size_t)T_ * 512, (const u16*)(ws + WS_BB), T_, D_, 512};
               EpiBranch<false> E{(const u16*)(ws + WS_GATES), (u16*)(ws + WS_TMP), (u16*)(ws + WS_MERGED)}; pg8::gemm_phase(lds, g, S, E); })
    PHASE(9, pg8::StaticOrder S; S.init(T_, D_, G, blockIdx.x); pg8::Gemm g{(const u16*)(ws + WS_MERGED), (const u16*)(ws + WS_WO), T_, D_, D_};
             EpiResid<false> E{(const u16*)p.out, nullptr, (u16*)(ws + WS_AB), (float*)(ws + WS_P2), 1.0f}; pg8::gemm_phase(lds, g, S, E);)
    PHASE(10, pg8::StaticOrder S; S.init(T_, 2 * DFF, G, blockIdx.x); pg8::Gemm g{(const u16*)(ws + WS_AB), (const u16*)(ws + WS_GU2), T_, 2 * DFF, D_};
              build_rtab(lds, S, (const float*)(ws + WS_P2)); EpiSwiglu E{(u16*)(ws + WS_ACT), lds}; pg8::gemm_phase(lds, g, S, E);)
    PHASE(11, pg8::StaticOrder S; S.init(T_, D_, G, blockIdx.x); pg8::Gemm g{(const u16*)(ws + WS_ACT), (const u16*)(ws + WS_DN2), T_, D_, DFF};
              EpiFinal E{(const u16*)(ws + WS_AB), p.out, (float*)(ws + WS_P3), g_sync + 4096, p.nf, 0.5f}; pg8::gemm_phase(lds, g, S, E);)
    asm volatile("s_waitcnt vmcnt(0)" ::: "memory");
    __syncthreads();
    if (threadIdx.x == 0) xst[3] = (__hip_atomic_fetch_add(&g_sync[8192], 1u, __ATOMIC_RELAXED, __HIP_MEMORY_SCOPE_AGENT) == gridDim.x - 1u) ? 1u : 0u;
    __syncthreads();
    if (xst[3]) { for (int i2 = threadIdx.x; i2 < 8192; i2 += 512) g_sync[i2] = 0u; if (threadIdx.x == 0) g_sync[8192] = 0u; }
}

extern "C" void kernel_launch(void* const* d_in, const int* in_sizes, int n_in, void* d_out, int out_size, void* d_ws, size_t ws_size, hipStream_t stream) {
    constexpr int LDS_BYTES = 152 * 1024 + 64 + 7 * 1024;
    static int grid = 0;
    if (grid == 0) {
        int dev = 0, cus = 0, per_cu = 0;
        hipGetDevice(&dev); hipDeviceGetAttribute(&cus, hipDeviceAttributeMultiprocessorCount, dev);
        hipFuncSetAttribute((const void*)fwd_megakernel, hipFuncAttributeMaxDynamicSharedMemorySize, LDS_BYTES);
        hipOccupancyMaxActiveBlocksPerMultiprocessor(&per_cu, (const void*)fwd_megakernel, 512, LDS_BYTES);
        if (per_cu < 1) { fprintf(stderr, "occupancy query says %d blocks/CU\n", per_cu); per_cu = 1; }
        (void)hipGetLastError();
        grid = cus;
        if (ws_size < WS_END) { fprintf(stderr, "workspace too small: %zu < %zu\n", ws_size, (size_t)WS_END); grid = -1; }
    }
    if (grid < 0) return;
    Params p{};
    p.x = (const float*)d_in[0]; p.pos = (const int*)d_in[1];
    p.n1 = (const float*)d_in[2]; p.g1 = (const float*)d_in[3]; p.u1 = (const float*)d_in[4]; p.d1 = (const float*)d_in[5];
    p.nm = (const float*)d_in[6]; p.win = (const float*)d_in[7]; p.bg = (const float*)d_in[8]; p.wba = (const float*)d_in[9]; p.wbb = (const float*)d_in[10]; p.wo = (const float*)d_in[11];
    p.n2 = (const float*)d_in[12]; p.g2 = (const float*)d_in[13]; p.u2 = (const float*)d_in[14]; p.d2 = (const float*)d_in[15]; p.nf = (const float*)d_in[16];
    p.out = (float*)d_out; p.ws = (unsigned char*)d_ws;
#ifndef ONE_LAUNCH
#define ONE_LAUNCH 1
#endif
#if ONE_LAUNCH
    p.ph_lo = 0; p.ph_hi = N_PHASES;
    void* args[] = {&p};
    hipError_t e = hipLaunchCooperativeKernel((const void*)fwd_megakernel, dim3(grid), dim3(512), args, LDS_BYTES, stream);
    if (e != hipSuccess) fprintf(stderr, "cooperative launch failed: %s (grid %d)\n", hipGetErrorString(e), grid);
#else
#ifndef DBG_MASK
#define DBG_MASK 0x1fff
#endif
#ifndef DBG_FPART
#define DBG_FPART 0
#endif
    p.fpart = DBG_FPART;
    for (int ph = 0; ph < N_PHASES; ++ph) { if (!((DBG_MASK >> ph) & 1)) continue; p.ph_lo = ph; p.ph_hi = ph + 1; hipLaunchKernelGGL(fwd_megakernel, dim3(grid), dim3(512), LDS_BYTES, stream, p); }
#endif
}
```

```cpp
#include <hip/hip_runtime.h>
#include <hip/hip_cooperative_groups.h>
#include <cstdio>
namespace cg = cooperative_groups;

#define LAS __attribute__((address_space(3)))
typedef unsigned short u16;
typedef short bf16x8 __attribute__((ext_vector_type(8)));
typedef short s16x4 __attribute__((ext_vector_type(4)));
typedef float f32x4 __attribute__((ext_vector_type(4)));
typedef unsigned u32x4 __attribute__((ext_vector_type(4)));
typedef unsigned u32x2 __attribute__((ext_vector_type(2)));

constexpr int T_ = 16384, D_ = 1024, DFF = 2816, DIN = 5120, NH = 8, HD = 64;
constexpr int LDA_ = 1536;
constexpr float EPS = 1e-6f;
constexpr int LISTH = 256 * 2016;
constexpr int N_PHASES = 12;
#ifndef PH_MASK
#define PH_MASK 0x1fff
#endif

constexpr size_t SZ_GU = (size_t)2 * DFF * D_ * 2, SZ_DN = (size_t)D_ * DFF * 2, SZ_IN = (size_t)DIN * D_ * 2, SZ_BR = (size_t)D_ * 512 * 2, SZ_WO = (size_t)D_ * D_ * 2;
constexpr size_t WS_GU1 = 0, WS_DN1 = WS_GU1 + SZ_GU, WS_IN = WS_DN1 + SZ_DN, WS_BA = WS_IN + SZ_IN, WS_BB = WS_BA + SZ_BR, WS_WO = WS_BB + SZ_BR,
                 WS_GU2 = WS_WO + SZ_WO, WS_DN2 = WS_GU2 + SZ_GU, WS_CS = WS_DN2 + SZ_DN;
constexpr size_t SZ_PART = (size_t)T_ * 16 * 4;
constexpr size_t WS_P0 = WS_CS + (size_t)T_ * 16 * 4, WS_P1 = WS_P0 + SZ_PART, WS_P2 = WS_P1 + SZ_PART, WS_P3 = WS_P2 + SZ_PART;
constexpr size_t WS_KMEAN = WS_P3 + SZ_PART, WS_CNT = WS_KMEAN + (size_t)64 * 2 * 512 * 4, WS_BAR = WS_CNT + 4096, WS_PML = WS_BAR + 32768;
constexpr size_t WS_LIST = WS_PML + (size_t)T_ * NH * 3 * 2 * 4;
constexpr size_t WS_AB = WS_LIST + (size_t)NH * LISTH * 2;
constexpr size_t WS_BIG = WS_AB + (size_t)T_ * D_ * 2;
constexpr size_t SZ_QKV = (size_t)T_ * LDA_ * 2;
constexpr size_t WS_GATES = WS_BIG, WS_QKVA = WS_GATES + (size_t)T_ * 2048 * 2, WS_QKVB = WS_QKVA + SZ_QKV, WS_END = WS_QKVB + SZ_QKV;
constexpr size_t WS_ACT = WS_BIG, WS_TMP = WS_QKVA, WS_MERGED = WS_TMP + (size_t)T_ * D_ * 4, WS_PO = WS_QKVB;
static_assert(WS_END <= (size_t)256 * 1024 * 1024, "workspace");
static_assert(WS_AB % 256 == 0 && WS_BIG % 256 == 0 && WS_LIST % 16 == 0, "align");

__device__ unsigned g_sync[8192 + 64];

struct Params {
    const float* x; const int* pos;
    const float *n1, *g1, *u1, *d1, *nm, *win, *bg, *wba, *wbb, *wo, *n2, *g2, *u2, *d2, *nf;
    float* out; unsigned char* ws;
    int ph_lo, ph_hi, fpart, use_cg;
};

typedef __bf16 bf16x2_t __attribute__((ext_vector_type(2)));
typedef float f32x2_t __attribute__((ext_vector_type(2)));
__device__ __forceinline__ unsigned cvt_pk_bf16(float lo, float hi) { f32x2_t v = {lo, hi}; bf16x2_t b = __builtin_convertvector(v, bf16x2_t); return __builtin_bit_cast(unsigned, b); }
__device__ __forceinline__ float bf2f(u16 b) { return __uint_as_float(((unsigned)b) << 16); }
__device__ __forceinline__ float bflo(unsigned w) { return __uint_as_float(w << 16); }
__device__ __forceinline__ float bfhi(unsigned w) { return __uint_as_float(w & 0xffff0000u); }
__device__ __forceinline__ float fexp2(float x) { return __builtin_amdgcn_exp2f(x); }
__device__ __forceinline__ float frcp(float x) { return __builtin_amdgcn_rcpf(x); }

namespace pg8 {
constexpr int BM = 256, BK = 64, HALF = 128, HTB = HALF * BK * 2, STAGE_BYTES = 8 * HTB, NXCD = 8, WGM = 8;
__host__ __device__ __forceinline__ int lds_byte(int r, int c) { const int st = (r >> 4) * 2 + (c >> 5), rr = r & 15, cc = c & 31, ob = rr * 64 + cc * 2; return st * 1024 + (ob ^ (((ob >> 9) & 1) << 5)); }
__host__ __device__ __forceinline__ void stage_rc(int b, int& R, int& C) { const int st = b / 1024, sb = b % 1024, swz = sb ^ (((sb >> 9) & 1) << 5); R = (st >> 1) * 16 + swz / 64; C = (st & 1) * 32 + (swz % 64) / 2; }
struct Unit { int pm, pn; };
struct Gemm { const u16* A; const u16* Bt; int M, N, K; };
struct StaticOrder {
    int nM, nN, nwg, G, c;
    __host__ __device__ void init(int M, int N, int G_, int c_) { nM = M / BM; nN = N / BM; nwg = nM * nN; G = G_; c = c_; }
    __host__ __device__ bool next(int i, Unit& u) const {
        const long L = (long)i * G + c; if (L >= nwg) return false;
        int wgid = (int)L; { const int q = nwg / NXCD, r = nwg % NXCD, xcd = wgid % NXCD, off = wgid / NXCD; wgid = (xcd < r ? xcd * (q + 1) : r * (q + 1) + (xcd - r) * q) + off; }
        const int nig = WGM * nN, gid = wgid / nig, fm = gid * WGM, gsz = (nM - fm) < WGM ? (nM - fm) : WGM;
        u.pm = fm + ((wgid % nig) % gsz); u.pn = (wgid % nig) / gsz; return true;
    }
};

template <class Epi>
__device__ __forceinline__ void gemm_phase(LAS unsigned char* lds, const Gemm g, const StaticOrder& S, const Epi& E) {
    int tid_ = threadIdx.x; asm volatile("" : "+v"(tid_));
    const int tid = tid_, wid = __builtin_amdgcn_readfirstlane(tid >> 6), lane = tid & 63, wr = wid >> 2, wc = wid & 3, fr = lane & 15, fq = lane >> 4;
    const int K = g.K, nt = K / BK;
    unsigned voffA[2];
#pragma unroll
    for (int i = 0; i < 2; ++i) { int R, C; stage_rc(tid * 16 + i * 8192, R, C); voffA[i] = (unsigned)(R * K + C) * 2u; }
    const size_t kstep = (size_t)(BK * 2);
    const size_t hstep = (size_t)HALF * K * 2;
    const size_t tstep = 2 * hstep;
    const unsigned ldsw = (unsigned)wid * 1024u;
    const int aoff = lds_byte(wr * 64 + fr, fq * 8), boff = lds_byte(wc * 32 + fr, fq * 8);
#define PG8_SA(b, h) (((b) * 2 + (h)) * HTB)
#define PG8_SB(b, h) ((4 + (b) * 2 + (h)) * HTB)
#define PG8_STAGE(bufoff, gbase, voff) do { _Pragma("unroll") for (int _i = 0; _i < 2; ++_i) \
        __builtin_amdgcn_global_load_lds((const unsigned*)((const char*)(gbase) + (voff)[_i]), (LAS unsigned*)(lds + (bufoff) + ldsw + _i * 8192), 16, 0, 0); } while (0)
#define PG8_LDA(dst, b, h) do { _Pragma("unroll") for (int m = 0; m < 4; ++m) _Pragma("unroll") for (int k = 0; k < 2; ++k) dst[m][k] = *(const LAS bf16x8*)(lds + PG8_SA(b, h) + aoff + m * 2048 + k * 1024); } while (0)
#define PG8_LDB(dst, b, h) do { _Pragma("unroll") for (int n = 0; n < 2; ++n) _Pragma("unroll") for (int k = 0; k < 2; ++k) dst[n][k] = *(const LAS bf16x8*)(lds + PG8_SB(b, h) + boff + n * 2048 + k * 1024); } while (0)
#define PG8_MMA(ai, bj, At, Bt) do { __builtin_amdgcn_s_setprio(1); _Pragma("unroll") for (int m = 0; m < 4; ++m) _Pragma("unroll") for (int n = 0; n < 2; ++n) _Pragma("unroll") for (int k = 0; k < 2; ++k) \
        acc[ai][bj][m][n] = __builtin_amdgcn_mfma_f32_16x16x32_bf16(Bt[n][k], At[m][k], acc[ai][bj][m][n], 0, 0, 0); __builtin_amdgcn_s_setprio(0); } while (0)
#define PG8_WAIT_V(n) asm volatile("s_waitcnt vmcnt(" #n ")" ::: "memory")
#define PG8_WAIT_L(n) asm volatile("s_waitcnt lgkmcnt(" #n ")" ::: "memory")
#define PG8_BAR __builtin_amdgcn_s_barrier()
#define PG8_SCHED __builtin_amdgcn_sched_barrier(0)
    Unit cur, nxt; int ui = 0;
    if (!S.next(0, cur)) return;
    f32x4 acc[2][2][4][2];
#pragma unroll
    for (int a = 0; a < 2; ++a)
#pragma unroll
        for (int b = 0; b < 2; ++b)
#pragma unroll
            for (int m = 0; m < 4; ++m)
#pragma unroll
                for (int n = 0; n < 2; ++n) acc[a][b][m][n] = (f32x4){0.f, 0.f, 0.f, 0.f};
    bf16x8 At[4][2], B0[2][2], B1[2][2];
    const char* cA = (const char*)g.A + (size_t)cur.pm * tstep; const char* cB = (const char*)g.Bt + (size_t)cur.pn * tstep;
    PG8_STAGE(PG8_SB(0, 0), cB, voffA); PG8_STAGE(PG8_SA(0, 0), cA, voffA); PG8_STAGE(PG8_SB(0, 1), cB + hstep, voffA); PG8_STAGE(PG8_SA(0, 1), cA + hstep, voffA);
    if (wr == 1) PG8_BAR;
    PG8_WAIT_V(4); PG8_BAR;
    PG8_STAGE(PG8_SB(1, 0), cB + kstep, voffA); PG8_STAGE(PG8_SA(1, 0), cA + kstep, voffA); PG8_STAGE(PG8_SB(1, 1), cB + hstep + kstep, voffA);
    PG8_WAIT_V(6); PG8_BAR;
    for (;;) {
        const bool has_next = S.next(ui + 1, nxt);
        const char* nA = has_next ? (const char*)g.A + (size_t)nxt.pm * tstep : cA; const char* nB = has_next ? (const char*)g.Bt + (size_t)nxt.pn * tstep : cB;
        for (int t = 0; t < nt; t += 2) {
            const bool last = (t == nt - 2);
            const char* a1 = cA + (size_t)(t + 1) * kstep;
            const char* a2 = last ? nA : cA + (size_t)(t + 2) * kstep; const char* b2 = last ? nB : cB + (size_t)(t + 2) * kstep;
            const char* a3 = a2 + kstep; const char* b3 = b2 + kstep;
            PG8_LDB(B0, 0, 0); PG8_SCHED; PG8_LDA(At, 0, 0); PG8_STAGE(PG8_SA(1, 1), a1 + hstep, voffA);
            PG8_WAIT_L(8); PG8_BAR; PG8_WAIT_L(0); PG8_MMA(0, 0, At, B0); PG8_BAR; PG8_SCHED;
            PG8_LDB(B1, 0, 1); PG8_STAGE(PG8_SB(0, 0), b2, voffA);
            PG8_BAR; PG8_WAIT_L(0); PG8_MMA(0, 1, At, B1); PG8_BAR;
            PG8_LDA(At, 0, 1); PG8_STAGE(PG8_SA(0, 0), a2, voffA);
            PG8_BAR; PG8_WAIT_L(0); PG8_MMA(1, 0, At, B0); PG8_BAR; PG8_SCHED;
            PG8_STAGE(PG8_SB(0, 1), b2 + hstep, voffA);
            PG8_WAIT_V(6); PG8_BAR; PG8_MMA(1, 1, At, B1); PG8_BAR;
            PG8_LDB(B0, 1, 0); PG8_SCHED; PG8_LDA(At, 1, 0); PG8_STAGE(PG8_SA(0, 1), a2 + hstep, voffA);
            PG8_WAIT_L(8); PG8_BAR; PG8_WAIT_L(0); PG8_MMA(0, 0, At, B0); PG8_BAR; PG8_SCHED;
            PG8_LDB(B1, 1, 1); PG8_STAGE(PG8_SB(1, 0), b3, voffA);
            PG8_BAR; PG8_WAIT_L(0); PG8_MMA(0, 1, At, B1); PG8_BAR;
            PG8_LDA(At, 1, 1); PG8_STAGE(PG8_SA(1, 0), a3, voffA);
            PG8_BAR; PG8_WAIT_L(0); PG8_MMA(1, 0, At, B0); PG8_BAR; PG8_SCHED;
            PG8_STAGE(PG8_SB(1, 1), b3 + hstep, voffA);
            PG8_WAIT_V(6); PG8_BAR; PG8_MMA(1, 1, At, B1); PG8_BAR;
        }
        if constexpr (!Epi::AFTER_DRAIN) E(acc, cur, ui, wr, wc, fr, fq);
        if (!has_next) break;
#pragma unroll
        for (int a = 0; a < 2; ++a)
#pragma unroll
            for (int b = 0; b < 2; ++b)
#pragma unroll
                for (int m = 0; m < 4; ++m)
#pragma unroll
                    for (int n = 0; n < 2; ++n) acc[a][b][m][n] = (f32x4){0.f, 0.f, 0.f, 0.f};
        cur = nxt; cA = nA; cB = nB; ++ui;
    }
    PG8_WAIT_V(0);
    if (wr == 0) PG8_BAR;
    PG8_BAR;
    if constexpr (Epi::AFTER_DRAIN) E.fused(acc, cur, wr, wc, fr, fq, lane);
#undef PG8_SA
#undef PG8_SB
#undef PG8_STAGE
#undef PG8_LDA
#undef PG8_LDB
#undef PG8_MMA
#undef PG8_WAIT_V
#undef PG8_WAIT_L
#undef PG8_BAR
#undef PG8_SCHED
}
}
using pg8::Unit;
typedef f32x4 Acc[2][2][4][2];

constexpr int XST_OFF = 152 * 1024, RTAB_OFF = XST_OFF + 64;
__device__ __forceinline__ void build_rtab(LAS unsigned char* lds, const pg8::StaticOrder& S, const float* part) {
    LAS float* rtab = (LAS float*)(lds + RTAB_OFF);
    int nu = 0; { pg8::Unit u; while (nu < 7 && S.next(nu, u)) ++nu; }
    for (int idx = threadIdx.x; idx < nu * 256; idx += 512) { pg8::Unit u; S.next(idx >> 8, u);
        const f32x4* pp = (const f32x4*)(part + (size_t)(u.pm * 256 + (idx & 255)) * 16);
        f32x4 a = pp[0], b = pp[1], c = pp[2], d = pp[3]; f32x4 sv = (a + b) + (c + d);
        rtab[idx] = __builtin_amdgcn_rsqf((sv[0] + sv[1] + sv[2] + sv[3]) * (1.0f / D_) + EPS); }
    __syncthreads();
}
__device__ __forceinline__ void rtab_get(float (&rinv)[2][4], LAS const unsigned char* lds, int ui, int wr, int fr) {
    LAS const float* rtab = (LAS const float*)(lds + RTAB_OFF) + ui * 256 + wr * 64 + fr;
#pragma unroll
    for (int ai = 0; ai < 2; ++ai)
#pragma unroll
        for (int m = 0; m < 4; ++m) rinv[ai][m] = rtab[ai * 128 + m * 16];
}

struct EpiSwiglu {
    static constexpr bool AFTER_DRAIN = false;
    u16* act; LAS const unsigned char* lds;
    __device__ __forceinline__ void operator()(const Acc& acc, const Unit& u, int ui, int wr, int wc, int fr, int fq) const {
        const int row0 = u.pm * 256 + wr * 64 + fr, col0 = u.pn * 128 + wc * 32 + fq * 8;
        float rinv[2][4]; rtab_get(rinv, lds, ui, wr, fr);
#pragma unroll
        for (int ai = 0; ai < 2; ++ai)
#pragma unroll
            for (int m = 0; m < 4; ++m) {
                const float ri = rinv[ai][m]; float v[8];
#pragma unroll
                for (int n = 0; n < 2; ++n)
#pragma unroll
                    for (int j = 0; j < 4; ++j) { const float g = acc[ai][0][m][n][j] * ri, up = acc[ai][1][m][n][j] * ri;
                        v[n * 4 + j] = g * frcp(1.0f + fexp2(-1.4426950408889634f * g)) * up; }
                u32x4 o; o[0] = cvt_pk_bf16(v[0], v[1]); o[1] = cvt_pk_bf16(v[2], v[3]); o[2] = cvt_pk_bf16(v[4], v[5]); o[3] = cvt_pk_bf16(v[6], v[7]);
                *(u32x4*)(act + (size_t)(row0 + ai * 128 + m * 16) * DFF + col0) = o;
            }
    }
};

template <bool OF> struct EpiResid {
    static constexpr bool AFTER_DRAIN = true;
    const u16* resid; float* out; u16* hb; float* part; float scale;
    __device__ __forceinline__ void fused(Acc& acc, const Unit& u, int wr, int wc, int fr, int fq, int) const { (*this)(acc, u, 0, wr, wc, fr, fq); }
    __device__ __forceinline__ void operator()(const Acc& acc, const Unit& u, int ui, int wr, int wc, int fr, int fq) const {
        const int row0 = u.pm * 256 + wr * 64 + fr, col0 = u.pn * 256 + wc * 32 + fq * 8;
        u32x4 rwa[2][4][2];
#pragma unroll
        for (int ai = 0; ai < 2; ++ai)
#pragma unroll
            for (int m = 0; m < 4; ++m)
#pragma unroll
                for (int bj = 0; bj < 2; ++bj) rwa[ai][m][bj] = *(const u32x4*)(resid + (size_t)(row0 + ai * 128 + m * 16) * D_ + col0 + bj * 128);
#pragma unroll
        for (int ai = 0; ai < 2; ++ai) {
#pragma unroll
            for (int m = 0; m < 4; ++m) {
                const int row = row0 + ai * 128 + m * 16; float ss = 0.f;
#pragma unroll
                for (int bj = 0; bj < 2; ++bj) {
                    const size_t o = (size_t)row * D_ + col0 + bj * 128;
                    const u32x4 w = rwa[ai][m][bj];
                    f32x4 h0 = (f32x4){bflo(w[0]), bfhi(w[0]), bflo(w[1]), bfhi(w[1])} + acc[ai][bj][m][0] * scale;
                    f32x4 h1 = (f32x4){bflo(w[2]), bfhi(w[2]), bflo(w[3]), bfhi(w[3])} + acc[ai][bj][m][1] * scale;
                    ss += h0[0] * h0[0] + h0[1] * h0[1] + h0[2] * h0[2] + h0[3] * h0[3] + h1[0] * h1[0] + h1[1] * h1[1] + h1[2] * h1[2] + h1[3] * h1[3];
                    if (OF) { *(f32x4*)(out + o) = h0; *(f32x4*)(out + o + 4) = h1; }
                    else { u32x4 b; b[0] = cvt_pk_bf16(h0[0], h0[1]); b[1] = cvt_pk_bf16(h0[2], h0[3]); b[2] = cvt_pk_bf16(h1[0], h1[1]); b[3] = cvt_pk_bf16(h1[2], h1[3]); *(u32x4*)(hb + o) = b; }
                }
                ss += __shfl_xor(ss, 16); ss += __shfl_xor(ss, 32);
                if (fq == 0) part[(size_t)row * 16 + u.pn * 4 + wc] = ss;
            }
        }
    }
};

struct EpiWin {
    static constexpr bool AFTER_DRAIN = false;
    u16 *qkva, *qkvb, *gates; LAS const unsigned char* lds; const float *cs, *bgate; float* kmp;
    __device__ __forceinline__ void operator()(const Acc& acc, const Unit& u, int ui, int wr, int wc, int fr, int fq) const {
        const int row0 = u.pm * 256 + wr * 64 + fr;
        const int pn = u.pn;
        LAS const float* rtab = (LAS const float*)(lds + RTAB_OFF) + ui * 256 + wr * 64 + fr;
        if (pn >= 12) {
            f32x4 bb[2][2];
#pragma unroll
            for (int bj = 0; bj < 2; ++bj) { const int gc = pn * 256 + bj * 128 + wc * 32 - 3072 + fq * 8; bb[bj][0] = *(const f32x4*)(bgate + gc); bb[bj][1] = *(const f32x4*)(bgate + gc + 4); }
#pragma unroll
            for (int bj = 0; bj < 2; ++bj) { const int gc = pn * 256 + bj * 128 + wc * 32 - 3072 + fq * 8;
#pragma unroll
                for (int ai = 0; ai < 2; ++ai)
#pragma unroll
                    for (int m = 0; m < 4; ++m) { const float ri = rtab[ai * 128 + m * 16]; float v[8];
#pragma unroll
                        for (int j = 0; j < 4; ++j) { v[j] = acc[ai][bj][m][0][j] * ri + bb[bj][0][j]; v[4 + j] = acc[ai][bj][m][1][j] * ri + bb[bj][1][j]; }
#pragma unroll
                        for (int j = 0; j < 8; ++j) v[j] = frcp(1.0f + fexp2(-1.4426950408889634f * v[j]));
                        u32x4 o; o[0] = cvt_pk_bf16(v[0], v[1]); o[1] = cvt_pk_bf16(v[2], v[3]); o[2] = cvt_pk_bf16(v[4], v[5]); o[3] = cvt_pk_bf16(v[6], v[7]);
                        *(u32x4*)(gates + (size_t)(row0 + ai * 128 + m * 16) * 2048 + gc) = o; } }
        } else {
            const bool isk = (pn == 2) || (pn == 3);
#pragma unroll
            for (int bj = 0; bj < 2; ++bj) {
                const int g32 = pn * 256 + bj * 128 + wc * 32;
                u16* base = g32 < 1536 ? qkva + g32 : qkvb + (g32 - 1536);
                const bool rot = (g32 < 1024) && ((g32 & 63) == 0) && (fq < 2);
                f32x4 ks0 = {0.f, 0.f, 0.f, 0.f}, ks1 = {0.f, 0.f, 0.f, 0.f};
                if (rot) {
#pragma unroll
                    for (int ai = 0; ai < 2; ++ai) {
                        f32x4 cc[4], sn[4];
#pragma unroll
                        for (int m = 0; m < 4; ++m) { const int row = row0 + ai * 128 + m * 16; cc[m] = *(const f32x4*)(cs + (size_t)row * 16 + fq * 4); sn[m] = *(const f32x4*)(cs + (size_t)row * 16 + 8 + fq * 4); }
#pragma unroll
                        for (int m = 0; m < 4; ++m) { const float ri = rtab[ai * 128 + m * 16]; const int row = row0 + ai * 128 + m * 16;
                            f32x4 a = acc[ai][bj][m][0] * ri, b = acc[ai][bj][m][1] * ri;
                            f32x4 o1 = a * cc[m] - b * sn[m], o2 = b * cc[m] + a * sn[m];
                            u32x2 w1, w2; w1[0] = cvt_pk_bf16(o1[0], o1[1]); w1[1] = cvt_pk_bf16(o1[2], o1[3]); w2[0] = cvt_pk_bf16(o2[0], o2[1]); w2[1] = cvt_pk_bf16(o2[2], o2[3]);
                            *(u32x2*)(base + (size_t)row * LDA_ + fq * 4) = w1; *(u32x2*)(base + (size_t)row * LDA_ + 8 + fq * 4) = w2;
                            ks0 += o1; ks1 += o2; } }
                } else {
#pragma unroll
                    for (int ai = 0; ai < 2; ++ai)
#pragma unroll
                        for (int m = 0; m < 4; ++m) { const float ri = rtab[ai * 128 + m * 16]; const int row = row0 + ai * 128 + m * 16;
                            f32x4 a = acc[ai][bj][m][0] * ri, b = acc[ai][bj][m][1] * ri;
                            u32x4 o; o[0] = cvt_pk_bf16(a[0], a[1]); o[1] = cvt_pk_bf16(a[2], a[3]); o[2] = cvt_pk_bf16(b[0], b[1]); o[3] = cvt_pk_bf16(b[2], b[3]);
                            *(u32x4*)(base + (size_t)row * LDA_ + fq * 8) = o;
                            ks0 += a; ks1 += b; }
                }
                if (isk) {
#pragma unroll
                    for (int j = 0; j < 4; ++j) {
#pragma unroll
                        for (int o = 1; o < 16; o <<= 1) { ks0[j] += __shfl_xor(ks0[j], o); ks1[j] += __shfl_xor(ks1[j], o); } }
                    if (fr == 0) { float* kp = kmp + (size_t)u.pm * 512 + (g32 - 512);
#pragma unroll
                        for (int j = 0; j < 4; ++j) { atomicAdd(kp + (rot ? fq * 4 : fq * 8) + j, ks0[j]); atomicAdd(kp + (rot ? 8 + fq * 4 : fq * 8 + 4) + j, ks1[j]); } }
                }
            }
        }
    }
};

template <bool FIRST> struct EpiBranch {
    static constexpr bool AFTER_DRAIN = true;
    const u16* gates; u16* tmp; u16* merged;
    __device__ __forceinline__ void fused(Acc& acc, const Unit& u, int wr, int wc, int fr, int fq, int) const { (*this)(acc, u, 0, wr, wc, fr, fq); }
    __device__ __forceinline__ void operator()(const Acc& acc, const Unit& u, int ui, int wr, int wc, int fr, int fq) const {
        const int row0 = u.pm * 256 + wr * 64 + fr, col0 = u.pn * 256 + wc * 32 + fq * 8;
        constexpr int NB = FIRST ? 1 : 2, AIB = FIRST ? 2 : 1;
#pragma unroll
        for (int bt = 0; bt < NB; ++bt) {
            u32x4 gw[AIB][4][2], tw[AIB][4][2];
#pragma unroll
            for (int a2 = 0; a2 < AIB; ++a2)
#pragma unroll
                for (int m = 0; m < 4; ++m)
#pragma unroll
                    for (int bj = 0; bj < 2; ++bj) { const int ai = FIRST ? a2 : bt, row = row0 + ai * 128 + m * 16, col = col0 + bj * 128;
                        gw[a2][m][bj] = *(const u32x4*)(gates + (size_t)row * 2048 + (FIRST ? 0 : 1024) + col);
                        if (!FIRST) tw[a2][m][bj] = *(const u32x4*)(tmp + (size_t)row * D_ + col); }
#pragma unroll
            for (int a2 = 0; a2 < AIB; ++a2)
#pragma unroll
                for (int m = 0; m < 4; ++m)
#pragma unroll
                    for (int bj = 0; bj < 2; ++bj) { const int ai = FIRST ? a2 : bt, row = row0 + ai * 128 + m * 16, col = col0 + bj * 128;
                        const u32x4 g2 = gw[a2][m][bj];
                        f32x4 v0 = (f32x4){bflo(g2[0]), bfhi(g2[0]), bflo(g2[1]), bfhi(g2[1])} * acc[ai][bj][m][0];
                        f32x4 v1 = (f32x4){bflo(g2[2]), bfhi(g2[2]), bflo(g2[3]), bfhi(g2[3])} * acc[ai][bj][m][1];
                        if (!FIRST) { const u32x4 t2 = tw[a2][m][bj]; v0 += (f32x4){bflo(t2[0]), bfhi(t2[0]), bflo(t2[1]), bfhi(t2[1])}; v1 += (f32x4){bflo(t2[2]), bfhi(t2[2]), bflo(t2[3]), bfhi(t2[3])}; }
                        u32x4 b; b[0] = cvt_pk_bf16(v0[0], v0[1]); b[1] = cvt_pk_bf16(v0[2], v0[3]); b[2] = cvt_pk_bf16(v1[0], v1[1]); b[3] = cvt_pk_bf16(v1[2], v1[3]);
                        *(u32x4*)((FIRST ? tmp : merged) + (size_t)row * D_ + col) = b; }
        }
    }
};

struct EpiFinal {
    static constexpr bool AFTER_DRAIN = true;
    const u16* resid; float* out; float* part; unsigned* pcnt; const float* gain; float scale;
    __device__ __forceinline__ void operator()(const Acc&, const Unit&, int, int, int, int, int) const {}
    __device__ __forceinline__ void fused(Acc& acc, const Unit& u, int wr, int wc, int fr, int fq, int lane) const {
        const int row0 = u.pm * 256 + wr * 64 + fr, col0 = u.pn * 256 + wc * 32 + fq * 8;
        u32x4 rwa[2][4][2];
#pragma unroll
        for (int ai = 0; ai < 2; ++ai)
#pragma unroll
            for (int m = 0; m < 4; ++m)
#pragma unroll
                for (int bj = 0; bj < 2; ++bj) rwa[ai][m][bj] = *(const u32x4*)(resid + (size_t)(row0 + ai * 128 + m * 16) * D_ + col0 + bj * 128);
#pragma unroll
        for (int ai = 0; ai < 2; ++ai)
#pragma unroll
            for (int m = 0; m < 4; ++m) { float ss = 0.f;
#pragma unroll
                for (int bj = 0; bj < 2; ++bj) { const u32x4 w = rwa[ai][m][bj];
                    f32x4 h0 = (f32x4){bflo(w[0]), bfhi(w[0]), bflo(w[1]), bfhi(w[1])} + acc[ai][bj][m][0] * scale;
                    f32x4 h1 = (f32x4){bflo(w[2]), bfhi(w[2]), bflo(w[3]), bfhi(w[3])} + acc[ai][bj][m][1] * scale;
                    acc[ai][bj][m][0] = h0; acc[ai][bj][m][1] = h1;
                    ss += h0[0] * h0[0] + h0[1] * h0[1] + h0[2] * h0[2] + h0[3] * h0[3] + h1[0] * h1[0] + h1[1] * h1[1] + h1[2] * h1[2] + h1[3] * h1[3]; }
                ss += __shfl_xor(ss, 16); ss += __shfl_xor(ss, 32);
                if (fq == 0) __hip_atomic_store(part + (size_t)(row0 + ai * 128 + m * 16) * 16 + u.pn * 4 + wc, ss, __ATOMIC_RELAXED, __HIP_MEMORY_SCOPE_AGENT); }
        asm volatile("s_waitcnt vmcnt(0)" ::: "memory");
        unsigned* cw = pcnt + u.pm * 16;
        if (lane == 0) {
            __hip_atomic_fetch_add(cw, 1u, __ATOMIC_RELAXED, __HIP_MEMORY_SCOPE_AGENT);
            unsigned sp = 0;
            while (__hip_atomic_load(cw, __ATOMIC_RELAXED, __HIP_MEMORY_SCOPE_AGENT) < 32u) { __builtin_amdgcn_s_sleep(1); if (++sp > (1u << 22)) break; }
        }
        float rinv[2][4];
        { float pv[2][4][4];
#pragma unroll
          for (int ai = 0; ai < 2; ++ai)
#pragma unroll
            for (int m = 0; m < 4; ++m)
#pragma unroll
              for (int k = 0; k < 4; ++k) pv[ai][m][k] = __hip_atomic_load(part + (size_t)(row0 + ai * 128 + m * 16) * 16 + fq * 4 + k, __ATOMIC_RELAXED, __HIP_MEMORY_SCOPE_AGENT);
#pragma unroll
          for (int ai = 0; ai < 2; ++ai)
#pragma unroll
            for (int m = 0; m < 4; ++m) { float sv = (pv[ai][m][0] + pv[ai][m][1]) + (pv[ai][m][2] + pv[ai][m][3]);
                sv += __shfl_xor(sv, 16); sv += __shfl_xor(sv, 32); rinv[ai][m] = __builtin_amdgcn_rsqf(sv * (1.0f / D_) + EPS); } }
        f32x4 gv[2][2];
#pragma unroll
        for (int bj = 0; bj < 2; ++bj)
#pragma unroll
            for (int n = 0; n < 2; ++n) gv[bj][n] = *(const f32x4*)(gain + col0 + bj * 128 + n * 4);
#pragma unroll
        for (int ai = 0; ai < 2; ++ai)
#pragma unroll
            for (int m = 0; m < 4; ++m)
#pragma unroll
                for (int bj = 0; bj < 2; ++bj)
#pragma unroll
                    for (int n = 0; n < 2; ++n)
                        *(f32x4*)(out + (size_t)(row0 + ai * 128 + m * 16) * D_ + col0 + bj * 128 + n * 4) = acc[ai][bj][m][n] * rinv[ai][m] * gv[bj][n];
    }
};

__device__ __forceinline__ int map_gu(int c, int up) { const int pn = c >> 7, w = c & 127, wc = w >> 5, r = w & 31; return pn * 256 + up * 128 + wc * 32 + ((r >> 2) & 1) * 16 + (r >> 3) * 4 + (r & 3); }
__device__ __forceinline__ int map_perm8(int c) { const int r = c & 31; return (c & ~31) + ((r >> 2) & 1) * 16 + (r >> 3) * 4 + (r & 3); }
__device__ __forceinline__ int map_win(int c) { if (c < 1024 && (c & 63) < 16) { const int r = c & 15, x2 = r >> 3, i = r & 7; return (c & ~63) + x2 * 16 + (i >> 2) * 4 + (i & 3); } return map_perm8(c); }

struct TileDesc { const float* W; u16* Wt; const float* gain; int K, N, mode, tile; };
struct TileRegs { f32x4 v[2]; float gk[2]; };
__device__ __forceinline__ void tile_load(TileRegs& r, const TileDesc& d) {
    const int ntn = d.N >> 6, tk = d.tile / ntn, tn = d.tile - tk * ntn, k0 = tk * 64, n0 = tn * 64, tid = threadIdx.x;
    const float cscale = d.mode == 3 ? (n0 < 512 ? 0.125f * 1.4426950408889634f : (n0 >= 1536 && n0 < 2048) ? 0.125f : 1.0f) : 1.0f;
#pragma unroll
    for (int i = 0; i < 2; ++i) { const int e = tid + i * 512, k = e >> 4, c4 = (e & 15) * 4;
        r.v[i] = *(const f32x4*)(d.W + (size_t)(k0 + k) * d.N + n0 + c4); r.gk[i] = (d.gain ? d.gain[k0 + k] : 1.0f) * cscale; }
}
__device__ __forceinline__ void tile_store(LAS float* tl, const TileRegs& r, const TileDesc& d) {
    const int ntn = d.N >> 6, tk = d.tile / ntn, tn = d.tile - tk * ntn, k0 = tk * 64, n0 = tn * 64, tid = threadIdx.x;
    __syncthreads();
#pragma unroll
    for (int i = 0; i < 2; ++i) { const int e = tid + i * 512, k = e >> 4, c4 = (e & 15) * 4; const f32x4 v = r.v[i] * r.gk[i];
        tl[k * 65 + c4] = v[0]; tl[k * 65 + c4 + 1] = v[1]; tl[k * 65 + c4 + 2] = v[2]; tl[k * 65 + c4 + 3] = v[3]; }
    __syncthreads();
    const int n = tid & 63, kg = tid >> 6; float v[8];
#pragma unroll
    for (int i = 0; i < 8; ++i) v[i] = tl[(kg * 8 + i) * 65 + n];
    const int c = n0 + n; const int rr = d.mode == 0 ? c : d.mode == 1 ? map_gu(c, 0) : d.mode == 2 ? map_gu(c, 1) : d.mode == 3 ? map_win(c) : map_perm8(c);
    u32x4 o; o[0] = cvt_pk_bf16(v[0], v[1]); o[1] = cvt_pk_bf16(v[2], v[3]); o[2] = cvt_pk_bf16(v[4], v[5]); o[3] = cvt_pk_bf16(v[6], v[7]);
    *(u32x4*)(d.Wt + (size_t)rr * d.K + k0 + kg * 8) = o;
}

__device__ __forceinline__ void prep_phase(const Params& p, LAS unsigned char* lds) {
    unsigned char* ws = p.ws; LAS float* tl = (LAS float*)lds;
    const int tid = threadIdx.x, lane = tid & 63, wid = tid >> 6, G = gridDim.x;
    if (blockIdx.x == 0) { ((int*)(ws + WS_CNT))[tid] = 0; }
    if (blockIdx.x < 64) ((float*)(ws + WS_KMEAN))[blockIdx.x * 512 + tid] = 0.f;
    constexpr int T_GU = 16 * 44, T_DN = 44 * 16, T_IN = 16 * 80, T_BR = 8 * 16, T_WO = 16 * 16;
    constexpr int o1 = T_GU, o2 = o1 + T_GU, o3 = o2 + T_DN, o4 = o3 + T_IN, o5 = o4 + T_BR, o6 = o5 + T_BR, o7 = o6 + T_WO, o8 = o7 + T_GU, o9 = o8 + T_GU, o10 = o9 + T_DN;
    auto desc = [&](int t) -> TileDesc {
        if (t < o1) return TileDesc{p.g1, (u16*)(ws + WS_GU1), p.n1, D_, DFF, 1, t};
        if (t < o2) return TileDesc{p.u1, (u16*)(ws + WS_GU1), p.n1, D_, DFF, 2, t - o1};
        if (t < o3) return TileDesc{p.d1, (u16*)(ws + WS_DN1), nullptr, DFF, D_, 4, t - o2};
        if (t < o4) return TileDesc{p.win, (u16*)(ws + WS_IN), p.nm, D_, DIN, 3, t - o3};
        if (t < o5) return TileDesc{p.wba, (u16*)(ws + WS_BA), nullptr, 512, D_, 4, t - o4};
        if (t < o6) return TileDesc{p.wbb, (u16*)(ws + WS_BB), nullptr, 512, D_, 4, t - o5};
        if (t < o7) return TileDesc{p.wo, (u16*)(ws + WS_WO), nullptr, D_, D_, 4, t - o6};
        if (t < o8) return TileDesc{p.g2, (u16*)(ws + WS_GU2), p.n2, D_, DFF, 1, t - o7};
        if (t < o9) return TileDesc{p.u2, (u16*)(ws + WS_GU2), p.n2, D_, DFF, 2, t - o8};
        return TileDesc{p.d2, (u16*)(ws + WS_DN2), nullptr, DFF, D_, 4, t - o9};
    };
    const int NPREP = (int)gridDim.x == 256 ? 2 * T_GU : 2 * T_GU + 2 * T_GU + T_DN;
    auto pdesc = [&](int t) -> TileDesc { return t < 2 * T_GU ? desc(t) : desc(t - 2 * T_GU + o7); };
    { int t = blockIdx.x;
      if (t < NPREP) { TileDesc d = pdesc(t); TileRegs ra; tile_load(ra, d);
        for (;;) { const int tn = t + G; const bool more = tn < NPREP; TileDesc dn = d; TileRegs rb = ra;
            if (more) { dn = pdesc(tn); tile_load(rb, dn); }
            tile_store(tl, ra, d);
            if (!more) break;
            d = dn; ra = rb; t = tn; } } }
    u16* xb = (u16*)(ws + WS_AB); float* part0 = (float*)(ws + WS_P0); float* cs = (float*)(ws + WS_CS);
    f32x4 xv[4];
    { const int row0_ = blockIdx.x * 8 + wid; if (row0_ < T_) {
#pragma unroll
        for (int i = 0; i < 4; ++i) xv[i] = *(const f32x4*)(p.x + (size_t)row0_ * D_ + i * 256 + lane * 4); } }
    for (int row = blockIdx.x * 8 + wid; row < T_; row += G * 8) {
        float ss = 0.f; f32x4 cur[4];
#pragma unroll
        for (int i = 0; i < 4; ++i) cur[i] = xv[i];
        if (row + G * 8 < T_) {
#pragma unroll
            for (int i = 0; i < 4; ++i) xv[i] = *(const f32x4*)(p.x + (size_t)(row + G * 8) * D_ + i * 256 + lane * 4); }
#pragma unroll
        for (int i = 0; i < 4; ++i) { const f32x4 v = cur[i]; ss += v[0] * v[0] + v[1] * v[1] + v[2] * v[2] + v[3] * v[3];
            u32x2 b; b[0] = cvt_pk_bf16(v[0], v[1]); b[1] = cvt_pk_bf16(v[2], v[3]); *(u32x2*)(xb + (size_t)row * D_ + i * 256 + lane * 4) = b; }
#pragma unroll
        for (int o = 32; o >= 1; o >>= 1) ss += __shfl_xor(ss, o);
        if (lane < 16) part0[(size_t)row * 16 + lane] = lane == 0 ? ss : 0.f;
        if (lane >= 16 && lane < 24) {
            const int i = lane - 16;
            const float invf = i == 0 ? 1.0f : i == 1 ? 0.1939227432012558f : i == 2 ? 0.03760603070259094f : i == 3 ? 0.007292664609849453f : i == 4 ? 0.0014142135623842478f
                             : i == 5 ? 0.00027424818836152554f : i == 6 ? 5.318296098266728e-05f : 1.0313386155758053e-05f;
            const float ang = (float)p.pos[row] * invf;
            const double a = (double)ang, kk = __builtin_rint(a * 0.15915494309189535), r = a - kk * 6.283185307179586;
            const float rf = (float)r;
            cs[(size_t)row * 16 + i] = __cosf(rf); cs[(size_t)row * 16 + 8 + i] = __sinf(rf);
        }
    }
}


__device__ __forceinline__ void deferred_weights(const Params& p, LAS unsigned char* lds, int j, int nidle, int lo, int hi) {
    unsigned char* ws = p.ws; LAS float* tl = (LAS float*)lds;
    constexpr int T_GU = 16 * 44, T_DN = 44 * 16, T_IN = 16 * 80, T_BR = 8 * 16, T_WO = 16 * 16;
    constexpr int o2 = 2 * T_GU, o3 = o2 + T_DN, o4 = o3 + T_IN, o5 = o4 + T_BR, o6 = o5 + T_BR, o7 = o6 + T_WO, o8 = o7 + T_GU, o9 = o8 + T_GU;
    auto desc = [&](int t) -> TileDesc {
        if (t < o3) return TileDesc{p.d1, (u16*)(ws + WS_DN1), nullptr, DFF, D_, 4, t - o2};
        if (t < o4) return TileDesc{p.win, (u16*)(ws + WS_IN), p.nm, D_, DIN, 3, t - o3};
        if (t < o5) return TileDesc{p.wba, (u16*)(ws + WS_BA), nullptr, 512, D_, 4, t - o4};
        if (t < o6) return TileDesc{p.wbb, (u16*)(ws + WS_BB), nullptr, 512, D_, 4, t - o5};
        if (t < o7) return TileDesc{p.wo, (u16*)(ws + WS_WO), nullptr, D_, D_, 4, t - o6};
        if (t < o8) return TileDesc{p.g2, (u16*)(ws + WS_GU2), p.n2, D_, DFF, 1, t - o7};
        if (t < o9) return TileDesc{p.u2, (u16*)(ws + WS_GU2), p.n2, D_, DFF, 2, t - o8};
        return TileDesc{p.d2, (u16*)(ws + WS_DN2), nullptr, DFF, D_, 4, t - o9};
    };
    int t = lo + j;
    if (t < hi) { TileDesc d = desc(t); TileRegs ra; tile_load(ra, d);
        for (;;) { const int tn = t + nidle; const bool more = tn < hi; TileDesc dn = d; TileRegs rb = ra;
            if (more) { dn = desc(tn); tile_load(rb, dn); }
            tile_store(tl, ra, d);
            if (!more) break;
            d = dn; ra = rb; t = tn; } }
}

__device__ __forceinline__ s16x4 vtr(LAS const unsigned char* p) { typedef short v4i16_t __attribute__((ext_vector_type(4))); return __builtin_bit_cast(s16x4, __builtin_amdgcn_ds_read_tr16_b64_v4i16((LAS v4i16_t*)p)); }

__device__ __forceinline__ void pv_tile(f32x4 (&o)[4], LAS const unsigned char* vs, const bf16x8 (&pf)[2], int lane) {
    const int li = lane & 15, g = lane >> 4, q_ = li >> 2, pp = li & 3;
    LAS const unsigned char* b0 = vs + (4 * g + q_) * 144 + pp * 8;
#pragma unroll
    for (int ks = 0; ks < 2; ++ks)
#pragma unroll
        for (int dt = 0; dt < 4; ++dt) {
            s16x4 lo = vtr(b0 + (32 * ks) * 144 + dt * 32), hi = vtr(b0 + (32 * ks + 16) * 144 + dt * 32);
            bf16x8 va = {lo[0], lo[1], lo[2], lo[3], hi[0], hi[1], hi[2], hi[3]};
            o[dt] = __builtin_amdgcn_mfma_f32_16x16x32_bf16(va, pf[ks], o[dt], 0, 0, 0);
        }
}
__device__ __forceinline__ void pack_p(bf16x8 (&pf)[2], const float (&w)[4][4]) {
#pragma unroll
    for (int ks = 0; ks < 2; ++ks) { u32x4 t; t[0] = cvt_pk_bf16(w[2 * ks][0], w[2 * ks][1]); t[1] = cvt_pk_bf16(w[2 * ks][2], w[2 * ks][3]);
        t[2] = cvt_pk_bf16(w[2 * ks + 1][0], w[2 * ks + 1][1]); t[3] = cvt_pk_bf16(w[2 * ks + 1][2], w[2 * ks + 1][3]); pf[ks] = __builtin_bit_cast(bf16x8, t); }
}
__device__ __forceinline__ void load_qf(bf16x8 (&qf)[2], const u16* qrow, int lane) { const int g = lane >> 4; qf[0] = *(const bf16x8*)(qrow + 8 * g); qf[1] = *(const bf16x8*)(qrow + 32 + 8 * g); }

__device__ __forceinline__ int list_off(int n) { return 256 * (63 * n - (n * (n - 1)) / 2); }

struct Top3 { float v1, v2, v3; int i1, i2, i3; };
__device__ __forceinline__ void top3_insert(Top3& t, float v, int i) {
    const bool b1 = v > t.v1 || (v == t.v1 && i < t.i1), b2 = v > t.v2 || (v == t.v2 && i < t.i2), b3 = v > t.v3 || (v == t.v3 && i < t.i3);
    if (b1) { t.v3 = t.v2; t.i3 = t.i2; t.v2 = t.v1; t.i2 = t.i1; t.v1 = v; t.i1 = i; }
    else if (b2) { t.v3 = t.v2; t.i3 = t.i2; t.v2 = v; t.i2 = i; }
    else if (b3) { t.v3 = v; t.i3 = i; }
}
__device__ __forceinline__ void topk_item(const Params& p, int item, int lane, LAS int* hist  ) {
    const u16* qkva = (const u16*)(p.ws + WS_QKVA); const float* km = (const float*)(p.ws + WS_KMEAN);
    int* cnt = (int*)(p.ws + WS_CNT); u16* list = (u16*)(p.ws + WS_LIST);
    const int h = item & 7, qc = item >> 3, q0 = qc * 64, own = qc >> 2, r = lane & 15, g = lane >> 4;
    if (own == 0) return;
    Top3 tp[4];
#pragma unroll
    for (int qt = 0; qt < 4; ++qt) { tp[qt].v1 = tp[qt].v2 = tp[qt].v3 = -INFINITY; tp[qt].i1 = 0; tp[qt].i2 = 1; tp[qt].i3 = 2; }
    if (own > 3) {
#pragma unroll
        for (int qt = 0; qt < 4; ++qt) { tp[qt].i1 = 1000; tp[qt].i2 = 1001; tp[qt].i3 = 1002; }
        bf16x8 qfr[4][2];
#pragma unroll
        for (int qt = 0; qt < 4; ++qt) load_qf(qfr[qt], qkva + (size_t)(q0 + 16 * qt + r) * LDA_ + h * 64, lane);
        const int ntile = (own + 15) >> 4;
        for (int nt = 0; nt < ntile; ++nt) {
            const int nrow = 16 * nt + r; const bool nv = nrow < own;
            bf16x8 ahi[2], alo[2];
#pragma unroll
            for (int ks = 0; ks < 2; ++ks) { const float* kp = km + (size_t)(nv ? nrow : 0) * 512 + h * 64 + 32 * ks + 8 * g;
                f32x4 a = *(const f32x4*)kp, b = *(const f32x4*)(kp + 4);
                u32x4 hi; hi[0] = cvt_pk_bf16(a[0], a[1]); hi[1] = cvt_pk_bf16(a[2], a[3]); hi[2] = cvt_pk_bf16(b[0], b[1]); hi[3] = cvt_pk_bf16(b[2], b[3]);
                f32x4 ra = {a[0] - bflo(hi[0]), a[1] - bfhi(hi[0]), a[2] - bflo(hi[1]), a[3] - bfhi(hi[1])}, rb = {b[0] - bflo(hi[2]), b[1] - bfhi(hi[2]), b[2] - bflo(hi[3]), b[3] - bfhi(hi[3])};
                u32x4 lo; lo[0] = cvt_pk_bf16(ra[0], ra[1]); lo[1] = cvt_pk_bf16(ra[2], ra[3]); lo[2] = cvt_pk_bf16(rb[0], rb[1]); lo[3] = cvt_pk_bf16(rb[2], rb[3]);
                ahi[ks] = __builtin_bit_cast(bf16x8, hi); alo[ks] = __builtin_bit_cast(bf16x8, lo); }
#pragma unroll
            for (int qt = 0; qt < 4; ++qt) { f32x4 acc = {0.f, 0.f, 0.f, 0.f};
#pragma unroll
                for (int ks = 0; ks < 2; ++ks) { acc = __builtin_amdgcn_mfma_f32_16x16x32_bf16(ahi[ks], qfr[qt][ks], acc, 0, 0, 0); acc = __builtin_amdgcn_mfma_f32_16x16x32_bf16(alo[ks], qfr[qt][ks], acc, 0, 0, 0); }
#pragma unroll
                for (int j = 0; j < 4; ++j) { const int n = 16 * nt + 4 * g + j; if (n < own) top3_insert(tp[qt], acc[j], n); } }
        }
#pragma unroll
        for (int step = 16; step <= 32; step <<= 1)
#pragma unroll
            for (int qt = 0; qt < 4; ++qt) { const float pv1 = __shfl_xor(tp[qt].v1, step), pv2 = __shfl_xor(tp[qt].v2, step), pv3 = __shfl_xor(tp[qt].v3, step);
                const int pi1 = __shfl_xor(tp[qt].i1, step), pi2 = __shfl_xor(tp[qt].i2, step), pi3 = __shfl_xor(tp[qt].i3, step);
                if (pi1 < 1000) top3_insert(tp[qt], pv1, pi1); if (pi2 < 1000) top3_insert(tp[qt], pv2, pi2); if (pi3 < 1000) top3_insert(tp[qt], pv3, pi3); }
    }
    const int nsel = own < 3 ? own : 3;
    volatile LAS int* vh = (volatile LAS int*)hist;
    vh[lane] = 0;
    __builtin_amdgcn_fence(__ATOMIC_RELEASE, "wavefront"); __builtin_amdgcn_wave_barrier();
    int rank[4][3];
    if (g == 0) {
#pragma unroll
        for (int qt = 0; qt < 4; ++qt)
#pragma unroll
            for (int s2 = 0; s2 < 3; ++s2) { const int n = s2 == 0 ? tp[qt].i1 : s2 == 1 ? tp[qt].i2 : tp[qt].i3;
                rank[qt][s2] = s2 < nsel ? __hip_atomic_fetch_add(hist + n, 1, __ATOMIC_RELAXED, __HIP_MEMORY_SCOPE_WORKGROUP) : 0; }
    }
    __builtin_amdgcn_fence(__ATOMIC_ACQ_REL, "wavefront"); __builtin_amdgcn_wave_barrier();
    { const int c = vh[lane]; vh[64 + lane] = c > 0 ? atomicAdd(cnt + h * 64 + lane, c) : 0; }
    __builtin_amdgcn_fence(__ATOMIC_ACQ_REL, "wavefront"); __builtin_amdgcn_wave_barrier();
    if (g == 0) {
#pragma unroll
        for (int qt = 0; qt < 4; ++qt) { const int q = q0 + 16 * qt + r;
#pragma unroll
            for (int s2 = 0; s2 < 3; ++s2) if (s2 < nsel) { const int n = s2 == 0 ? tp[qt].i1 : s2 == 1 ? tp[qt].i2 : tp[qt].i3;
                list[(size_t)h * LISTH + list_off(n) + vh[64 + n] + rank[qt][s2]] = (u16)(q | (s2 << 14)); } }
    }
}

struct CoopKV { u32x4 k, v; };
#define KB_OFF(b) ((b) * 18432)
#define VB_OFF(b) ((b) * 18432 + 9216)
__device__ __forceinline__ void coop_load(CoopKV& c, const u16* kbase, int tid) { const u16* p = kbase + (size_t)(tid >> 3) * LDA_ + 8 * (tid & 7); c.k = *(const u32x4*)p; c.v = *(const u32x4*)(p + 512); }
__device__ __forceinline__ void qk_lds(f32x4 (&acc)[4], LAS const unsigned char* kb, const bf16x8 (&qf)[2], int lane) {
    const int r = lane & 15, g = lane >> 4;
#pragma unroll
    for (int kt = 0; kt < 4; ++kt) { LAS const unsigned char* kp = kb + (16 * kt + r) * 144 + 16 * g;
        bf16x8 k0 = *(LAS const bf16x8*)kp, k1 = *(LAS const bf16x8*)(kp + 64);
        f32x4 z = {0.f, 0.f, 0.f, 0.f};
        z = __builtin_amdgcn_mfma_f32_16x16x32_bf16(k0, qf[0], z, 0, 0, 0);
        acc[kt] = __builtin_amdgcn_mfma_f32_16x16x32_bf16(k1, qf[1], z, 0, 0, 0); }
}
template <bool CAUSAL>
__device__ __forceinline__ void sm_tile_l(LAS const unsigned char* kb, LAS const unsigned char* vb, int key0, int t, const bf16x8 (&qf)[2], float& m, float& l, f32x4 (&o)[4], int lane) {
    const int g = lane >> 4;
    f32x4 acc[4]; qk_lds(acc, kb, qf, lane);
    float s[4][4]; float lm = -INFINITY;
#pragma unroll
    for (int kt = 0; kt < 4; ++kt)
#pragma unroll
        for (int j = 0; j < 4; ++j) { float v = acc[kt][j]; if (CAUSAL && (key0 + 16 * kt + 4 * g + j) > t) v = -INFINITY; s[kt][j] = v; lm = fmaxf(lm, v); }
    lm = fmaxf(lm, __shfl_xor(lm, 16)); lm = fmaxf(lm, __shfl_xor(lm, 32));
    const float mn = fmaxf(m, lm), al = fexp2(m - mn);
    float sum = 0.f;
#pragma unroll
    for (int kt = 0; kt < 4; ++kt)
#pragma unroll
        for (int j = 0; j < 4; ++j) { s[kt][j] = fexp2(s[kt][j] - mn); sum += s[kt][j]; }
    l = l * al + sum; m = mn;
#pragma unroll
    for (int dt = 0; dt < 4; ++dt) o[dt] *= al;
    bf16x8 pf[2]; pack_p(pf, s);
    pv_tile(o, vb, pf, lane);
}

__device__ __forceinline__ void sel_block_stream(const Params& p, LAS unsigned char* lds, LAS const int* sched, int total, int tid, int wid, int lane) {
    const u16* qkva = (const u16*)(p.ws + WS_QKVA); const u16* list = (const u16*)(p.ws + WS_LIST);
    u16* po = (u16*)(p.ws + WS_PO); float* pml = (float*)(p.ws + WS_PML);
    const int r = lane & 15, g = lane >> 4, G = gridDim.x;
    int i = (G & 7) == 0 ? (int)(blockIdx.x & 7) * (G >> 3) + (int)(blockIdx.x >> 3) : (int)blockIdx.x; if (i >= total) return;
#define SELB_DECODE(kk_, H, N, E, OK, ACT) do { const int hn_ = __builtin_amdgcn_readfirstlane(sched[(kk_) * 4]), grp_ = __builtin_amdgcn_readfirstlane(sched[(kk_) * 4 + 1]), c_ = __builtin_amdgcn_readfirstlane(sched[(kk_) * 4 + 2]); \
        H = hn_ >> 6; N = hn_ & 63; const int e0_ = grp_ * 128 + wid * 16; ACT = e0_ < c_; int ei_ = e0_ + r; OK = ei_ < c_; if (!OK) ei_ = ACT ? e0_ : 0; \
        E = list[(size_t)H * LISTH + list_off(N) + ei_]; } while (0)
    int kq = 0; int h, n; unsigned e; bool ok, act; SELB_DECODE(kq, h, n, e, ok, act);
    bf16x8 qf[2]; load_qf(qf, qkva + (size_t)(e & 0x3FFF) * LDA_ + h * 64, lane);
#define KBIG(b_) ((b_) * 73728)
#define VBIG(b_) ((b_) * 73728 + 36864)
    CoopKV cN[4];
    { const u16* kb0 = qkva + (size_t)(n * 256) * LDA_ + 512 + h * 64;
#pragma unroll
      for (int t4 = 0; t4 < 4; ++t4) coop_load(cN[t4], kb0 + (size_t)t4 * 64 * LDA_, tid);
      const int o_ = (tid >> 3) * 144 + (tid & 7) * 16;
#pragma unroll
      for (int t4 = 0; t4 < 4; ++t4) { *(LAS u32x4*)(lds + KBIG(0) + t4 * 9216 + o_) = cN[t4].k; *(LAS u32x4*)(lds + VBIG(0) + t4 * 9216 + o_) = cN[t4].v; } }
    __syncthreads();
    int buf = 0;
    for (;;) {
        const int i2 = i + G; const bool has_next = i2 < total;
        int h2 = 0, n2 = 0; unsigned e2 = 0; bool ok2 = false, act2 = false;
        if (has_next) { SELB_DECODE(kq + 1, h2, n2, e2, ok2, act2);
            const u16* kb2 = qkva + (size_t)(n2 * 256) * LDA_ + 512 + h2 * 64;
#pragma unroll
            for (int t4 = 0; t4 < 4; ++t4) coop_load(cN[t4], kb2 + (size_t)t4 * 64 * LDA_, tid); }
        f32x4 o[4];
#pragma unroll
        for (int q_ = 0; q_ < 4; ++q_) o[q_] = (f32x4){0.f, 0.f, 0.f, 0.f};
        float m = -INFINITY, l = 0.f; bf16x8 qn[2] = {qf[0], qf[1]};
        if (has_next) load_qf(qn, qkva + (size_t)(e2 & 0x3FFF) * LDA_ + h2 * 64, lane);
        if (act) {
#pragma unroll 1
            for (int tile = 0; tile < 4; ++tile) sm_tile_l<false>(lds + KBIG(buf) + tile * 9216, lds + VBIG(buf) + tile * 9216, 0, 0, qf, m, l, o, lane);
            l += __shfl_xor(l, 16); l += __shfl_xor(l, 32);
            const float inv = frcp(l);
            if (ok) { const size_t sidx = ((size_t)(e & 0x3FFF) * NH + h) * 3 + (e >> 14);
#pragma unroll
                for (int dt = 0; dt < 4; ++dt) { u32x2 b; b[0] = cvt_pk_bf16(o[dt][0] * inv, o[dt][1] * inv); b[1] = cvt_pk_bf16(o[dt][2] * inv, o[dt][3] * inv);
                    *(u32x2*)(po + sidx * 64 + 16 * dt + 4 * g) = b; }
                if (g == 0) { pml[sidx * 2] = m; pml[sidx * 2 + 1] = l; } } }
        if (!has_next) break;
        { const int o_ = (tid >> 3) * 144 + (tid & 7) * 16;
#pragma unroll
          for (int t4 = 0; t4 < 4; ++t4) { *(LAS u32x4*)(lds + KBIG(buf ^ 1) + t4 * 9216 + o_) = cN[t4].k; *(LAS u32x4*)(lds + VBIG(buf ^ 1) + t4 * 9216 + o_) = cN[t4].v; } }
        __syncthreads(); buf ^= 1;
        i = i2; ++kq; h = h2; n = n2; e = e2; ok = ok2; act = act2; qf[0] = qn[0]; qf[1] = qn[1];
    }
#undef KBIG
#undef VBIG
#undef SELB_DECODE
}

__device__ __forceinline__ void own_block_stream(const Params& p, LAS unsigned char* lds, int tid, int wid, int lane) {
    const u16* qkva = (const u16*)(p.ws + WS_QKVA); const u16* po = (const u16*)(p.ws + WS_PO); const float* pml = (const float*)(p.ws + WS_PML);
    u16* ya = (u16*)(p.ws + WS_AB);
    const int r = lane & 15, g = lane >> 4, G = gridDim.x, total = (T_ / 128) * NH;
    int i = (G & 7) == 0 ? (int)(blockIdx.x & 7) * (G >> 3) + (int)(blockIdx.x >> 3) : (int)blockIdx.x, kk = 0; if (i >= total) return;
#define OWN_DEC(ii, k_, C, H) do { C = ((ii) >> 3) ^ ((k_) & 1); H = (ii) & 7; } while (0)
    int cch, h; OWN_DEC(i, kk, cch, h);
    bf16x8 qf[2]; load_qf(qf, qkva + (size_t)(cch * 128 + wid * 16 + r) * LDA_ + h * 64, lane);
#define KBIG(b_) ((b_) * 73728)
#define VBIG(b_) ((b_) * 73728 + 36864)
    CoopKV cN[4]; const int o_ = (tid >> 3) * 144 + (tid & 7) * 16;
    { const u16* kb0 = qkva + (size_t)((cch >> 1) * 256) * LDA_ + 512 + h * 64; const int nt0 = (cch & 1) ? 4 : 2;
#pragma unroll
      for (int t4 = 0; t4 < 4; ++t4) if (t4 < nt0) coop_load(cN[t4], kb0 + (size_t)t4 * 64 * LDA_, tid);
#pragma unroll
      for (int t4 = 0; t4 < 4; ++t4) if (t4 < nt0) { *(LAS u32x4*)(lds + KBIG(0) + t4 * 9216 + o_) = cN[t4].k; *(LAS u32x4*)(lds + VBIG(0) + t4 * 9216 + o_) = cN[t4].v; } }
    __syncthreads();
    int buf = 0;
    for (;;) {
        const int i2 = i + G; const bool has_next = i2 < total; int c2 = 0, h2 = 0; OWN_DEC(i2, kk + 1, c2, h2);
        const int own = cch >> 1, q0 = cch * 128 + wid * 16, t = q0 + r, wmax = ((cch & 1) * 128 + wid * 16 + 15) >> 6;
        const int nt2 = (c2 & 1) ? 4 : 2;
        f32x4 o[4];
#pragma unroll
        for (int q_ = 0; q_ < 4; ++q_) o[q_] = (f32x4){0.f, 0.f, 0.f, 0.f};
        float m = -INFINITY, l = 0.f; bf16x8 qn[2] = {qf[0], qf[1]};
        if (has_next) { const u16* kb2 = qkva + (size_t)((c2 >> 1) * 256) * LDA_ + 512 + h2 * 64;
#pragma unroll
            for (int t4 = 0; t4 < 4; ++t4) if (t4 < nt2) coop_load(cN[t4], kb2 + (size_t)t4 * 64 * LDA_, tid);
            load_qf(qn, qkva + (size_t)(c2 * 128 + wid * 16 + r) * LDA_ + h2 * 64, lane); }
        const int nsel = own < 3 ? own : 3;
        const size_t sidx = ((size_t)t * NH + h) * 3;
        float ms[3], lsv[3]; u32x2 pw[3][4];
#pragma unroll
        for (int s2 = 0; s2 < 3; ++s2) { ms[s2] = -INFINITY; lsv[s2] = 0.f;
#pragma unroll
            for (int dt = 0; dt < 4; ++dt) pw[s2][dt] = (u32x2){0u, 0u};
            if (s2 < nsel) { ms[s2] = pml[(sidx + s2) * 2]; lsv[s2] = pml[(sidx + s2) * 2 + 1];
#pragma unroll
                for (int dt = 0; dt < 4; ++dt) pw[s2][dt] = *(const u32x2*)(po + (sidx + s2) * 64 + 16 * dt + 4 * g); } }
#pragma unroll 1
        for (int tile = 0; tile <= wmax; ++tile) sm_tile_l<true>(lds + KBIG(buf) + tile * 9216, lds + VBIG(buf) + tile * 9216, own * 256 + tile * 64, t, qf, m, l, o, lane);
        l += __shfl_xor(l, 16); l += __shfl_xor(l, 32);
        float M = m;
#pragma unroll
        for (int s2 = 0; s2 < 3; ++s2) M = fmaxf(M, ms[s2]);
        const float a0 = fexp2(m - M); float den = l * a0;
#pragma unroll
        for (int dt = 0; dt < 4; ++dt) o[dt] *= a0;
#pragma unroll
        for (int s2 = 0; s2 < 3; ++s2) { const float a = lsv[s2] * fexp2(ms[s2] - M); den += a;
#pragma unroll
            for (int dt = 0; dt < 4; ++dt) { const u32x2 w = pw[s2][dt];
                o[dt][0] += a * bflo(w[0]); o[dt][1] += a * bfhi(w[0]); o[dt][2] += a * bflo(w[1]); o[dt][3] += a * bfhi(w[1]); } }
        const float inv = frcp(den);
#pragma unroll
        for (int dt = 0; dt < 4; ++dt) { u32x2 b; b[0] = cvt_pk_bf16(o[dt][0] * inv, o[dt][1] * inv); b[1] = cvt_pk_bf16(o[dt][2] * inv, o[dt][3] * inv);
            *(u32x2*)(ya + (size_t)t * 512 + h * 64 + 16 * dt + 4 * g) = b; }
        if (!has_next) break;
#pragma unroll
        for (int t4 = 0; t4 < 4; ++t4) if (t4 < nt2) { *(LAS u32x4*)(lds + KBIG(buf ^ 1) + t4 * 9216 + o_) = cN[t4].k; *(LAS u32x4*)(lds + VBIG(buf ^ 1) + t4 * 9216 + o_) = cN[t4].v; }
        __syncthreads(); buf ^= 1;
        i = i2; ++kk; cch = c2; h = h2; qf[0] = qn[0]; qf[1] = qn[1];
    }
#undef KBIG
#undef VBIG
#undef OWN_DEC
}

__device__ __forceinline__ void sb_tile_l(LAS const unsigned char* kb, LAS const unsigned char* vb, int key0, int t, const bf16x8 (&qf)[2], float& R, f32x4 (&o)[4], int lane) {
    const int g = lane >> 4;
    f32x4 acc[4]; qk_lds(acc, kb, qf, lane);
    float lf[4][4], Tk[4], ex[4];
#pragma unroll
    for (int kt = 0; kt < 4; ++kt) { float c = 0.f;
#pragma unroll
        for (int j = 0; j < 4; ++j) { const bool valid = (key0 + 16 * kt + 4 * g + j) < t; const float z = acc[kt][j];
            const float sp = fmaxf(z, 0.f) + __logf(1.0f + __expf(-fabsf(z)));
            acc[kt][j] = z; lf[kt][j] = valid ? -sp : 0.f; c += lf[kt][j]; }
        const float b = __shfl_xor(c, 16), s2 = c + b, d = __shfl_xor(s2, 32);
        Tk[kt] = s2 + d; ex[kt] = ((g & 1) ? 0.f : b) + ((g & 2) ? 0.f : d); }
    float w[4][4]; float run = R;
#pragma unroll
    for (int kt = 3; kt >= 0; --kt) { const float E = run + ex[kt]; float suf = 0.f;
#pragma unroll
        for (int j = 3; j >= 0; --j) { const bool valid = (key0 + 16 * kt + 4 * g + j) < t; w[kt][j] = valid ? __expf(acc[kt][j] + lf[kt][j] + E + suf) : 0.f; suf += lf[kt][j]; }
        run += Tk[kt]; }
    R = run;
    bf16x8 pf[2]; pack_p(pf, w);
    pv_tile(o, vb, pf, lane);
}

__device__ __forceinline__ void sb_block_stream(const Params& p, LAS unsigned char* lds, int tid, int wid, int lane) {
    const u16* qkvb = (const u16*)(p.ws + WS_QKVB); u16* yb = (u16*)(p.ws + WS_AB) + (size_t)T_ * 512;
    const int r = lane & 15, g = lane >> 4, G = gridDim.x, total = (T_ / 128) * NH;
    int i = (G & 7) == 0 ? (int)(blockIdx.x & 7) * (G >> 3) + (int)(blockIdx.x >> 3) : (int)blockIdx.x; if (i >= total) return;
    int cch = i >> 3, h = i & 7;
    bf16x8 qf[2]; load_qf(qf, qkvb + (size_t)(cch * 128 + wid * 16 + r) * LDA_ + h * 64, lane);
#define KBIG(b_) ((b_) * 73728)
#define VBIG(b_) ((b_) * 73728 + 36864)
    CoopKV cN[3]; const int o_ = (tid >> 3) * 144 + (tid & 7) * 16;
    { const int ns0 = cch == 0 ? 2 : 3;
#pragma unroll
      for (int s4 = 0; s4 < 3; ++s4) if (s4 < ns0) coop_load(cN[s4], qkvb + (size_t)((2 * cch + 1 - s4) * 64) * LDA_ + 512 + h * 64, tid);
#pragma unroll
      for (int s4 = 0; s4 < 3; ++s4) if (s4 < ns0) { *(LAS u32x4*)(lds + KBIG(0) + s4 * 9216 + o_) = cN[s4].k; *(LAS u32x4*)(lds + VBIG(0) + s4 * 9216 + o_) = cN[s4].v; } }
    __syncthreads();
    int buf = 0;
    for (;;) {
        const int i2 = i + G; const bool has_next = i2 < total; const int c2 = i2 >> 3, h2 = i2 & 7;
        const int q0 = cch * 128 + wid * 16, t = q0 + r, dw = 2 * cch + (wid >> 2);
        const int nstep = cch == 0 ? 2 : 3, ns2 = c2 == 0 ? 2 : 3;
        const u16* kb = qkvb + 512 + h * 64;
        f32x4 o[4];
#pragma unroll
        for (int q_ = 0; q_ < 4; ++q_) o[q_] = (f32x4){0.f, 0.f, 0.f, 0.f};
        float R = 0.f; bool done = false; bf16x8 qn[2] = {qf[0], qf[1]};
        if (has_next) {
#pragma unroll
            for (int s4 = 0; s4 < 3; ++s4) if (s4 < ns2) coop_load(cN[s4], qkvb + (size_t)((2 * c2 + 1 - s4) * 64) * LDA_ + 512 + h2 * 64, tid);
            load_qf(qn, qkvb + (size_t)(c2 * 128 + wid * 16 + r) * LDA_ + h2 * 64, lane); }
        int tile = 2 * cch + 1;
#pragma unroll 1
        for (int s4 = 0; s4 < nstep; ++s4, --tile)
            if (tile <= dw && !done) { sb_tile_l(lds + KBIG(buf) + s4 * 9216, lds + VBIG(buf) + s4 * 9216, tile * 64, t, qf, R, o, lane);
                done = (tile == 0) || (__builtin_amdgcn_ballot_w64(R > -40.f) == 0ull); }
        if (has_next) {
#pragma unroll
            for (int s4 = 0; s4 < 3; ++s4) if (s4 < ns2) { *(LAS u32x4*)(lds + KBIG(buf ^ 1) + s4 * 9216 + o_) = cN[s4].k; *(LAS u32x4*)(lds + VBIG(buf ^ 1) + s4 * 9216 + o_) = cN[s4].v; } }
        int any = __syncthreads_or(done ? 0 : 1);
        while (any && tile >= 0) {
            CoopKV c3; coop_load(c3, kb + (size_t)(tile * 64) * LDA_, tid);
            *(LAS u32x4*)(lds + KBIG(buf) + o_) = c3.k; *(LAS u32x4*)(lds + VBIG(buf) + o_) = c3.v; __syncthreads();
            if (!done) { sb_tile_l(lds + KBIG(buf), lds + VBIG(buf), tile * 64, t, qf, R, o, lane);
                done = (tile == 0) || (__builtin_amdgcn_ballot_w64(R > -40.f) == 0ull); }
            any = __syncthreads_or(done ? 0 : 1); --tile;
        }
#pragma unroll
        for (int dt = 0; dt < 4; ++dt) { u32x2 b; b[0] = cvt_pk_bf16(o[dt][0], o[dt][1]); b[1] = cvt_pk_bf16(o[dt][2], o[dt][3]);
            *(u32x2*)(yb + (size_t)t * 512 + h * 64 + 16 * dt + 4 * g) = b; }
        if (!has_next) break;
        buf ^= 1;
        i = i2; cch = c2; h = h2; qf[0] = qn[0]; qf[1] = qn[1];
    }
#undef KBIG
#undef VBIG
}

#define XB_TMO      128
#define XB_XCNT(j)  (256  + 64 * (j))
#define XB_XSUB(j)  (1280 + 64 * (j))
#define XB_XGEN(j)  (2304 + 64 * (j))
#define XB_TOP      3328
#define XB_TOPGEN   3392
#define XCD_BAR_WORDS 3456
#define XB_SPIN_CAP (1u << 22)
__device__ __forceinline__ unsigned xb_ld(unsigned* p)              { return __hip_atomic_load(p, __ATOMIC_RELAXED, __HIP_MEMORY_SCOPE_AGENT); }
__device__ __forceinline__ unsigned xb_add(unsigned* p, unsigned v) { return __hip_atomic_fetch_add(p, v, __ATOMIC_RELAXED, __HIP_MEMORY_SCOPE_AGENT); }
__device__ __forceinline__ unsigned xb_xcc_id() { return (unsigned)__builtin_amdgcn_s_getreg((3 << 11) | 20) & 0xFu; }
#define XB_SPIN(cond, bar) do { unsigned _sp = 0; while (cond) { __builtin_amdgcn_s_sleep(1); \
    if ((++_sp & 255u) == 0u) { if (xb_ld(&(bar)[XB_TMO])) break; if (_sp > XB_SPIN_CAP) { atomicAdd(&(bar)[XB_TMO], 1u); break; } } } } while (0)
struct XcdBarrier { unsigned* bar; unsigned x; volatile LAS unsigned* st; };
__device__ __forceinline__ XcdBarrier xcd_barrier_post(unsigned* bar, volatile LAS unsigned* st) {
    XcdBarrier b; b.bar = bar; b.x = xb_xcc_id(); b.st = st;
    if (threadIdx.x == 0) (void)xb_add(&bar[XB_XCNT(b.x)], 1u);
    return b;
}
__device__ __forceinline__ void xcd_barrier_complete(unsigned* bar, unsigned x, unsigned& nloc, unsigned& nx) {
    const unsigned G = gridDim.x * gridDim.y * gridDim.z;
    unsigned sum, cnt, mine, sp = 0u;
    for (;;) {
        sum = 0u; cnt = 0u; mine = 0u;
#pragma unroll
        for (unsigned j = 0; j < 16; ++j) { const unsigned c = xb_ld(&bar[XB_XCNT(j)]); sum += c; cnt += (c > 0u) ? 1u : 0u; mine = (j == x) ? c : mine; }
        if (sum == G) break;
        __builtin_amdgcn_s_sleep(1);
        if ((++sp & 255u) == 0u) { if (xb_ld(&bar[XB_TMO])) break; if (sp > XB_SPIN_CAP) { atomicAdd(&bar[XB_TMO], 1u); break; } }
    }
    nloc = mine > 0u ? mine : 1u; nx = cnt > 0u ? cnt : 1u;
}
__device__ __forceinline__ void xcd_barrier_arrive(const XcdBarrier& b) {
    asm volatile("s_waitcnt vmcnt(0)" ::: "memory");
    __syncthreads();
    if (threadIdx.x == 0) {
        unsigned* bar = b.bar;
        __builtin_amdgcn_s_waitcnt(0);
        unsigned nloc = b.st[0], nx = b.st[1];
        if (nloc == 0u) { xcd_barrier_complete(bar, b.x, nloc, nx); b.st[0] = nloc; b.st[1] = nx; }
        const unsigned old = xb_add(&bar[XB_XSUB(b.x)], 1u);
        const unsigned gen = old / nloc;
        if (old + 1u == (gen + 1u) * nloc) {
            __builtin_amdgcn_fence(__ATOMIC_RELEASE, "agent");
            asm volatile("s_waitcnt vmcnt(0)" ::: "memory");
            const unsigned og = xb_add(&bar[XB_TOP], 1u);
            const unsigned tg = og / nx;
            if (og + 1u == (tg + 1u) * nx) xb_add(&bar[XB_TOPGEN], 1u);
        }
    }
}
__device__ __forceinline__ void xcd_barrier_wait(const XcdBarrier& b) {
    if (threadIdx.x == 0) {
        unsigned* bar = b.bar;
        const unsigned tgen = b.st[2]; b.st[2] = tgen + 1u;
        XB_SPIN(xb_ld(&bar[XB_TOPGEN]) <= tgen, bar);
        __builtin_amdgcn_fence(__ATOMIC_ACQUIRE, "agent");
        asm volatile("s_waitcnt vmcnt(0)" ::: "memory");
    }
    __syncthreads();
}
__device__ __forceinline__ void xcd_barrier(const XcdBarrier& b) { xcd_barrier_arrive(b); xcd_barrier_wait(b); }

#define PH_PROLOG int tid_ = threadIdx.x; asm volatile("" : "+v"(tid_)); const int tid = tid_, lane = tid & 63, wid = __builtin_amdgcn_readfirstlane(tid >> 6); \
    const int G = gridDim.x, W = blockIdx.x * 8 + wid, NW = G * 8; LAS unsigned char* vs = lds + wid * 9216; (void)vs; (void)W; (void)NW; (void)lane; (void)G;
#ifndef REP_MASK
#define REP_MASK 0
#endif
#ifndef REPN
#define REPN 2
#endif
#ifndef EXTRA_SYNCS
#define EXTRA_SYNCS 0
#endif
#define PHASE(N, ...) if constexpr ((PH_MASK >> N) & 1) { if (p.ph_lo <= N && N < p.ph_hi) { \
    for (int rep_ = 0; rep_ < (((REP_MASK >> N) & 1) ? REPN : 1); ++rep_) { if (rep_) xcd_barrier(xb); { PH_PROLOG __VA_ARGS__ } } } } if (p.ph_lo <= N && N + 1 < p.ph_hi) xcd_barrier(xb);
#define PHASE_S(N, SLOT, ...) if constexpr ((PH_MASK >> N) & 1) { if (p.ph_lo <= N && N < p.ph_hi) { { PH_PROLOG __VA_ARGS__ } } } \
    if (p.ph_lo <= N && N + 1 < p.ph_hi) { xcd_barrier_arrive(xb); \
        { constexpr int lo_ = 2 * 16 * 44 + 44 * 16 + 16 * 80 + 2 * 8 * 16 + 16 * 16 + (SLOT) * 512, end_ = 2 * 16 * 44 + 44 * 16 + 16 * 80 + 2 * 8 * 16 + 16 * 16 + 2 * 16 * 44 + 44 * 16; \
          if ((int)gridDim.x == 256) deferred_weights(p, lds, (int)blockIdx.x, 256, lo_, (lo_ + 512 < end_ ? lo_ + 512 : end_)); } \
        xcd_barrier_wait(xb); }

__global__ void __launch_bounds__(512) fwd_megakernel(Params p) {
    extern __shared__ __attribute__((aligned(16))) unsigned char shm_raw[];
    LAS unsigned char* lds = (LAS unsigned char*)shm_raw;
    cg::grid_group grid = cg::this_grid();
    unsigned char* ws = p.ws;
    volatile LAS unsigned* xst = (volatile LAS unsigned*)(lds + XST_OFF);
    if (threadIdx.x == 0) { xst[0] = 0u; xst[1] = 0u; xst[2] = 0u; }
    __syncthreads();
    XcdBarrier xb = xcd_barrier_post(g_sync, xst);
    if (p.use_cg) grid.sync();

    for (int es_ = 0; es_ < EXTRA_SYNCS; ++es_) xcd_barrier(xb);
    PHASE(0, prep_phase(p, lds);)
    PHASE(1, pg8::StaticOrder S; S.init(T_, 2 * DFF, G, blockIdx.x); pg8::Gemm g{(const u16*)(ws + WS_AB), (const u16*)(ws + WS_GU1), T_, 2 * DFF, D_};
             build_rtab(lds, S, (const float*)(ws + WS_P0)); EpiSwiglu E{(u16*)(ws + WS_ACT), lds}; pg8::gemm_phase(lds, g, S, E);
             { const int nfull = (T_ / 256) * (2 * DFF / 256) - 5 * G;
               constexpr int lo_ = 2 * 16 * 44, hi_ = lo_ + 44 * 16 + 16 * 80 + 2 * 8 * 16 + 16 * 16;
               if (nfull >= 0 && nfull < G) { if ((int)blockIdx.x >= nfull) deferred_weights(p, lds, (int)blockIdx.x - nfull, G - nfull, lo_, hi_); }
               else deferred_weights(p, lds, (int)blockIdx.x, G, lo_, hi_); })
    PHASE_S(2, 0, pg8::StaticOrder S; S.init(T_, D_, G, blockIdx.x); pg8::Gemm g{(const u16*)(ws + WS_ACT), (const u16*)(ws + WS_DN1), T_, D_, DFF};
             EpiResid<false> E{(const u16*)(ws + WS_AB), nullptr, (u16*)p.out, (float*)(ws + WS_P1), 0.5f}; pg8::gemm_phase(lds, g, S, E);)
    PHASE_S(3, 1, pg8::StaticOrder S; S.init(T_, DIN, G, blockIdx.x); pg8::Gemm g{(const u16*)p.out, (const u16*)(ws + WS_IN), T_, DIN, D_};
             build_rtab(lds, S, (const float*)(ws + WS_P1)); EpiWin E{(u16*)(ws + WS_QKVA), (u16*)(ws + WS_QKVB), (u16*)(ws + WS_GATES), lds, (const float*)(ws + WS_CS), p.bg, (float*)(ws + WS_KMEAN)}; pg8::gemm_phase(lds, g, S, E);)
    PHASE_S(4, 2, for (int i = W; i < (T_ / 64) * NH; i += NW) topk_item(p, i, lane, (LAS int*)(lds + wid * 512));
             __syncthreads(); sb_block_stream(p, lds, tid, wid, lane); __syncthreads();)
    PHASE_S(6, 3, LAS int* pref = (LAS int*)(lds + 96 * 1024); const int* cnt = (const int*)(ws + WS_CNT);
             __syncthreads();
             pref[tid] = (cnt[tid] + 127) >> 7; __syncthreads();
             for (int o = 1; o < 512; o <<= 1) { const int v = tid >= o ? pref[tid - o] : 0; __syncthreads(); pref[tid] += v; __syncthreads(); }
             const int total = pref[511];
             LAS int* sched = (LAS int*)(lds + 148 * 1024);
             { const int slot0 = (G & 7) == 0 ? (int)(blockIdx.x & 7) * (G >> 3) + (int)(blockIdx.x >> 3) : (int)blockIdx.x; const int ii = slot0 + tid * G;
               if (tid < 64 && ii < total) { int lo = 0; int hi = 511; while (lo < hi) { const int mid = (lo + hi) >> 1; if (pref[mid] > ii) hi = mid; else lo = mid + 1; }
                   sched[tid * 4] = lo; sched[tid * 4 + 1] = ii - (lo ? pref[lo - 1] : 0); sched[tid * 4 + 2] = cnt[lo]; } }
             __syncthreads();
             sel_block_stream(p, lds, sched, total, tid, wid, lane);
             __syncthreads();)
    PHASE_S(7, 4, __syncthreads(); own_block_stream(p, lds, tid, wid, lane); __syncthreads();)
    PHASE(8, { pg8::StaticOrder S; S.init(T_, D_, G, blockIdx.x); pg8::Gemm g{(const u16*)(ws + WS_AB), (const u16*)(ws + WS_BA), T_, D_, 512};
               EpiBranch<true> E{(const u16*)(ws + WS_GATES), (u16*)(ws + WS_TMP), (u16*)(ws + WS_MERGED)}; pg8::gemm_phase(lds, g, S, E); }
             { pg8::StaticOrder S; S.init(T_, D_, G, blockIdx.x); pg8::Gemm g{(const u16*)(ws + WS_AB) + (size_t)T_ * 512, (const u16*)(ws + WS_BB), T_, D_, 512};
               EpiBranch<false> E{(const u16*)(ws + WS_GATES), (u16*)(ws + WS_TMP), (u16*)(ws + WS_MERGED)}; pg8::gemm_phase(lds, g, S, E); })
    PHASE(9, pg8::StaticOrder S; S.init(T_, D_, G, blockIdx.x); pg8::Gemm g{(const u16*)(ws + WS_MERGED), (const u16*)(ws + WS_WO), T_, D_, D_};
             EpiResid<false> E{(const u16*)p.out, nullptr, (u16*)(ws + WS_AB), (float*)(ws + WS_P2), 1.0f}; pg8::gemm_phase(lds, g, S, E);)
    PHASE(10, pg8::StaticOrder S; S.init(T_, 2 * DFF, G, blockIdx.x); pg8::Gemm g{(const u16*)(ws + WS_AB), (const u16*)(ws + WS_GU2), T_, 2 * DFF, D_};
              build_rtab(lds, S, (const float*)(ws + WS_P2)); EpiSwiglu E{(u16*)(ws + WS_ACT), lds}; pg8::gemm_phase(lds, g, S, E);)
    PHASE(11, pg8::StaticOrder S; S.init(T_, D_, G, blockIdx.x); pg8::Gemm g{(const u16*)(ws + WS_ACT), (const u16*)(ws + WS_DN2), T_, D_, DFF};
              EpiFinal E{(const u16*)(ws + WS_AB), p.out, (float*)(ws + WS_P3), g_sync + 4096, p.nf, 0.5f}; pg8::gemm_phase(lds, g, S, E);)
    asm volatile("s_waitcnt vmcnt(0)" ::: "memory");
    __syncthreads();
    if (threadIdx.x == 0) xst[3] = (__hip_atomic_fetch_add(&g_sync[8192], 1u, __ATOMIC_RELAXED, __HIP_MEMORY_SCOPE_AGENT) == gridDim.x - 1u) ? 1u : 0u;
    __syncthreads();
    if (xst[3]) { for (int i2 = threadIdx.x; i2 < 8192; i2 += 512) g_sync[i2] = 0u; if (threadIdx.x == 0) g_sync[8192] = 0u; }
}

extern "C" void kernel_launch(void* const* d_in, const int* in_sizes, int n_in, void* d_out, int out_size, void* d_ws, size_t ws_size, hipStream_t stream) {
    constexpr int LDS_BYTES = 152 * 1024 + 64 + 7 * 1024;
    static int grid = 0;
    if (grid == 0) {
        int dev = 0, cus = 0, per_cu = 0;
        hipGetDevice(&dev); hipDeviceGetAttribute(&cus, hipDeviceAttributeMultiprocessorCount, dev);
        hipFuncSetAttribute((const void*)fwd_megakernel, hipFuncAttributeMaxDynamicSharedMemorySize, LDS_BYTES);
        hipOccupancyMaxActiveBlocksPerMultiprocessor(&per_cu, (const void*)fwd_megakernel, 512, LDS_BYTES);
        if (per_cu < 1) { fprintf(stderr, "occupancy query says %d blocks/CU\n", per_cu); per_cu = 1; }
        (void)hipGetLastError();
        grid = cus;
        if (ws_size < WS_END) { fprintf(stderr, "workspace too small: %zu < %zu\n", ws_size, (size_t)WS_END); grid = -1; }
    }
    if (grid < 0) return;
    Params p{};
    p.x = (const float*)d_in[0]; p.pos = (const int*)d_in[1];
    p.n1 = (const float*)d_in[2]; p.g1 = (const float*)d_in[3]; p.u1 = (const float*)d_in[4]; p.d1 = (const float*)d_in[5];
    p.nm = (const float*)d_in[6]; p.win = (const float*)d_in[7]; p.bg = (const float*)d_in[8]; p.wba = (const float*)d_in[9]; p.wbb = (const float*)d_in[10]; p.wo = (const float*)d_in[11];
    p.n2 = (const float*)d_in[12]; p.g2 = (const float*)d_in[13]; p.u2 = (const float*)d_in[14]; p.d2 = (const float*)d_in[15]; p.nf = (const float*)d_in[16];
    p.out = (float*)d_out; p.ws = (unsigned char*)d_ws;
#ifndef ONE_LAUNCH
#define ONE_LAUNCH 1
#endif
#if ONE_LAUNCH
    p.ph_lo = 0; p.ph_hi = N_PHASES;
    void* args[] = {&p};
    hipError_t e = hipLaunchCooperativeKernel((const void*)fwd_megakernel, dim3(grid), dim3(512), args, LDS_BYTES, stream);
    if (e != hipSuccess) fprintf(stderr, "cooperative launch failed: %s (grid %d)\n", hipGetErrorString(e), grid);
#else
#ifndef DBG_MASK
#define DBG_MASK 0x1fff
#endif
#ifndef DBG_FPART
#define DBG_FPART 0
#endif
    p.fpart = DBG_FPART;
    for (int ph = 0; ph < N_PHASES; ++ph) { if (!((DBG_MASK >> ph) & 1)) continue; p.ph_lo = ph; p.ph_hi = ph + 1; hipLaunchKernelGGL(fwd_megakernel, dim3(grid), dim3(512), LDS_BYTES, stream, p); }
#endif
}
```

```cpp
#include <hip/hip_runtime.h>
#include <hip/hip_cooperative_groups.h>
#include <cstdio>
namespace cg = cooperative_groups;

#define LAS __attribute__((address_space(3)))
typedef unsigned short u16;
typedef short bf16x8 __attribute__((ext_vector_type(8)));
typedef short s16x4 __attribute__((ext_vector_type(4)));
typedef float f32x4 __attribute__((ext_vector_type(4)));
typedef unsigned u32x4 __attribute__((ext_vector_type(4)));
typedef unsigned u32x2 __attribute__((ext_vector_type(2)));

constexpr int T_ = 16384, D_ = 1024, DFF = 2816, DIN = 5120, NH = 8, HD = 64;
constexpr int LDA_ = 1536;
constexpr float EPS = 1e-6f;
constexpr int LISTH = 256 * 2016;
constexpr int N_PHASES = 12;
#ifndef PH_MASK
#define PH_MASK 0x1fff
#endif

constexpr size_t SZ_GU = (size_t)2 * DFF * D_ * 2, SZ_DN = (size_t)D_ * DFF * 2, SZ_IN = (size_t)DIN * D_ * 2, SZ_BR = (size_t)D_ * 512 * 2, SZ_WO = (size_t)D_ * D_ * 2;
constexpr size_t WS_GU1 = 0, WS_DN1 = WS_GU1 + SZ_GU, WS_IN = WS_DN1 + SZ_DN, WS_BA = WS_IN + SZ_IN, WS_BB = WS_BA + SZ_BR, WS_WO = WS_BB + SZ_BR,
                 WS_GU2 = WS_WO + SZ_WO, WS_DN2 = WS_GU2 + SZ_GU, WS_CS = WS_DN2 + SZ_DN;
constexpr size_t SZ_PART = (size_t)T_ * 16 * 4;
constexpr size_t WS_P0 = WS_CS + (size_t)T_ * 16 * 4, WS_P1 = WS_P0 + SZ_PART, WS_P2 = WS_P1 + SZ_PART, WS_P3 = WS_P2 + SZ_PART;
constexpr size_t WS_KMEAN = WS_P3 + SZ_PART, WS_CNT = WS_KMEAN + (size_t)64 * 2 * 512 * 4, WS_BAR = WS_CNT + 4096, WS_PML = WS_BAR + 32768;
constexpr size_t WS_LIST = WS_PML + (size_t)T_ * NH * 3 * 2 * 4;
constexpr size_t WS_AB = WS_LIST + (size_t)NH * LISTH * 2;
constexpr size_t WS_BIG = WS_AB + (size_t)T_ * D_ * 2;
constexpr size_t SZ_QKV = (size_t)T_ * LDA_ * 2;
constexpr size_t WS_GATES = WS_BIG, WS_QKVA = WS_GATES + (size_t)T_ * 2048 * 2, WS_QKVB = WS_QKVA + SZ_QKV, WS_END = WS_QKVB + SZ_QKV;
constexpr size_t WS_ACT = WS_BIG, WS_TMP = WS_QKVA, WS_MERGED = WS_TMP + (size_t)T_ * D_ * 4, WS_PO = WS_QKVB;
static_assert(WS_END <= (size_t)256 * 1024 * 1024, "workspace");
static_assert(WS_AB % 256 == 0 && WS_BIG % 256 == 0 && WS_LIST % 16 == 0, "align");

__device__ unsigned g_sync[8192 + 64];

struct Params {
    const float* x; const int* pos;
    const float *n1, *g1, *u1, *d1, *nm, *win, *bg, *wba, *wbb, *wo, *n2, *g2, *u2, *d2, *nf;
    float* out; unsigned char* ws;
    int ph_lo, ph_hi, fpart, use_cg;
};

typedef __bf16 bf16x2_t __attribute__((ext_vector_type(2)));
typedef float f32x2_t __attribute__((ext_vector_type(2)));
__device__ __forceinline__ unsigned cvt_pk_bf16(float lo, float hi) { f32x2_t v = {lo, hi}; bf16x2_t b = __builtin_convertvector(v, bf16x2_t); return __builtin_bit_cast(unsigned, b); }
__device__ __forceinline__ float bf2f(u16 b) { return __uint_as_float(((unsigned)b) << 16); }
__device__ __forceinline__ float bflo(unsigned w) { return __uint_as_float(w << 16); }
__device__ __forceinline__ float bfhi(unsigned w) { return __uint_as_float(w & 0xffff0000u); }
__device__ __forceinline__ float fexp2(float x) { return __builtin_amdgcn_exp2f(x); }
__device__ __forceinline__ float frcp(float x) { return __builtin_amdgcn_rcpf(x); }

namespace pg8 {
constexpr int BM = 256, BK = 64, HALF = 128, HTB = HALF * BK * 2, STAGE_BYTES = 8 * HTB, NXCD = 8, WGM = 8;
__host__ __device__ __forceinline__ int lds_byte(int r, int c) { const int st = (r >> 4) * 2 + (c >> 5), rr = r & 15, cc = c & 31, ob = rr * 64 + cc * 2; return st * 1024 + (ob ^ (((ob >> 9) & 1) << 5)); }
__host__ __device__ __forceinline__ void stage_rc(int b, int& R, int& C) { const int st = b / 1024, sb = b % 1024, swz = sb ^ (((sb >> 9) & 1) << 5); R = (st >> 1) * 16 + swz / 64; C = (st & 1) * 32 + (swz % 64) / 2; }
struct Unit { int pm, pn; };
struct Gemm { const u16* A; const u16* Bt; int M, N, K; };
struct StaticOrder {
    int nM, nN, nwg, G, c;
    __host__ __device__ void init(int M, int N, int G_, int c_) { nM = M / BM; nN = N / BM; nwg = nM * nN; G = G_; c = c_; }
    __host__ __device__ bool next(int i, Unit& u) const {
        const long L = (long)i * G + c; if (L >= nwg) return false;
        int wgid = (int)L; { const int q = nwg / NXCD, r = nwg % NXCD, xcd = wgid % NXCD, off = wgid / NXCD; wgid = (xcd < r ? xcd * (q + 1) : r * (q + 1) + (xcd - r) * q) + off; }
        const int nig = WGM * nN, gid = wgid / nig, fm = gid * WGM, gsz = (nM - fm) < WGM ? (nM - fm) : WGM;
        u.pm = fm + ((wgid % nig) % gsz); u.pn = (wgid % nig) / gsz; return true;
    }
};

template <class Epi>
__device__ __forceinline__ void gemm_phase(LAS unsigned char* lds, const Gemm g, const StaticOrder& S, const Epi& E) {
    int tid_ = threadIdx.x; asm volatile("" : "+v"(tid_));
    const int tid = tid_, wid = __builtin_amdgcn_readfirstlane(tid >> 6), lane = tid & 63, wr = wid >> 2, wc = wid & 3, fr = lane & 15, fq = lane >> 4;
    const int K = g.K, nt = K / BK;
    unsigned voffA[2];
#pragma unroll
    for (int i = 0; i < 2; ++i) { int R, C; stage_rc(tid * 16 + i * 8192, R, C); voffA[i] = (unsigned)(R * K + C) * 2u; }
    const size_t kstep = (size_t)(BK * 2);
    const size_t hstep = (size_t)HALF * K * 2;
    const size_t tstep = 2 * hstep;
    const unsigned ldsw = (unsigned)wid * 1024u;
    const int aoff = lds_byte(wr * 64 + fr, fq * 8), boff = lds_byte(wc * 32 + fr, fq * 8);
#define PG8_SA(b, h) (((b) * 2 + (h)) * HTB)
#define PG8_SB(b, h) ((4 + (b) * 2 + (h)) * HTB)
#define PG8_STAGE(bufoff, gbase, voff) do { _Pragma("unroll") for (int _i = 0; _i < 2; ++_i) \
        __builtin_amdgcn_global_load_lds((const unsigned*)((const char*)(gbase) + (voff)[_i]), (LAS unsigned*)(lds + (bufoff) + ldsw + _i * 8192), 16, 0, 0); } while (0)
#define PG8_LDA(dst, b, h) do { _Pragma("unroll") for (int m = 0; m < 4; ++m) _Pragma("unroll") for (int k = 0; k < 2; ++k) dst[m][k] = *(const LAS bf16x8*)(lds + PG8_SA(b, h) + aoff + m * 2048 + k * 1024); } while (0)
#define PG8_LDB(dst, b, h) do { _Pragma("unroll") for (int n = 0; n < 2; ++n) _Pragma("unroll") for (int k = 0; k < 2; ++k) dst[n][k] = *(const LAS bf16x8*)(lds + PG8_SB(b, h) + boff + n * 2048 + k * 1024); } while (0)
#define PG8_MMA(ai, bj, At, Bt) do { __builtin_amdgcn_s_setprio(1); _Pragma("unroll") for (int m = 0; m < 4; ++m) _Pragma("unroll") for (int n = 0; n < 2; ++n) _Pragma("unroll") for (int k = 0; k < 2; ++k) \
        acc[ai][bj][m][n] = __builtin_amdgcn_mfma_f32_16x16x32_bf16(Bt[n][k], At[m][k], acc[ai][bj][m][n], 0, 0, 0); __builtin_amdgcn_s_setprio(0); } while (0)
#define PG8_WAIT_V(n) asm volatile("s_waitcnt vmcnt(" #n ")" ::: "memory")
#define PG8_WAIT_L(n) asm volatile("s_waitcnt lgkmcnt(" #n ")" ::: "memory")
#define PG8_BAR __builtin_amdgcn_s_barrier()
#define PG8_SCHED __builtin_amdgcn_sched_barrier(0)
    Unit cur, nxt; int ui = 0;
    if (!S.next(0, cur)) return;
    f32x4 acc[2][2][4][2];
#pragma unroll
    for (int a = 0; a < 2; ++a)
#pragma unroll
        for (int b = 0; b < 2; ++b)
#pragma unroll
            for (int m = 0; m < 4; ++m)
#pragma unroll
                for (int n = 0; n < 2; ++n) acc[a][b][m][n] = (f32x4){0.f, 0.f, 0.f, 0.f};
    bf16x8 At[4][2], B0[2][2], B1[2][2];
    const char* cA = (const char*)g.A + (size_t)cur.pm * tstep; const char* cB = (const char*)g.Bt + (size_t)cur.pn * tstep;
    PG8_STAGE(PG8_SB(0, 0), cB, voffA); PG8_STAGE(PG8_SA(0, 0), cA, voffA); PG8_STAGE(PG8_SB(0, 1), cB + hstep, voffA); PG8_STAGE(PG8_SA(0, 1), cA + hstep, voffA);
    if (wr == 1) PG8_BAR;
    PG8_WAIT_V(4); PG8_BAR;
    PG8_STAGE(PG8_SB(1, 0), cB + kstep, voffA); PG8_STAGE(PG8_SA(1, 0), cA + kstep, voffA); PG8_STAGE(PG8_SB(1, 1), cB + hstep + kstep, voffA);
    PG8_WAIT_V(6); PG8_BAR;
    for (;;) {
        const bool has_next = S.next(ui + 1, nxt);
        const char* nA = has_next ? (const char*)g.A + (size_t)nxt.pm * tstep : cA; const char* nB = has_next ? (const char*)g.Bt + (size_t)nxt.pn * tstep : cB;
        for (int t = 0; t < nt; t += 2) {
            const bool last = (t == nt - 2);
            const char* a1 = cA + (size_t)(t + 1) * kstep;
            const char* a2 = last ? nA : cA + (size_t)(t + 2) * kstep; const char* b2 = last ? nB : cB + (size_t)(t + 2) * kstep;
            const char* a3 = a2 + kstep; const char* b3 = b2 + kstep;
            PG8_LDB(B0, 0, 0); PG8_SCHED; PG8_LDA(At, 0, 0); PG8_STAGE(PG8_SA(1, 1), a1 + hstep, voffA);
            PG8_WAIT_L(8); PG8_BAR; PG8_WAIT_L(0); PG8_MMA(0, 0, At, B0); PG8_BAR; PG8_SCHED;
            PG8_LDB(B1, 0, 1); PG8_STAGE(PG8_SB(0, 0), b2, voffA);
            PG8_BAR; PG8_WAIT_L(0); PG8_MMA(0, 1, At, B1); PG8_BAR;
            PG8_LDA(At, 0, 1); PG8_STAGE(PG8_SA(0, 0), a2, voffA);
            PG8_BAR; PG8_WAIT_L(0); PG8_MMA(1, 0, At, B0); PG8_BAR; PG8_SCHED;
            PG8_STAGE(PG8_SB(0, 1), b2 + hstep, voffA);
            PG8_WAIT_V(6); PG8_BAR; PG8_MMA(1, 1, At, B1); PG8_BAR;
            PG8_LDB(B0, 1, 0); PG8_SCHED; PG8_LDA(At, 1, 0); PG8_STAGE(PG8_SA(0, 1), a2 + hstep, voffA);
            PG8_WAIT_L(8); PG8_BAR; PG8_WAIT_L(0); PG8_MMA(0, 0, At, B0); PG8_BAR; PG8_SCHED;
            PG8_LDB(B1, 1, 1); PG8_STAGE(PG8_SB(1, 0), b3, voffA);
            PG8_BAR; PG8_WAIT_L(0); PG8_MMA(0, 1, At, B1); PG8_BAR;
            PG8_LDA(At, 1, 1); PG8_STAGE(PG8_SA(1, 0), a3, voffA);
            PG8_BAR; PG8_WAIT_L(0); PG8_MMA(1, 0, At, B0); PG8_BAR; PG8_SCHED;
            PG8_STAGE(PG8_SB(1, 1), b3 + hstep, voffA);
            PG8_WAIT_V(6); PG8_BAR; PG8_MMA(1, 1, At, B1); PG8_BAR;
        }
        if constexpr (!Epi::AFTER_DRAIN) E(acc, cur, ui, wr, wc, fr, fq);
        if (!has_next) break;
#pragma unroll
        for (int a = 0; a < 2; ++a)
#pragma unroll
            for (int b = 0; b < 2; ++b)
#pragma unroll
                for (int m = 0; m < 4; ++m)
#pragma unroll
                    for (int n = 0; n < 2; ++n) acc[a][b][m][n] = (f32x4){0.f, 0.f, 0.f, 0.f};
        cur = nxt; cA = nA; cB = nB; ++ui;
    }
    PG8_WAIT_V(0);
    if (wr == 0) PG8_BAR;
    PG8_BAR;
    if constexpr (Epi::AFTER_DRAIN) E.fused(acc, cur, wr, wc, fr, fq, lane);
#undef PG8_SA
#undef PG8_SB
#undef PG8_STAGE
#undef PG8_LDA
#undef PG8_LDB
#undef PG8_MMA
#undef PG8_WAIT_V
#undef PG8_WAIT_L
#undef PG8_BAR
#undef PG8_SCHED
}
}
using pg8::Unit;
typedef f32x4 Acc[2][2][4][2];

constexpr int XST_OFF = 152 * 1024, RTAB_OFF = XST_OFF + 64;
__device__ __forceinline__ void build_rtab(LAS unsigned char* lds, const pg8::StaticOrder& S, const float* part) {
    LAS float* rtab = (LAS float*)(lds + RTAB_OFF);
    int nu = 0; { pg8::Unit u; while (nu < 7 && S.next(nu, u)) ++nu; }
    for (int idx = threadIdx.x; idx < nu * 256; idx += 512) { pg8::Unit u; S.next(idx >> 8, u);
        const f32x4* pp = (const f32x4*)(part + (size_t)(u.pm * 256 + (idx & 255)) * 16);
        f32x4 a = pp[0], b = pp[1], c = pp[2], d = pp[3]; f32x4 sv = (a + b) + (c + d);
        rtab[idx] = __builtin_amdgcn_rsqf((sv[0] + sv[1] + sv[2] + sv[3]) * (1.0f / D_) + EPS); }
    __syncthreads();
}
__device__ __forceinline__ void rtab_get(float (&rinv)[2][4], LAS const unsigned char* lds, int ui, int wr, int fr) {
    LAS const float* rtab = (LAS const float*)(lds + RTAB_OFF) + ui * 256 + wr * 64 + fr;
#pragma unroll
    for (int ai = 0; ai < 2; ++ai)
#pragma unroll
        for (int m = 0; m < 4; ++m) rinv[ai][m] = rtab[ai * 128 + m * 16];
}

struct EpiSwiglu {
    static constexpr bool AFTER_DRAIN = false;
    u16* act; LAS const unsigned char* lds;
    __device__ __forceinline__ void operator()(const Acc& acc, const Unit& u, int ui, int wr, int wc, int fr, int fq) const {
        const int row0 = u.pm * 256 + wr * 64 + fr, col0 = u.pn * 128 + wc * 32 + fq * 8;
        float rinv[2][4]; rtab_get(rinv, lds, ui, wr, fr);
#pragma unroll
        for (int ai = 0; ai < 2; ++ai)
#pragma unroll
            for (int m = 0; m < 4; ++m) {
                const float ri = rinv[ai][m]; float v[8];
#pragma unroll
                for (int n = 0; n < 2; ++n)
#pragma unroll
                    for (int j = 0; j < 4; ++j) { const float g = acc[ai][0][m][n][j] * ri, up = acc[ai][1][m][n][j] * ri;
                        v[n * 4 + j] = g * frcp(1.0f + fexp2(-1.4426950408889634f * g)) * up; }
                u32x4 o; o[0] = cvt_pk_bf16(v[0], v[1]); o[1] = cvt_pk_bf16(v[2], v[3]); o[2] = cvt_pk_bf16(v[4], v[5]); o[3] = cvt_pk_bf16(v[6], v[7]);
                *(u32x4*)(act + (size_t)(row0 + ai * 128 + m * 16) * DFF + col0) = o;
            }
    }
};

template <bool OF> struct EpiResid {
    static constexpr bool AFTER_DRAIN = true;
    const u16* resid; float* out; u16* hb; float* part; float scale;
    __device__ __forceinline__ void fused(Acc& acc, const Unit& u, int wr, int wc, int fr, int fq, int) const { (*this)(acc, u, 0, wr, wc, fr, fq); }
    __device__ __forceinline__ void operator()(const Acc& acc, const Unit& u, int ui, int wr, int wc, int fr, int fq) const {
        const int row0 = u.pm * 256 + wr * 64 + fr, col0 = u.pn * 256 + wc * 32 + fq * 8;
        u32x4 rwa[2][4][2];
#pragma unroll
        for (int ai = 0; ai < 2; ++ai)
#pragma unroll
            for (int m = 0; m < 4; ++m)
#pragma unroll
                for (int bj = 0; bj < 2; ++bj) rwa[ai][m][bj] = *(const u32x4*)(resid + (size_t)(row0 + ai * 128 + m * 16) * D_ + col0 + bj * 128);
#pragma unroll
        for (int ai = 0; ai < 2; ++ai) {
#pragma unroll
            for (int m = 0; m < 4; ++m) {
                const int row = row0 + ai * 128 + m * 16; float ss = 0.f;
#pragma unroll
                for (int bj = 0; bj < 2; ++bj) {
                    const size_t o = (size_t)row * D_ + col0 + bj * 128;
                    const u32x4 w = rwa[ai][m][bj];
                    f32x4 h0 = (f32x4){bflo(w[0]), bfhi(w[0]), bflo(w[1]), bfhi(w[1])} + acc[ai][bj][m][0] * scale;
                    f32x4 h1 = (f32x4){bflo(w[2]), bfhi(w[2]), bflo(w[3]), bfhi(w[3])} + acc[ai][bj][m][1] * scale;
                    ss += h0[0] * h0[0] + h0[1] * h0[1] + h0[2] * h0[2] + h0[3] * h0[3] + h1[0] * h1[0] + h1[1] * h1[1] + h1[2] * h1[2] + h1[3] * h1[3];
                    if (OF) { *(f32x4*)(out + o) = h0; *(f32x4*)(out + o + 4) = h1; }
                    else { u32x4 b; b[0] = cvt_pk_bf16(h0[0], h0[1]); b[1] = cvt_pk_bf16(h0[2], h0[3]); b[2] = cvt_pk_bf16(h1[0], h1[1]); b[3] = cvt_pk_bf16(h1[2], h1[3]); *(u32x4*)(hb + o) = b; }
                }
                ss += __shfl_xor(ss, 16); ss += __shfl_xor(ss, 32);
                if (fq == 0) part[(size_t)row * 16 + u.pn * 4 + wc] = ss;
            }
        }
    }
};

struct EpiWin {
    static constexpr bool AFTER_DRAIN = false;
    u16 *qkva, *qkvb, *gates; LAS const unsigned char* lds; const float *cs, *bgate; float* kmp;
    __device__ __forceinline__ void operator()(const Acc& acc, const Unit& u, int ui, int wr, int wc, int fr, int fq) const {
        const int row0 = u.pm * 256 + wr * 64 + fr;
        const int pn = u.pn;
        LAS const float* rtab = (LAS const float*)(lds + RTAB_OFF) + ui * 256 + wr * 64 + fr;
        if (pn >= 12) {
            f32x4 bb[2][2];
#pragma unroll
            for (int bj = 0; bj < 2; ++bj) { const int gc = pn * 256 + bj * 128 + wc * 32 - 3072 + fq * 8; bb[bj][0] = *(const f32x4*)(bgate + gc); bb[bj][1] = *(const f32x4*)(bgate + gc + 4); }
#pragma unroll
            for (int bj = 0; bj < 2; ++bj) { const int gc = pn * 256 + bj * 128 + wc * 32 - 3072 + fq * 8;
#pragma unroll
                for (int ai = 0; ai < 2; ++ai)
#pragma unroll
                    for (int m = 0; m < 4; ++m) { const float ri = rtab[ai * 128 + m * 16]; float v[8];
#pragma unroll
                        for (int j = 0; j < 4; ++j) { v[j] = acc[ai][bj][m][0][j] * ri + bb[bj][0][j]; v[4 + j] = acc[ai][bj][m][1][j] * ri + bb[bj][1][j]; }
#pragma unroll
                        for (int j = 0; j < 8; ++j) v[j] = frcp(1.0f + fexp2(-1.4426950408889634f * v[j]));
                        u32x4 o; o[0] = cvt_pk_bf16(v[0], v[1]); o[1] = cvt_pk_bf16(v[2], v[3]); o[2] = cvt_pk_bf16(v[4], v[5]); o[3] = cvt_pk_bf16(v[6], v[7]);
                        *(u32x4*)(gates + (size_t)(row0 + ai * 128 + m * 16) * 2048 + gc) = o; } }
        } else {
            const bool isk = (pn == 2) || (pn == 3);
#pragma unroll
            for (int bj = 0; bj < 2; ++bj) {
                const int g32 = pn * 256 + bj * 128 + wc * 32;
                u16* base = g32 < 1536 ? qkva + g32 : qkvb + (g32 - 1536);
                const bool rot = (g32 < 1024) && ((g32 & 63) == 0) && (fq < 2);
                f32x4 ks0 = {0.f, 0.f, 0.f, 0.f}, ks1 = {0.f, 0.f, 0.f, 0.f};
                if (rot) {
#pragma unroll
                    for (int ai = 0; ai < 2; ++ai) {
                        f32x4 cc[4], sn[4];
#pragma unroll
                        for (int m = 0; m < 4; ++m) { const int row = row0 + ai * 128 + m * 16; cc[m] = *(const f32x4*)(cs + (size_t)row * 16 + fq * 4); sn[m] = *(const f32x4*)(cs + (size_t)row * 16 + 8 + fq * 4); }
#pragma unroll
                        for (int m = 0; m < 4; ++m) { const float ri = rtab[ai * 128 + m * 16]; const int row = row0 + ai * 128 + m * 16;
                            f32x4 a = acc[ai][bj][m][0] * ri, b = acc[ai][bj][m][1] * ri;
                            f32x4 o1 = a * cc[m] - b * sn[m], o2 = b * cc[m] + a * sn[m];
                            u32x2 w1, w2; w1[0] = cvt_pk_bf16(o1[0], o1[1]); w1[1] = cvt_pk_bf16(o1[2], o1[3]); w2[0] = cvt_pk_bf16(o2[0], o2[1]); w2[1] = cvt_pk_bf16(o2[2], o2[3]);
                            *(u32x2*)(base + (size_t)row * LDA_ + fq * 4) = w1; *(u32x2*)(base + (size_t)row * LDA_ + 8 + fq * 4) = w2;
                            ks0 += o1; ks1 += o2; } }
                } else {
#pragma unroll
                    for (int ai = 0; ai < 2; ++ai)
#pragma unroll
                        for (int m = 0; m < 4; ++m) { const float ri = rtab[ai * 128 + m * 16]; const int row = row0 + ai * 128 + m * 16;
                            f32x4 a = acc[ai][bj][m][0] * ri, b = acc[ai][bj][m][1] * ri;
                            u32x4 o; o[0] = cvt_pk_bf16(a[0], a[1]); o[1] = cvt_pk_bf16(a[2], a[3]); o[2] = cvt_pk_bf16(b[0], b[1]); o[3] = cvt_pk_bf16(b[2], b[3]);
                            *(u32x4*)(base + (size_t)row * LDA_ + fq * 8) = o;
                            ks0 += a; ks1 += b; }
                }
                if (isk) {
#pragma unroll
                    for (int j = 0; j < 4; ++j) {
#pragma unroll
                        for (int o = 1; o < 16; o <<= 1) { ks0[j] += __shfl_xor(ks0[j], o); ks1[j] += __shfl_xor(ks1[j], o); } }
                    if (fr == 0) { float* kp = kmp + (size_t)u.pm * 512 + (g32 - 512);
#pragma unroll
                        for (int j = 0; j < 4; ++j) { atomicAdd(kp + (rot ? fq * 4 : fq * 8) + j, ks0[j]); atomicAdd(kp + (rot ? 8 + fq * 4 : fq * 8 + 4) + j, ks1[j]); } }
                }
            }
        }
    }
};

template <bool FIRST> struct EpiBranch {
    static constexpr bool AFTER_DRAIN = true;
    const u16* gates; u16* tmp; u16* merged;
    __device__ __forceinline__ void fused(Acc& acc, const Unit& u, int wr, int wc, int fr, int fq, int) const { (*this)(acc, u, 0, wr, wc, fr, fq); }
    __device__ __forceinline__ void operator()(const Acc& acc, const Unit& u, int ui, int wr, int wc, int fr, int fq) const {
        const int row0 = u.pm * 256 + wr * 64 + fr, col0 = u.pn * 256 + wc * 32 + fq * 8;
        constexpr int NB = FIRST ? 1 : 2, AIB = FIRST ? 2 : 1;
#pragma unroll
        for (int bt = 0; bt < NB; ++bt) {
            u32x4 gw[AIB][4][2], tw[AIB][4][2];
#pragma unroll
            for (int a2 = 0; a2 < AIB; ++a2)
#pragma unroll
                for (int m = 0; m < 4; ++m)
#pragma unroll
                    for (int bj = 0; bj < 2; ++bj) { const int ai = FIRST ? a2 : bt, row = row0 + ai * 128 + m * 16, col = col0 + bj * 128;
                        gw[a2][m][bj] = *(const u32x4*)(gates + (size_t)row * 2048 + (FIRST ? 0 : 1024) + col);
                        if (!FIRST) tw[a2][m][bj] = *(const u32x4*)(tmp + (size_t)row * D_ + col); }
#pragma unroll
            for (int a2 = 0; a2 < AIB; ++a2)
#pragma unroll
                for (int m = 0; m < 4; ++m)
#pragma unroll
                    for (int bj = 0; bj < 2; ++bj) { const int ai = FIRST ? a2 : bt, row = row0 + ai * 128 + m * 16, col = col0 + bj * 128;
                        const u32x4 g2 = gw[a2][m][bj];
                        f32x4 v0 = (f32x4){bflo(g2[0]), bfhi(g2[0]), bflo(g2[1]), bfhi(g2[1])} * acc[ai][bj][m][0];
                        f32x4 v1 = (f32x4){bflo(g2[2]), bfhi(g2[2]), bflo(g2[3]), bfhi(g2[3])} * acc[ai][bj][m][1];
                        if (!FIRST) { const u32x4 t2 = tw[a2][m][bj]; v0 += (f32x4){bflo(t2[0]), bfhi(t2[0]), bflo(t2[1]), bfhi(t2[1])}; v1 += (f32x4){bflo(t2[2]), bfhi(t2[2]), bflo(t2[3]), bfhi(t2[3])}; }
                        u32x4 b; b[0] = cvt_pk_bf16(v0[0], v0[1]); b[1] = cvt_pk_bf16(v0[2], v0[3]); b[2] = cvt_pk_bf16(v1[0], v1[1]); b[3] = cvt_pk_bf16(v1[2], v1[3]);
                        *(u32x4*)((FIRST ? tmp : merged) + (size_t)row * D_ + col) = b; }
        }
    }
};

struct EpiFinal {
    static constexpr bool AFTER_DRAIN = true;
    const u16* resid; float* out; float* part; unsigned* pcnt; const float* gain; float scale;
    __device__ __forceinline__ void operator()(const Acc&, const Unit&, int, int, int, int, int) const {}
    __device__ __forceinline__ void fused(Acc& acc, const Unit& u, int wr, int wc, int fr, int fq, int lane) const {
        const int row0 = u.pm * 256 + wr * 64 + fr, col0 = u.pn * 256 + wc * 32 + fq * 8;
        u32x4 rwa[2][4][2];
#pragma unroll
        for (int ai = 0; ai < 2; ++ai)
#pragma unroll
            for (int m = 0; m < 4; ++m)
#pragma unroll
                for (int bj = 0; bj < 2; ++bj) rwa[ai][m][bj] = *(const u32x4*)(resid + (size_t)(row0 + ai * 128 + m * 16) * D_ + col0 + bj * 128);
#pragma unroll
        for (int ai = 0; ai < 2; ++ai)
#pragma unroll
            for (int m = 0; m < 4; ++m) { float ss = 0.f;
#pragma unroll
                for (int bj = 0; bj < 2; ++bj) { const u32x4 w = rwa[ai][m][bj];
                    f32x4 h0 = (f32x4){bflo(w[0]), bfhi(w[0]), bflo(w[1]), bfhi(w[1])} + acc[ai][bj][m][0] * scale;
                    f32x4 h1 = (f32x4){bflo(w[2]), bfhi(w[2]), bflo(w[3]), bfhi(w[3])} + acc[ai][bj][m][1] * scale;
                    acc[ai][bj][m][0] = h0; acc[ai][bj][m][1] = h1;
                    ss += h0[0] * h0[0] + h0[1] * h0[1] + h0[2] * h0[2] + h0[3] * h0[3] + h1[0] * h1[0] + h1[1] * h1[1] + h1[2] * h1[2] + h1[3] * h1[3]; }
                ss += __shfl_xor(ss, 16); ss += __shfl_xor(ss, 32);
                if (fq == 0) __hip_atomic_store(part + (size_t)(row0 + ai * 128 + m * 16) * 16 + u.pn * 4 + wc, ss, __ATOMIC_RELAXED, __HIP_MEMORY_SCOPE_AGENT); }
        asm volatile("s_waitcnt vmcnt(0)" ::: "memory");
        unsigned* cw = pcnt + u.pm * 16;
        if (lane == 0) {
            __hip_atomic_fetch_add(cw, 1u, __ATOMIC_RELAXED, __HIP_MEMORY_SCOPE_AGENT);
            unsigned sp = 0;
            while (__hip_atomic_load(cw, __ATOMIC_RELAXED, __HIP_MEMORY_SCOPE_AGENT) < 32u) { __builtin_amdgcn_s_sleep(1); if (++sp > (1u << 22)) break; }
        }
        float rinv[2][4];
        { float pv[2][4][4];
#pragma unroll
          for (int ai = 0; ai < 2; ++ai)
#pragma unroll
            for (int m = 0; m < 4; ++m)
#pragma unroll
              for (int k = 0; k < 4; ++k) pv[ai][m][k] = __hip_atomic_load(part + (size_t)(row0 + ai * 128 + m * 16) * 16 + fq * 4 + k, __ATOMIC_RELAXED, __HIP_MEMORY_SCOPE_AGENT);
#pragma unroll
          for (int ai = 0; ai < 2; ++ai)
#pragma unroll
            for (int m = 0; m < 4; ++m) { float sv = (pv[ai][m][0] + pv[ai][m][1]) + (pv[ai][m][2] + pv[ai][m][3]);
                sv += __shfl_xor(sv, 16); sv += __shfl_xor(sv, 32); rinv[ai][m] = __builtin_amdgcn_rsqf(sv * (1.0f / D_) + EPS); } }
        f32x4 gv[2][2];
#pragma unroll
        for (int bj = 0; bj < 2; ++bj)
#pragma unroll
            for (int n = 0; n < 2; ++n) gv[bj][n] = *(const f32x4*)(gain + col0 + bj * 128 + n * 4);
#pragma unroll
        for (int ai = 0; ai < 2; ++ai)
#pragma unroll
            for (int m = 0; m < 4; ++m)
#pragma unroll
                for (int bj = 0; bj < 2; ++bj)
#pragma unroll
                    for (int n = 0; n < 2; ++n)
                        *(f32x4*)(out + (size_t)(row0 + ai * 128 + m * 16) * D_ + col0 + bj * 128 + n * 4) = acc[ai][bj][m][n] * rinv[ai][m] * gv[bj][n];
    }
};

__device__ __forceinline__ int map_gu(int c, int up) { const int pn = c >> 7, w = c & 127, wc = w >> 5, r = w & 31; return pn * 256 + up * 128 + wc * 32 + ((r >> 2) & 1) * 16 + (r >> 3) * 4 + (r & 3); }
__device__ __forceinline__ int map_perm8(int c) { const int r = c & 31; return (c & ~31) + ((r >> 2) & 1) * 16 + (r >> 3) * 4 + (r & 3); }
__device__ __forceinline__ int map_win(int c) { if (c < 1024 && (c & 63) < 16) { const int r = c & 15, x2 = r >> 3, i = r & 7; return (c & ~63) + x2 * 16 + (i >> 2) * 4 + (i & 3); } return map_perm8(c); }

struct TileDesc { const float* W; u16* Wt; const float* gain; int K, N, mode, tile; };
struct TileRegs { f32x4 v[2]; float gk[2]; };
__device__ __forceinline__ void tile_load(TileRegs& r, const TileDesc& d) {
    const int ntn = d.N >> 6, tk = d.tile / ntn, tn = d.tile - tk * ntn, k0 = tk * 64, n0 = tn * 64, tid = threadIdx.x;
    const float cscale = d.mode == 3 ? (n0 < 512 ? 0.125f * 1.4426950408889634f : (n0 >= 1536 && n0 < 2048) ? 0.125f : 1.0f) : 1.0f;
#pragma unroll
    for (int i = 0; i < 2; ++i) { const int e = tid + i * 512, k = e >> 4, c4 = (e & 15) * 4;
        r.v[i] = *(const f32x4*)(d.W + (size_t)(k0 + k) * d.N + n0 + c4); r.gk[i] = (d.gain ? d.gain[k0 + k] : 1.0f) * cscale; }
}
__device__ __forceinline__ void tile_store(LAS float* tl, const TileRegs& r, const TileDesc& d) {
    const int ntn = d.N >> 6, tk = d.tile / ntn, tn = d.tile - tk * ntn, k0 = tk * 64, n0 = tn * 64, tid = threadIdx.x;
    __syncthreads();
#pragma unroll
    for (int i = 0; i < 2; ++i) { const int e = tid + i * 512, k = e >> 4, c4 = (e & 15) * 4; const f32x4 v = r.v[i] * r.gk[i];
        tl[k * 65 + c4] = v[0]; tl[k * 65 + c4 + 1] = v[1]; tl[k * 65 + c4 + 2] = v[2]; tl[k * 65 + c4 + 3] = v[3]; }
    __syncthreads();
    const int n = tid & 63, kg = tid >> 6; float v[8];
#pragma unroll
    for (int i = 0; i < 8; ++i) v[i] = tl[(kg * 8 + i) * 65 + n];
    const int c = n0 + n; const int rr = d.mode == 0 ? c : d.mode == 1 ? map_gu(c, 0) : d.mode == 2 ? map_gu(c, 1) : d.mode == 3 ? map_win(c) : map_perm8(c);
    u32x4 o; o[0] = cvt_pk_bf16(v[0], v[1]); o[1] = cvt_pk_bf16(v[2], v[3]); o[2] = cvt_pk_bf16(v[4], v[5]); o[3] = cvt_pk_bf16(v[6], v[7]);
    *(u32x4*)(d.Wt + (size_t)rr * d.K + k0 + kg * 8) = o;
}

__device__ __forceinline__ void prep_phase(const Params& p, LAS unsigned char* lds) {
    unsigned char* ws = p.ws; LAS float* tl = (LAS float*)lds;
    const int tid = threadIdx.x, lane = tid & 63, wid = tid >> 6, G = gridDim.x;
    if (blockIdx.x == 0) { ((int*)(ws + WS_CNT))[tid] = 0; }
    if (blockIdx.x < 64) ((float*)(ws + WS_KMEAN))[blockIdx.x * 512 + tid] = 0.f;
    constexpr int T_GU = 16 * 44, T_DN = 44 * 16, T_IN = 16 * 80, T_BR = 8 * 16, T_WO = 16 * 16;
    constexpr int o1 = T_GU, o2 = o1 + T_GU, o3 = o2 + T_DN, o4 = o3 + T_IN, o5 = o4 + T_BR, o6 = o5 + T_BR, o7 = o6 + T_WO, o8 = o7 + T_GU, o9 = o8 + T_GU, o10 = o9 + T_DN;
    auto desc = [&](int t) -> TileDesc {
        if (t < o1) return TileDesc{p.g1, (u16*)(ws + WS_GU1), p.n1, D_, DFF, 1, t};
        if (t < o2) return TileDesc{p.u1, (u16*)(ws + WS_GU1), p.n1, D_, DFF, 2, t - o1};
        if (t < o3) return TileDesc{p.d1, (u16*)(ws + WS_DN1), nullptr, DFF, D_, 4, t - o2};
        if (t < o4) return TileDesc{p.win, (u16*)(ws + WS_IN), p.nm, D_, DIN, 3, t - o3};
        if (t < o5) return TileDesc{p.wba, (u16*)(ws + WS_BA), nullptr, 512, D_, 4, t - o4};
        if (t < o6) return TileDesc{p.wbb, (u16*)(ws + WS_BB), nullptr, 512, D_, 4, t - o5};
        if (t < o7) return TileDesc{p.wo, (u16*)(ws + WS_WO), nullptr, D_, D_, 4, t - o6};
        if (t < o8) return TileDesc{p.g2, (u16*)(ws + WS_GU2), p.n2, D_, DFF, 1, t - o7};
        if (t < o9) return TileDesc{p.u2, (u16*)(ws + WS_GU2), p.n2, D_, DFF, 2, t - o8};
        return TileDesc{p.d2, (u16*)(ws + WS_DN2), nullptr, DFF, D_, 4, t - o9};
    };
    const int NPREP = (int)gridDim.x == 256 ? 2 * T_GU : 2 * T_GU + 2 * T_GU + T_DN;
    auto pdesc = [&](int t) -> TileDesc { return t < 2 * T_GU ? desc(t) : desc(t - 2 * T_GU + o7); };
    { int t = blockIdx.x;
      if (t < NPREP) { TileDesc d = pdesc(t); TileRegs ra; tile_load(ra, d);
        for (;;) { const int tn = t + G; const bool more = tn < NPREP; TileDesc dn = d; TileRegs rb = ra;
            if (more) { dn = pdesc(tn); tile_load(rb, dn); }
            tile_store(tl, ra, d);
            if (!more) break;
            d = dn; ra = rb; t = tn; } } }
    u16* xb = (u16*)(ws + WS_AB); float* part0 = (float*)(ws + WS_P0); float* cs = (float*)(ws + WS_CS);
    f32x4 xv[4];
    { const int row0_ = blockIdx.x * 8 + wid; if (row0_ < T_) {
#pragma unroll
        for (int i = 0; i < 4; ++i) xv[i] = *(const f32x4*)(p.x + (size_t)row0_ * D_ + i * 256 + lane * 4); } }
    for (int row = blockIdx.x * 8 + wid; row < T_; row += G * 8) {
        float ss = 0.f; f32x4 cur[4];
#pragma unroll
        for (int i = 0; i < 4; ++i) cur[i] = xv[i];
        if (row + G * 8 < T_) {
#pragma unroll
            for (int i = 0; i < 4; ++i) xv[i] = *(const f32x4*)(p.x + (size_t)(row + G * 8) * D_ + i * 256 + lane * 4); }
#pragma unroll
        for (int i = 0; i < 4; ++i) { const f32x4 v = cur[i]; ss += v[0] * v[0] + v[1] * v[1] + v[2] * v[2] + v[3] * v[3];
            u32x2 b; b[0] = cvt_pk_bf16(v[0], v[1]); b[1] = cvt_pk_bf16(v[2], v[3]); *(u32x2*)(xb + (size_t)row * D_ + i * 256 + lane * 4) = b; }
#pragma unroll
        for (int o = 32; o >= 1; o >>= 1) ss += __shfl_xor(ss, o);
        if (lane < 16) part0[(size_t)row * 16 + lane] = lane == 0 ? ss : 0.f;
        if (lane >= 16 && lane < 24) {
            const int i = lane - 16;
            const float invf = i == 0 ? 1.0f : i == 1 ? 0.1939227432012558f : i == 2 ? 0.03760603070259094f : i == 3 ? 0.007292664609849453f : i == 4 ? 0.0014142135623842478f
                             : i == 5 ? 0.00027424818836152554f : i == 6 ? 5.318296098266728e-05f : 1.0313386155758053e-05f;
            const float ang = (float)p.pos[row] * invf;
            const double a = (double)ang, kk = __builtin_rint(a * 0.15915494309189535), r = a - kk * 6.283185307179586;
            const float rf = (float)r;
            cs[(size_t)row * 16 + i] = __cosf(rf); cs[(size_t)row * 16 + 8 + i] = __sinf(rf);
        }
    }
}


__device__ __forceinline__ void deferred_weights(const Params& p, LAS unsigned char* lds, int j, int nidle, int lo, int hi) {
    unsigned char* ws = p.ws; LAS float* tl = (LAS float*)lds;
    constexpr int T_GU = 16 * 44, T_DN = 44 * 16, T_IN = 16 * 80, T_BR = 8 * 16, T_WO = 16 * 16;
    constexpr int o2 = 2 * T_GU, o3 = o2 + T_DN, o4 = o3 + T_IN, o5 = o4 + T_BR, o6 = o5 + T_BR, o7 = o6 + T_WO, o8 = o7 + T_GU, o9 = o8 + T_GU;
    auto desc = [&](int t) -> TileDesc {
        if (t < o3) return TileDesc{p.d1, (u16*)(ws + WS_DN1), nullptr, DFF, D_, 4, t - o2};
        if (t < o4) return TileDesc{p.win, (u16*)(ws + WS_IN), p.nm, D_, DIN, 3, t - o3};
        if (t < o5) return TileDesc{p.wba, (u16*)(ws + WS_BA), nullptr, 512, D_, 4, t - o4};
        if (t < o6) return TileDesc{p.wbb, (u16*)(ws + WS_BB), nullptr, 512, D_, 4, t - o5};
        if (t < o7) return TileDesc{p.wo, (u16*)(ws + WS_WO), nullptr, D_, D_, 4, t - o6};
        if (t < o8) return TileDesc{p.g2, (u16*)(ws + WS_GU2), p.n2, D_, DFF, 1, t - o7};
        if (t < o9) return TileDesc{p.u2, (u16*)(ws + WS_GU2), p.n2, D_, DFF, 2, t - o8};
        return TileDesc{p.d2, (u16*)(ws + WS_DN2), nullptr, DFF, D_, 4, t - o9};
    };
    int t = lo + j;
    if (t < hi) { TileDesc d = desc(t); TileRegs ra; tile_load(ra, d);
        for (;;) { const int tn = t + nidle; const bool more = tn < hi; TileDesc dn = d; TileRegs rb = ra;
            if (more) { dn = desc(tn); tile_load(rb, dn); }
            tile_store(tl, ra, d);
            if (!more) break;
            d = dn; ra = rb; t = tn; } }
}

__device__ __forceinline__ s16x4 vtr(LAS const unsigned char* p) { typedef short v4i16_t __attribute__((ext_vector_type(4))); return __builtin_bit_cast(s16x4, __builtin_amdgcn_ds_read_tr16_b64_v4i16((LAS v4i16_t*)p)); }

__device__ __forceinline__ void pv_tile(f32x4 (&o)[4], LAS const unsigned char* vs, const bf16x8 (&pf)[2], int lane) {
    const int li = lane & 15, g = lane >> 4, q_ = li >> 2, pp = li & 3;
    LAS const unsigned char* b0 = vs + (4 * g + q_) * 144 + pp * 8;
#pragma unroll
    for (int ks = 0; ks < 2; ++ks)
#pragma unroll
        for (int dt = 0; dt < 4; ++dt) {
            s16x4 lo = vtr(b0 + (32 * ks) * 144 + dt * 32), hi = vtr(b0 + (32 * ks + 16) * 144 + dt * 32);
            bf16x8 va = {lo[0], lo[1], lo[2], lo[3], hi[0], hi[1], hi[2], hi[3]};
            o[dt] = __builtin_amdgcn_mfma_f32_16x16x32_bf16(va, pf[ks], o[dt], 0, 0, 0);
        }
}
__device__ __forceinline__ void pack_p(bf16x8 (&pf)[2], const float (&w)[4][4]) {
#pragma unroll
    for (int ks = 0; ks < 2; ++ks) { u32x4 t; t[0] = cvt_pk_bf16(w[2 * ks][0], w[2 * ks][1]); t[1] = cvt_pk_bf16(w[2 * ks][2], w[2 * ks][3]);
        t[2] = cvt_pk_bf16(w[2 * ks + 1][0], w[2 * ks + 1][1]); t[3] = cvt_pk_bf16(w[2 * ks + 1][2], w[2 * ks + 1][3]); pf[ks] = __builtin_bit_cast(bf16x8, t); }
}
__device__ __forceinline__ void load_qf(bf16x8 (&qf)[2], const u16* qrow, int lane) { const int g = lane >> 4; qf[0] = *(const bf16x8*)(qrow + 8 * g); qf[1] = *(const bf16x8*)(qrow + 32 + 8 * g); }

__device__ __forceinline__ int list_off(int n) { return 256 * (63 * n - (n * (n - 1)) / 2); }

struct Top3 { unsigned k1, k2, k3; };
__device__ __forceinline__ unsigned topk_key(float v, int n) { unsigned u = __float_as_uint(v); u = (u & 0x80000000u) ? ~u : (u | 0x80000000u); return (u & ~63u) | (unsigned)(63 - n); }
__device__ __forceinline__ void top3_insert(Top3& t, unsigned k) {
    const unsigned a1 = t.k1 > k ? t.k1 : k, r1 = t.k1 > k ? k : t.k1;
    const unsigned a2 = t.k2 > r1 ? t.k2 : r1, r2 = t.k2 > r1 ? r1 : t.k2;
    t.k1 = a1; t.k2 = a2; t.k3 = t.k3 > r2 ? t.k3 : r2;
}
__device__ __forceinline__ void topk_item(const Params& p, int item, int lane, LAS int* hist  ) {
    const u16* qkva = (const u16*)(p.ws + WS_QKVA); const float* km = (const float*)(p.ws + WS_KMEAN);
    int* cnt = (int*)(p.ws + WS_CNT); u16* list = (u16*)(p.ws + WS_LIST);
    const int h = item & 7, qc = item >> 3, q0 = qc * 64, own = qc >> 2, r = lane & 15, g = lane >> 4;
    if (own == 0) return;
    int sel[4][3];
#pragma unroll
    for (int qt = 0; qt < 4; ++qt) { sel[qt][0] = 0; sel[qt][1] = 1; sel[qt][2] = 2; }
    if (own > 3) {
        Top3 tp[4];
#pragma unroll
        for (int qt = 0; qt < 4; ++qt) { tp[qt].k1 = 0u; tp[qt].k2 = 0u; tp[qt].k3 = 0u; }
        bf16x8 qfr[4][2];
#pragma unroll
        for (int qt = 0; qt < 4; ++qt) load_qf(qfr[qt], qkva + (size_t)(q0 + 16 * qt + r) * LDA_ + h * 64, lane);
        const int ntile = (own + 15) >> 4;
        for (int nt = 0; nt < ntile; ++nt) {
            const int nrow = 16 * nt + r; const bool nv = nrow < own;
            bf16x8 ahi[2], alo[2];
#pragma unroll
            for (int ks = 0; ks < 2; ++ks) { const float* kp = km + (size_t)(nv ? nrow : 0) * 512 + h * 64 + 32 * ks + 8 * g;
                f32x4 a = *(const f32x4*)kp, b = *(const f32x4*)(kp + 4);
                u32x4 hi; hi[0] = cvt_pk_bf16(a[0], a[1]); hi[1] = cvt_pk_bf16(a[2], a[3]); hi[2] = cvt_pk_bf16(b[0], b[1]); hi[3] = cvt_pk_bf16(b[2], b[3]);
                f32x4 ra = {a[0] - bflo(hi[0]), a[1] - bfhi(hi[0]), a[2] - bflo(hi[1]), a[3] - bfhi(hi[1])}, rb = {b[0] - bflo(hi[2]), b[1] - bfhi(hi[2]), b[2] - bflo(hi[3]), b[3] - bfhi(hi[3])};
                u32x4 lo; lo[0] = cvt_pk_bf16(ra[0], ra[1]); lo[1] = cvt_pk_bf16(ra[2], ra[3]); lo[2] = cvt_pk_bf16(rb[0], rb[1]); lo[3] = cvt_pk_bf16(rb[2], rb[3]);
                ahi[ks] = __builtin_bit_cast(bf16x8, hi); alo[ks] = __builtin_bit_cast(bf16x8, lo); }
#pragma unroll
            for (int qt = 0; qt < 4; ++qt) { f32x4 acc = {0.f, 0.f, 0.f, 0.f};
#pragma unroll
                for (int ks = 0; ks < 2; ++ks) { acc = __builtin_amdgcn_mfma_f32_16x16x32_bf16(ahi[ks], qfr[qt][ks], acc, 0, 0, 0); acc = __builtin_amdgcn_mfma_f32_16x16x32_bf16(alo[ks], qfr[qt][ks], acc, 0, 0, 0); }
#pragma unroll
                for (int j = 0; j < 4; ++j) { const int n = 16 * nt + 4 * g + j; top3_insert(tp[qt], n < own ? topk_key(acc[j], n) : 0u); } }
        }
#pragma unroll
        for (int step = 16; step <= 32; step <<= 1)
#pragma unroll
            for (int qt = 0; qt < 4; ++qt) { const unsigned p1 = __shfl_xor(tp[qt].k1, step), p2 = __shfl_xor(tp[qt].k2, step), p3 = __shfl_xor(tp[qt].k3, step);
                top3_insert(tp[qt], p1); top3_insert(tp[qt], p2); top3_insert(tp[qt], p3); }
#pragma unroll
        for (int qt = 0; qt < 4; ++qt) { sel[qt][0] = 63 - (int)(tp[qt].k1 & 63u); sel[qt][1] = 63 - (int)(tp[qt].k2 & 63u); sel[qt][2] = 63 - (int)(tp[qt].k3 & 63u); }
    }
    const int nsel = own < 3 ? own : 3;
    volatile LAS int* vh = (volatile LAS int*)hist;
    vh[lane] = 0;
    __builtin_amdgcn_fence(__ATOMIC_RELEASE, "wavefront"); __builtin_amdgcn_wave_barrier();
    int rank[4][3];
    if (g == 0) {
#pragma unroll
        for (int qt = 0; qt < 4; ++qt)
#pragma unroll
            for (int s2 = 0; s2 < 3; ++s2) { const int n = sel[qt][s2];
                rank[qt][s2] = s2 < nsel ? __hip_atomic_fetch_add(hist + n, 1, __ATOMIC_RELAXED, __HIP_MEMORY_SCOPE_WORKGROUP) : 0; }
    }
    __builtin_amdgcn_fence(__ATOMIC_ACQ_REL, "wavefront"); __builtin_amdgcn_wave_barrier();
    { const int c = vh[lane]; vh[64 + lane] = c > 0 ? atomicAdd(cnt + h * 64 + lane, c) : 0; }
    __builtin_amdgcn_fence(__ATOMIC_ACQ_REL, "wavefront"); __builtin_amdgcn_wave_barrier();
    if (g == 0) {
#pragma unroll
        for (int qt = 0; qt < 4; ++qt) { const int q = q0 + 16 * qt + r;
#pragma unroll
            for (int s2 = 0; s2 < 3; ++s2) if (s2 < nsel) { const int n = sel[qt][s2];
                list[(size_t)h * LISTH + list_off(n) + vh[64 + n] + rank[qt][s2]] = (u16)(q | (s2 << 14)); } }
    }
}

struct CoopKV { u32x4 k, v; };
#define KB_OFF(b) ((b) * 18432)
#define VB_OFF(b) ((b) * 18432 + 9216)
__device__ __forceinline__ void coop_load(CoopKV& c, const u16* kbase, int tid) { const u16* p = kbase + (size_t)(tid >> 3) * LDA_ + 8 * (tid & 7); c.k = *(const u32x4*)p; c.v = *(const u32x4*)(p + 512); }
__device__ __forceinline__ void qk_lds(f32x4 (&acc)[4], LAS const unsigned char* kb, const bf16x8 (&qf)[2], int lane) {
    const int r = lane & 15, g = lane >> 4;
#pragma unroll
    for (int kt = 0; kt < 4; ++kt) { LAS const unsigned char* kp = kb + (16 * kt + r) * 144 + 16 * g;
        bf16x8 k0 = *(LAS const bf16x8*)kp, k1 = *(LAS const bf16x8*)(kp + 64);
        f32x4 z = {0.f, 0.f, 0.f, 0.f};
        z = __builtin_amdgcn_mfma_f32_16x16x32_bf16(k0, qf[0], z, 0, 0, 0);
        acc[kt] = __builtin_amdgcn_mfma_f32_16x16x32_bf16(k1, qf[1], z, 0, 0, 0); }
}
template <bool CAUSAL>
__device__ __forceinline__ void sm_tile_l(LAS const unsigned char* kb, LAS const unsigned char* vb, int key0, int t, const bf16x8 (&qf)[2], float& m, float& l, f32x4 (&o)[4], int lane) {
    const int g = lane >> 4;
    f32x4 acc[4]; qk_lds(acc, kb, qf, lane);
    float s[4][4]; float lm = -INFINITY;
#pragma unroll
    for (int kt = 0; kt < 4; ++kt)
#pragma unroll
        for (int j = 0; j < 4; ++j) { float v = acc[kt][j]; if (CAUSAL && (key0 + 16 * kt + 4 * g + j) > t) v = -INFINITY; s[kt][j] = v; lm = fmaxf(lm, v); }
    lm = fmaxf(lm, __shfl_xor(lm, 16)); lm = fmaxf(lm, __shfl_xor(lm, 32));
    const float mn = fmaxf(m, lm), al = fexp2(m - mn);
    float sum = 0.f;
#pragma unroll
    for (int kt = 0; kt < 4; ++kt)
#pragma unroll
        for (int j = 0; j < 4; ++j) { s[kt][j] = fexp2(s[kt][j] - mn); sum += s[kt][j]; }
    l = l * al + sum; m = mn;
#pragma unroll
    for (int dt = 0; dt < 4; ++dt) o[dt] *= al;
    bf16x8 pf[2]; pack_p(pf, s);
    pv_tile(o, vb, pf, lane);
}

__device__ __forceinline__ void sel_block_stream(const Params& p, LAS unsigned char* lds, LAS const int* sched, int total, int tid, int wid, int lane) {
    const u16* qkva = (const u16*)(p.ws + WS_QKVA); const u16* list = (const u16*)(p.ws + WS_LIST);
    u16* po = (u16*)(p.ws + WS_PO); float* pml = (float*)(p.ws + WS_PML);
    const int r = lane & 15, g = lane >> 4, G = gridDim.x;
    int i = (G & 7) == 0 ? (int)(blockIdx.x & 7) * (G >> 3) + (int)(blockIdx.x >> 3) : (int)blockIdx.x; if (i >= total) return;
#define SELB_DECODE(kk_, H, N, E, OK, ACT) do { const int hn_ = __builtin_amdgcn_readfirstlane(sched[(kk_) * 4]), grp_ = __builtin_amdgcn_readfirstlane(sched[(kk_) * 4 + 1]), c_ = __builtin_amdgcn_readfirstlane(sched[(kk_) * 4 + 2]); \
        H = hn_ >> 6; N = hn_ & 63; const int e0_ = grp_ * 128 + wid * 16; ACT = e0_ < c_; int ei_ = e0_ + r; OK = ei_ < c_; if (!OK) ei_ = ACT ? e0_ : 0; \
        E = list[(size_t)H * LISTH + list_off(N) + ei_]; } while (0)
    int kq = 0; int h, n; unsigned e; bool ok, act; SELB_DECODE(kq, h, n, e, ok, act);
    bf16x8 qf[2]; load_qf(qf, qkva + (size_t)(e & 0x3FFF) * LDA_ + h * 64, lane);
#define KBIG(b_) ((b_) * 73728)
#define VBIG(b_) ((b_) * 73728 + 36864)
    CoopKV cN[4];
    { const u16* kb0 = qkva + (size_t)(n * 256) * LDA_ + 512 + h * 64;
#pragma unroll
      for (int t4 = 0; t4 < 4; ++t4) coop_load(cN[t4], kb0 + (size_t)t4 * 64 * LDA_, tid);
      const int o_ = (tid >> 3) * 144 + (tid & 7) * 16;
#pragma unroll
      for (int t4 = 0; t4 < 4; ++t4) { *(LAS u32x4*)(lds + KBIG(0) + t4 * 9216 + o_) = cN[t4].k; *(LAS u32x4*)(lds + VBIG(0) + t4 * 9216 + o_) = cN[t4].v; } }
    __syncthreads();
    int buf = 0;
    for (;;) {
        const int i2 = i + G; const bool has_next = i2 < total;
        int h2 = 0, n2 = 0; unsigned e2 = 0; bool ok2 = false, act2 = false;
        if (has_next) { SELB_DECODE(kq + 1, h2, n2, e2, ok2, act2);
            const u16* kb2 = qkva + (size_t)(n2 * 256) * LDA_ + 512 + h2 * 64;
#pragma unroll
            for (int t4 = 0; t4 < 4; ++t4) coop_load(cN[t4], kb2 + (size_t)t4 * 64 * LDA_, tid); }
        f32x4 o[4];
#pragma unroll
        for (int q_ = 0; q_ < 4; ++q_) o[q_] = (f32x4){0.f, 0.f, 0.f, 0.f};
        float m = -INFINITY, l = 0.f; bf16x8 qn[2] = {qf[0], qf[1]};
        if (has_next) load_qf(qn, qkva + (size_t)(e2 & 0x3FFF) * LDA_ + h2 * 64, lane);
        if (act) {
#pragma unroll 1
            for (int tile = 0; tile < 4; ++tile) sm_tile_l<false>(lds + KBIG(buf) + tile * 9216, lds + VBIG(buf) + tile * 9216, 0, 0, qf, m, l, o, lane);
            l += __shfl_xor(l, 16); l += __shfl_xor(l, 32);
            const float inv = frcp(l);
            if (ok) { const size_t sidx = ((size_t)(e & 0x3FFF) * NH + h) * 3 + (e >> 14);
#pragma unroll
                for (int dt = 0; dt < 4; ++dt) { u32x2 b; b[0] = cvt_pk_bf16(o[dt][0] * inv, o[dt][1] * inv); b[1] = cvt_pk_bf16(o[dt][2] * inv, o[dt][3] * inv);
                    *(u32x2*)(po + sidx * 64 + 16 * dt + 4 * g) = b; }
                if (g == 0) { pml[sidx * 2] = m; pml[sidx * 2 + 1] = l; } } }
        if (!has_next) break;
        { const int o_ = (tid >> 3) * 144 + (tid & 7) * 16;
#pragma unroll
          for (int t4 = 0; t4 < 4; ++t4) { *(LAS u32x4*)(lds + KBIG(buf ^ 1) + t4 * 9216 + o_) = cN[t4].k; *(LAS u32x4*)(lds + VBIG(buf ^ 1) + t4 * 9216 + o_) = cN[t4].v; } }
        __syncthreads(); buf ^= 1;
        i = i2; ++kq; h = h2; n = n2; e = e2; ok = ok2; act = act2; qf[0] = qn[0]; qf[1] = qn[1];
    }
#undef KBIG
#undef VBIG
#undef SELB_DECODE
}

__device__ __forceinline__ void own_block_stream(const Params& p, LAS unsigned char* lds, int tid, int wid, int lane) {
    const u16* qkva = (const u16*)(p.ws + WS_QKVA); const u16* po = (const u16*)(p.ws + WS_PO); const float* pml = (const float*)(p.ws + WS_PML);
    u16* ya = (u16*)(p.ws + WS_AB);
    const int r = lane & 15, g = lane >> 4, G = gridDim.x, total = (T_ / 128) * NH;
    int i = (G & 7) == 0 ? (int)(blockIdx.x & 7) * (G >> 3) + (int)(blockIdx.x >> 3) : (int)blockIdx.x, kk = 0; if (i >= total) return;
#define OWN_DEC(ii, k_, C, H) do { C = ((ii) >> 3) ^ ((k_) & 1); H = (ii) & 7; } while (0)
    int cch, h; OWN_DEC(i, kk, cch, h);
    bf16x8 qf[2]; load_qf(qf, qkva + (size_t)(cch * 128 + wid * 16 + r) * LDA_ + h * 64, lane);
#define KBIG(b_) ((b_) * 73728)
#define VBIG(b_) ((b_) * 73728 + 36864)
    CoopKV cN[4]; const int o_ = (tid >> 3) * 144 + (tid & 7) * 16;
    { const u16* kb0 = qkva + (size_t)((cch >> 1) * 256) * LDA_ + 512 + h * 64; const int nt0 = (cch & 1) ? 4 : 2;
#pragma unroll
      for (int t4 = 0; t4 < 4; ++t4) if (t4 < nt0) coop_load(cN[t4], kb0 + (size_t)t4 * 64 * LDA_, tid);
#pragma unroll
      for (int t4 = 0; t4 < 4; ++t4) if (t4 < nt0) { *(LAS u32x4*)(lds + KBIG(0) + t4 * 9216 + o_) = cN[t4].k; *(LAS u32x4*)(lds + VBIG(0) + t4 * 9216 + o_) = cN[t4].v; } }
    __syncthreads();
    int buf = 0;
    for (;;) {
        const int i2 = i + G; const bool has_next = i2 < total; int c2 = 0, h2 = 0; OWN_DEC(i2, kk + 1, c2, h2);
        const int own = cch >> 1, q0 = cch * 128 + wid * 16, t = q0 + r, wmax = ((cch & 1) * 128 + wid * 16 + 15) >> 6;
        const int nt2 = (c2 & 1) ? 4 : 2;
        f32x4 o[4];
#pragma unroll
        for (int q_ = 0; q_ < 4; ++q_) o[q_] = (f32x4){0.f, 0.f, 0.f, 0.f};
        float m = -INFINITY, l = 0.f; bf16x8 qn[2] = {qf[0], qf[1]};
        if (has_next) { const u16* kb2 = qkva + (size_t)((c2 >> 1) * 256) * LDA_ + 512 + h2 * 64;
#pragma unroll
            for (int t4 = 0; t4 < 4; ++t4) if (t4 < nt2) coop_load(cN[t4], kb2 + (size_t)t4 * 64 * LDA_, tid);
            load_qf(qn, qkva + (size_t)(c2 * 128 + wid * 16 + r) * LDA_ + h2 * 64, lane); }
        const int nsel = own < 3 ? own : 3;
        const size_t sidx = ((size_t)t * NH + h) * 3;
        float ms[3], lsv[3]; u32x2 pw[3][4];
#pragma unroll
        for (int s2 = 0; s2 < 3; ++s2) { ms[s2] = -INFINITY; lsv[s2] = 0.f;
#pragma unroll
            for (int dt = 0; dt < 4; ++dt) pw[s2][dt] = (u32x2){0u, 0u};
            if (s2 < nsel) { ms[s2] = pml[(sidx + s2) * 2]; lsv[s2] = pml[(sidx + s2) * 2 + 1];
#pragma unroll
                for (int dt = 0; dt < 4; ++dt) pw[s2][dt] = *(const u32x2*)(po + (sidx + s2) * 64 + 16 * dt + 4 * g); } }
#pragma unroll 1
        for (int tile = 0; tile <= wmax; ++tile) sm_tile_l<true>(lds + KBIG(buf) + tile * 9216, lds + VBIG(buf) + tile * 9216, own * 256 + tile * 64, t, qf, m, l, o, lane);
        l += __shfl_xor(l, 16); l += __shfl_xor(l, 32);
        float M = m;
#pragma unroll
        for (int s2 = 0; s2 < 3; ++s2) M = fmaxf(M, ms[s2]);
        const float a0 = fexp2(m - M); float den = l * a0;
#pragma unroll
        for (int dt = 0; dt < 4; ++dt) o[dt] *= a0;
#pragma unroll
        for (int s2 = 0; s2 < 3; ++s2) { const float a = lsv[s2] * fexp2(ms[s2] - M); den += a;
#pragma unroll
            for (int dt = 0; dt < 4; ++dt) { const u32x2 w = pw[s2][dt];
                o[dt][0] += a * bflo(w[0]); o[dt][1] += a * bfhi(w[0]); o[dt][2] += a * bflo(w[1]); o[dt][3] += a * bfhi(w[1]); } }
        const float inv = frcp(den);
#pragma unroll
        for (int dt = 0; dt < 4; ++dt) { u32x2 b; b[0] = cvt_pk_bf16(o[dt][0] * inv, o[dt][1] * inv); b[1] = cvt_pk_bf16(o[dt][2] * inv, o[dt][3] * inv);
            *(u32x2*)(ya + (size_t)t * 512 + h * 64 + 16 * dt + 4 * g) = b; }
        if (!has_next) break;
#pragma unroll
        for (int t4 = 0; t4 < 4; ++t4) if (t4 < nt2) { *(LAS u32x4*)(lds + KBIG(buf ^ 1) + t4 * 9216 + o_) = cN[t4].k; *(LAS u32x4*)(lds + VBIG(buf ^ 1) + t4 * 9216 + o_) = cN[t4].v; }
        __syncthreads(); buf ^= 1;
        i = i2; ++kk; cch = c2; h = h2; qf[0] = qn[0]; qf[1] = qn[1];
    }
#undef KBIG
#undef VBIG
#undef OWN_DEC
}

__device__ __forceinline__ void sb_tile_l(LAS const unsigned char* kb, LAS const unsigned char* vb, int key0, int t, const bf16x8 (&qf)[2], float& R, f32x4 (&o)[4], int lane) {
    const int g = lane >> 4;
    f32x4 acc[4]; qk_lds(acc, kb, qf, lane);
    float lf[4][4], Tk[4], ex[4];
#pragma unroll
    for (int kt = 0; kt < 4; ++kt) { float c = 0.f;
#pragma unroll
        for (int j = 0; j < 4; ++j) { const bool valid = (key0 + 16 * kt + 4 * g + j) < t; const float z = acc[kt][j];
            const float sp = fmaxf(z, 0.f) + __logf(1.0f + __expf(-fabsf(z)));
            acc[kt][j] = z; lf[kt][j] = valid ? -sp : 0.f; c += lf[kt][j]; }
        const float b = __shfl_xor(c, 16), s2 = c + b, d = __shfl_xor(s2, 32);
        Tk[kt] = s2 + d; ex[kt] = ((g & 1) ? 0.f : b) + ((g & 2) ? 0.f : d); }
    float w[4][4]; float run = R;
#pragma unroll
    for (int kt = 3; kt >= 0; --kt) { const float E = run + ex[kt]; float suf = 0.f;
#pragma unroll
        for (int j = 3; j >= 0; --j) { const bool valid = (key0 + 16 * kt + 4 * g + j) < t; w[kt][j] = valid ? __expf(acc[kt][j] + lf[kt][j] + E + suf) : 0.f; suf += lf[kt][j]; }
        run += Tk[kt]; }
    R = run;
    bf16x8 pf[2]; pack_p(pf, w);
    pv_tile(o, vb, pf, lane);
}

__device__ __forceinline__ void sb_block_stream(const Params& p, LAS unsigned char* lds, int tid, int wid, int lane) {
    const u16* qkvb = (const u16*)(p.ws + WS_QKVB); u16* yb = (u16*)(p.ws + WS_AB) + (size_t)T_ * 512;
    const int r = lane & 15, g = lane >> 4, G = gridDim.x, total = (T_ / 128) * NH;
    int i = (G & 7) == 0 ? (int)(blockIdx.x & 7) * (G >> 3) + (int)(blockIdx.x >> 3) : (int)blockIdx.x; if (i >= total) return;
    int cch = i >> 3, h = i & 7;
    bf16x8 qf[2]; load_qf(qf, qkvb + (size_t)(cch * 128 + wid * 16 + r) * LDA_ + h * 64, lane);
#define KBIG(b_) ((b_) * 73728)
#define VBIG(b_) ((b_) * 73728 + 36864)
    CoopKV cN[3]; const int o_ = (tid >> 3) * 144 + (tid & 7) * 16;
    { const int ns0 = cch == 0 ? 2 : 3;
#pragma unroll
      for (int s4 = 0; s4 < 3; ++s4) if (s4 < ns0) coop_load(cN[s4], qkvb + (size_t)((2 * cch + 1 - s4) * 64) * LDA_ + 512 + h * 64, tid);
#pragma unroll
      for (int s4 = 0; s4 < 3; ++s4) if (s4 < ns0) { *(LAS u32x4*)(lds + KBIG(0) + s4 * 9216 + o_) = cN[s4].k; *(LAS u32x4*)(lds + VBIG(0) + s4 * 9216 + o_) = cN[s4].v; } }
    __syncthreads();
    int buf = 0;
    for (;;) {
        const int i2 = i + G; const bool has_next = i2 < total; const int c2 = i2 >> 3, h2 = i2 & 7;
        const int q0 = cch * 128 + wid * 16, t = q0 + r, dw = 2 * cch + (wid >> 2);
        const int nstep = cch == 0 ? 2 : 3, ns2 = c2 == 0 ? 2 : 3;
        const u16* kb = qkvb + 512 + h * 64;
        f32x4 o[4];
#pragma unroll
        for (int q_ = 0; q_ < 4; ++q_) o[q_] = (f32x4){0.f, 0.f, 0.f, 0.f};
        float R = 0.f; bool done = false; bf16x8 qn[2] = {qf[0], qf[1]};
        if (has_next) {
#pragma unroll
            for (int s4 = 0; s4 < 3; ++s4) if (s4 < ns2) coop_load(cN[s4], qkvb + (size_t)((2 * c2 + 1 - s4) * 64) * LDA_ + 512 + h2 * 64, tid);
            load_qf(qn, qkvb + (size_t)(c2 * 128 + wid * 16 + r) * LDA_ + h2 * 64, lane); }
        int tile = 2 * cch + 1;
#pragma unroll 1
        for (int s4 = 0; s4 < nstep; ++s4, --tile)
            if (tile <= dw && !done) { sb_tile_l(lds + KBIG(buf) + s4 * 9216, lds + VBIG(buf) + s4 * 9216, tile * 64, t, qf, R, o, lane);
                done = (tile == 0) || (__builtin_amdgcn_ballot_w64(R > -40.f) == 0ull); }
        if (has_next) {
#pragma unroll
            for (int s4 = 0; s4 < 3; ++s4) if (s4 < ns2) { *(LAS u32x4*)(lds + KBIG(buf ^ 1) + s4 * 9216 + o_) = cN[s4].k; *(LAS u32x4*)(lds + VBIG(buf ^ 1) + s4 * 9216 + o_) = cN[s4].v; } }
        int any = __syncthreads_or(done ? 0 : 1);
        while (any && tile >= 0) {
            CoopKV c3; coop_load(c3, kb + (size_t)(tile * 64) * LDA_, tid);
            *(LAS u32x4*)(lds + KBIG(buf) + o_) = c3.k; *(LAS u32x4*)(lds + VBIG(buf) + o_) = c3.v; __syncthreads();
            if (!done) { sb_tile_l(lds + KBIG(buf), lds + VBIG(buf), tile * 64, t, qf, R, o, lane);
                done = (tile == 0) || (__builtin_amdgcn_ballot_w64(R > -40.f) == 0ull); }
            any = __syncthreads_or(done ? 0 : 1); --tile;
        }
#pragma unroll
        for (int dt = 0; dt < 4; ++dt) { u32x2 b; b[0] = cvt_pk_bf16(o[dt][0], o[dt][1]); b[1] = cvt_pk_bf16(o[dt][2], o[dt][3]);
            *(u32x2*)(yb + (size_t)t * 512 + h * 64 + 16 * dt + 4 * g) = b; }
        if (!has_next) break;
        buf ^= 1;
        i = i2; cch = c2; h = h2; qf[0] = qn[0]; qf[1] = qn[1];
    }
#undef KBIG
#undef VBIG
}

#define XB_TMO      128
#define XB_XCNT(j)  (256  + 64 * (j))
#define XB_XSUB(j)  (1280 + 64 * (j))
#define XB_XGEN(j)  (2304 + 64 * (j))
#define XB_TOP      3328
#define XB_TOPGEN   3392
#define XCD_BAR_WORDS 3456
#define XB_SPIN_CAP (1u << 22)
__device__ __forceinline__ unsigned xb_ld(unsigned* p)              { return __hip_atomic_load(p, __ATOMIC_RELAXED, __HIP_MEMORY_SCOPE_AGENT); }
__device__ __forceinline__ unsigned xb_add(unsigned* p, unsigned v) { return __hip_atomic_fetch_add(p, v, __ATOMIC_RELAXED, __HIP_MEMORY_SCOPE_AGENT); }
__device__ __forceinline__ unsigned xb_xcc_id() { return (unsigned)__builtin_amdgcn_s_getreg((3 << 11) | 20) & 0xFu; }
#define XB_SPIN(cond, bar) do { unsigned _sp = 0; while (cond) { __builtin_amdgcn_s_sleep(1); \
    if ((++_sp & 255u) == 0u) { if (xb_ld(&(bar)[XB_TMO])) break; if (_sp > XB_SPIN_CAP) { atomicAdd(&(bar)[XB_TMO], 1u); break; } } } } while (0)
struct XcdBarrier { unsigned* bar; unsigned x; volatile LAS unsigned* st; };
__device__ __forceinline__ XcdBarrier xcd_barrier_post(unsigned* bar, volatile LAS unsigned* st) {
    XcdBarrier b; b.bar = bar; b.x = xb_xcc_id(); b.st = st;
    if (threadIdx.x == 0) (void)xb_add(&bar[XB_XCNT(b.x)], 1u);
    return b;
}
__device__ __forceinline__ void xcd_barrier_complete(unsigned* bar, unsigned x, unsigned& nloc, unsigned& nx) {
    const unsigned G = gridDim.x * gridDim.y * gridDim.z;
    unsigned sum, cnt, mine, sp = 0u;
    for (;;) {
        sum = 0u; cnt = 0u; mine = 0u;
#pragma unroll
        for (unsigned j = 0; j < 16; ++j) { const unsigned c = xb_ld(&bar[XB_XCNT(j)]); sum += c; cnt += (c > 0u) ? 1u : 0u; mine = (j == x) ? c : mine; }
        if (sum == G) break;
        __builtin_amdgcn_s_sleep(1);
        if ((++sp & 255u) == 0u) { if (xb_ld(&bar[XB_TMO])) break; if (sp > XB_SPIN_CAP) { atomicAdd(&bar[XB_TMO], 1u); break; } }
    }
    nloc = mine > 0u ? mine : 1u; nx = cnt > 0u ? cnt : 1u;
}
__device__ __forceinline__ void xcd_barrier_arrive(const XcdBarrier& b) {
    asm volatile("s_waitcnt vmcnt(0)" ::: "memory");
    __syncthreads();
    if (threadIdx.x == 0) {
        unsigned* bar = b.bar;
        __builtin_amdgcn_s_waitcnt(0);
        unsigned nloc = b.st[0], nx = b.st[1];
        if (nloc == 0u) { xcd_barrier_complete(bar, b.x, nloc, nx); b.st[0] = nloc; b.st[1] = nx; }
        const unsigned old = xb_add(&bar[XB_XSUB(b.x)], 1u);
        const unsigned gen = old / nloc;
        if (old + 1u == (gen + 1u) * nloc) {
            __builtin_amdgcn_fence(__ATOMIC_RELEASE, "agent");
            asm volatile("s_waitcnt vmcnt(0)" ::: "memory");
            const unsigned og = xb_add(&bar[XB_TOP], 1u);
            const unsigned tg = og / nx;
            if (og + 1u == (tg + 1u) * nx) xb_add(&bar[XB_TOPGEN], 1u);
        }
    }
}
__device__ __forceinline__ void xcd_barrier_wait(const XcdBarrier& b) {
    if (threadIdx.x == 0) {
        unsigned* bar = b.bar;
        const unsigned tgen = b.st[2]; b.st[2] = tgen + 1u;
        XB_SPIN(xb_ld(&bar[XB_TOPGEN]) <= tgen, bar);
        __builtin_amdgcn_fence(__ATOMIC_ACQUIRE, "agent");
        asm volatile("s_waitcnt vmcnt(0)" ::: "memory");
    }
    __syncthreads();
}
__device__ __forceinline__ void xcd_barrier(const XcdBarrier& b) { xcd_barrier_arrive(b); xcd_barrier_wait(b); }

#define PH_PROLOG int tid_ = threadIdx.x; asm volatile("" : "+v"(tid_)); const int tid = tid_, lane = tid & 63, wid = __builtin_amdgcn_readfirstlane(tid >> 6); \
    const int G = gridDim.x, W = blockIdx.x * 8 + wid, NW = G * 8; LAS unsigned char* vs = lds + wid * 9216; (void)vs; (void)W; (void)NW; (void)lane; (void)G;
#ifndef REP_MASK
#define REP_MASK 0
#endif
#ifndef REPN
#define REPN 2
#endif
#ifndef EXTRA_SYNCS
#define EXTRA_SYNCS 0
#endif
#define PHASE(N, ...) if constexpr ((PH_MASK >> N) & 1) { if (p.ph_lo <= N && N < p.ph_hi) { \
    for (int rep_ = 0; rep_ < (((REP_MASK >> N) & 1) ? REPN : 1); ++rep_) { if (rep_) xcd_barrier(xb); { PH_PROLOG __VA_ARGS__ } } } } if (p.ph_lo <= N && N + 1 < p.ph_hi) xcd_barrier(xb);
#define PHASE_S(N, SLOT, ...) if constexpr ((PH_MASK >> N) & 1) { if (p.ph_lo <= N && N < p.ph_hi) { { PH_PROLOG __VA_ARGS__ } } } \
    if (p.ph_lo <= N && N + 1 < p.ph_hi) { xcd_barrier_arrive(xb); \
        { constexpr int lo_ = 2 * 16 * 44 + 44 * 16 + 16 * 80 + 2 * 8 * 16 + 16 * 16 + (SLOT) * 512, end_ = 2 * 16 * 44 + 44 * 16 + 16 * 80 + 2 * 8 * 16 + 16 * 16 + 2 * 16 * 44 + 44 * 16; \
          if ((int)gridDim.x == 256) deferred_weights(p, lds, (int)blockIdx.x, 256, lo_, (lo_ + 512 < end_ ? lo_ + 512 : end_)); } \
        xcd_barrier_wait(xb); }

__global__ void __launch_bounds__(512) fwd_megakernel(Params p) {
    extern __shared__ __attribute__((aligned(16))) unsigned char shm_raw[];
    LAS unsigned char* lds = (LAS unsigned char*)shm_raw;
    cg::grid_group grid = cg::this_grid();
    unsigned char* ws = p.ws;
    volatile LAS unsigned* xst = (volatile LAS unsigned*)(lds + XST_OFF);
    if (threadIdx.x == 0) { xst[0] = 0u; xst[1] = 0u; xst[2] = 0u; }
    __syncthreads();
    XcdBarrier xb = xcd_barrier_post(g_sync, xst);
    if (p.use_cg) grid.sync();

    for (int es_ = 0; es_ < EXTRA_SYNCS; ++es_) xcd_barrier(xb);
    PHASE(0, prep_phase(p, lds);)
    PHASE(1, pg8::StaticOrder S; S.init(T_, 2 * DFF, G, blockIdx.x); pg8::Gemm g{(const u16*)(ws + WS_AB), (const u16*)(ws + WS_GU1), T_, 2 * DFF, D_};
             build_rtab(lds, S, (const float*)(ws + WS_P0)); EpiSwiglu E{(u16*)(ws + WS_ACT), lds}; pg8::gemm_phase(lds, g, S, E);
             { const int nfull = (T_ / 256) * (2 * DFF / 256) - 5 * G;
               constexpr int lo_ = 2 * 16 * 44, hi_ = lo_ + 44 * 16 + 16 * 80 + 2 * 8 * 16 + 16 * 16;
               if (nfull >= 0 && nfull < G) { if ((int)blockIdx.x >= nfull) deferred_weights(p, lds, (int)blockIdx.x - nfull, G - nfull, lo_, hi_); }
               else deferred_weights(p, lds, (int)blockIdx.x, G, lo_, hi_); })
    PHASE_S(2, 0, pg8::StaticOrder S; S.init(T_, D_, G, blockIdx.x); pg8::Gemm g{(const u16*)(ws + WS_ACT), (const u16*)(ws + WS_DN1), T_, D_, DFF};
             EpiResid<false> E{(const u16*)(ws + WS_AB), nullptr, (u16*)p.out, (float*)(ws + WS_P1), 0.5f}; pg8::gemm_phase(lds, g, S, E);)
    PHASE_S(3, 1, pg8::StaticOrder S; S.init(T_, DIN, G, blockIdx.x); pg8::Gemm g{(const u16*)p.out, (const u16*)(ws + WS_IN), T_, DIN, D_};
             build_rtab(lds, S, (const float*)(ws + WS_P1)); EpiWin E{(u16*)(ws + WS_QKVA), (u16*)(ws + WS_QKVB), (u16*)(ws + WS_GATES), lds, (const float*)(ws + WS_CS), p.bg, (float*)(ws + WS_KMEAN)}; pg8::gemm_phase(lds, g, S, E);)
    PHASE_S(4, 2, for (int i = W; i < (T_ / 64) * NH; i += NW) topk_item(p, i, lane, (LAS int*)(lds + wid * 512));
             __syncthreads(); sb_block_stream(p, lds, tid, wid, lane); __syncthreads();)
    PHASE_S(6, 3, LAS int* pref = (LAS int*)(lds + 96 * 1024); const int* cnt = (const int*)(ws + WS_CNT);
             __syncthreads();
             pref[tid] = (cnt[tid] + 127) >> 7; __syncthreads();
             for (int o = 1; o < 512; o <<= 1) { const int v = tid >= o ? pref[tid - o] : 0; __syncthreads(); pref[tid] += v; __syncthreads(); }
             const int total = pref[511];
             LAS int* sched = (LAS int*)(lds + 148 * 1024);
             { const int slot0 = (G & 7) == 0 ? (int)(blockIdx.x & 7) * (G >> 3) + (int)(blockIdx.x >> 3) : (int)blockIdx.x; const int ii = slot0 + tid * G;
               if (tid < 64 && ii < total) { int lo = 0; int hi = 511; while (lo < hi) { const int mid = (lo + hi) >> 1; if (pref[mid] > ii) hi = mid; else lo = mid + 1; }
                   sched[tid * 4] = lo; sched[tid * 4 + 1] = ii - (lo ? pref[lo - 1] : 0); sched[tid * 4 + 2] = cnt[lo]; } }
             __syncthreads();
             sel_block_stream(p, lds, sched, total, tid, wid, lane);
             __syncthreads();)
    PHASE_S(7, 4, __syncthreads(); own_block_stream(p, lds, tid, wid, lane); __syncthreads();)
    PHASE(8, { pg8::StaticOrder S; S.init(T_, D_, G, blockIdx.x); pg8::Gemm g{(const u16*)(ws + WS_AB), (const u16*)(ws + WS_BA), T_, D_, 512};
               EpiBranch<true> E{(const u16*)(ws + WS_GATES), (u16*)(ws + WS_TMP), (u16*)(ws + WS_MERGED)}; pg8::gemm_phase(lds, g, S, E); }
             { pg8::StaticOrder S; S.init(T_, D_, G, blockIdx.x); pg8::Gemm g{(const u16*)(ws + WS_AB) + (size_t)T_ * 512, (const u16*)(ws + WS_BB), T_, D_, 512};
               EpiBranch<false> E{(const u16*)(ws + WS_GATES), (u16*)(ws + WS_TMP), (u16*)(ws + WS_MERGED)}; pg8::gemm_phase(lds, g, S, E); })
    PHASE(9, pg8::StaticOrder S; S.init(T_, D_, G, blockIdx.x); pg8::Gemm g{(const u16*)(ws + WS_MERGED), (const u16*)(ws + WS_WO), T_, D_, D_};
             EpiResid<false> E{(const u16*)p.out, nullptr, (u16*)(ws + WS_AB), (float*)(ws + WS_P2), 1.0f}; pg8::gemm_phase(lds, g, S, E);)
    PHASE(10, pg8::StaticOrder S; S.init(T_, 2 * DFF, G, blockIdx.x); pg8::Gemm g{(const u16*)(ws + WS_AB), (const u16*)(ws + WS_GU2), T_, 2 * DFF, D_};
              build_rtab(lds, S, (const float*)(ws + WS_P2)); EpiSwiglu E{(u16*)(ws + WS_ACT), lds}; pg8::gemm_phase(lds, g, S, E);)
    PHASE(11, pg8::StaticOrder S; S.init(T_, D_, G, blockIdx.x); pg8::Gemm g{(const u16*)(ws + WS_ACT), (const u16*)(ws + WS_DN2), T_, D_, DFF};
              EpiFinal E{(const u16*)(ws + WS_AB), p.out, (float*)(ws + WS_P3), g_sync + 4096, p.nf, 0.5f}; pg8::gemm_phase(lds, g, S, E);)
    asm volatile("s_waitcnt vmcnt(0)" ::: "memory");
    __syncthreads();
    if (threadIdx.x == 0) xst[3] = (__hip_atomic_fetch_add(&g_sync[8192], 1u, __ATOMIC_RELAXED, __HIP_MEMORY_SCOPE_AGENT) == gridDim.x - 1u) ? 1u : 0u;
    __syncthreads();
    if (xst[3]) { for (int i2 = threadIdx.x; i2 < 8192; i2 += 512) g_sync[i2] = 0u; if (threadIdx.x == 0) g_sync[8192] = 0u; }
}

extern "C" void kernel_launch(void* const* d_in, const int* in_sizes, int n_in, void* d_out, int out_size, void* d_ws, size_t ws_size, hipStream_t stream) {
    constexpr int LDS_BYTES = 152 * 1024 + 64 + 7 * 1024;
    static int grid = 0;
    if (grid == 0) {
        int dev = 0, cus = 0, per_cu = 0;
        hipGetDevice(&dev); hipDeviceGetAttribute(&cus, hipDeviceAttributeMultiprocessorCount, dev);
        hipFuncSetAttribute((const void*)fwd_megakernel, hipFuncAttributeMaxDynamicSharedMemorySize, LDS_BYTES);
        hipOccupancyMaxActiveBlocksPerMultiprocessor(&per_cu, (const void*)fwd_megakernel, 512, LDS_BYTES);
        if (per_cu < 1) { fprintf(stderr, "occupancy query says %d blocks/CU\n", per_cu); per_cu = 1; }
        (void)hipGetLastError();
        grid = cus;
        if (ws_size < WS_END) { fprintf(stderr, "workspace too small: %zu < %zu\n", ws_size, (size_t)WS_END); grid = -1; }
    }
    if (grid < 0) return;
    Params p{};
    p.x = (const float*)d_in[0]; p.pos = (const int*)d_in[1];
    p.n1 = (const float*)d_in[2]; p.g1 = (const float*)d_in[3]; p.u1 = (const float*)d_in[4]; p.d1 = (const float*)d_in[5];
    p.nm = (const float*)d_in[6]; p.win = (const float*)d_in[7]; p.bg = (const float*)d_in[8]; p.wba = (const float*)d_in[9]; p.wbb = (const float*)d_in[10]; p.wo = (const float*)d_in[11];
    p.n2 = (const float*)d_in[12]; p.g2 = (const float*)d_in[13]; p.u2 = (const float*)d_in[14]; p.d2 = (const float*)d_in[15]; p.nf = (const float*)d_in[16];
    p.out = (float*)d_out; p.ws = (unsigned char*)d_ws;
#ifndef ONE_LAUNCH
#define ONE_LAUNCH 1
#endif
#if ONE_LAUNCH
    p.ph_lo = 0; p.ph_hi = N_PHASES;
    void* args[] = {&p};
    hipError_t e = hipLaunchCooperativeKernel((const void*)fwd_megakernel, dim3(grid), dim3(512), args, LDS_BYTES, stream);
    if (e != hipSuccess) fprintf(stderr, "cooperative launch failed: %s (grid %d)\n", hipGetErrorString(e), grid);
#else
#ifndef DBG_MASK
#define DBG_MASK 0x1fff
#endif
#ifndef DBG_FPART
#define DBG_FPART 0
#endif
    p.fpart = DBG_FPART;
    for (int ph = 0; ph < N_PHASES; ++ph) { if (!((DBG_MASK >> ph) & 1)) continue; p.ph_lo = ph; p.ph_hi = ph + 1; hipLaunchKernelGGL(fwd_megakernel, dim3(grid), dim3(512), LDS_BYTES, stream, p); }
#endif
}
```

```cpp
#include <hip/hip_runtime.h>
#include <hip/hip_cooperative_groups.h>
#include <cstdio>
namespace cg = cooperative_groups;

#define LAS __attribute__((address_space(3)))
typedef unsigned short u16;
typedef short bf16x8 __attribute__((ext_vector_type(8)));
typedef short s16x4 __attribute__((ext_vector_type(4)));
typedef float f32x4 __attribute__((ext_vector_type(4)));
typedef unsigned u32x4 __attribute__((ext_vector_type(4)));
typedef unsigned u32x2 __attribute__((ext_vector_type(2)));

constexpr int T_ = 16384, D_ = 1024, DFF = 2816, DIN = 5120, NH = 8, HD = 64;
constexpr int LDA_ = 1536;
constexpr float EPS = 1e-6f;
constexpr int LISTH = 256 * 2016;
constexpr int N_PHASES = 12;
#ifndef PH_MASK
#define PH_MASK 0x1fff
#endif

constexpr size_t SZ_GU = (size_t)2 * DFF * D_ * 2, SZ_DN = (size_t)D_ * DFF * 2, SZ_IN = (size_t)DIN * D_ * 2, SZ_BR = (size_t)D_ * 512 * 2, SZ_WO = (size_t)D_ * D_ * 2;
constexpr size_t WS_GU1 = 0, WS_DN1 = WS_GU1 + SZ_GU, WS_IN = WS_DN1 + SZ_DN, WS_BA = WS_IN + SZ_IN, WS_BB = WS_BA + SZ_BR, WS_WO = WS_BB + SZ_BR,
                 WS_GU2 = WS_WO + SZ_WO, WS_DN2 = WS_GU2 + SZ_GU, WS_CS = WS_DN2 + SZ_DN;
constexpr size_t SZ_PART = (size_t)T_ * 16 * 4;
constexpr size_t WS_P0 = WS_CS + (size_t)T_ * 16 * 4, WS_P1 = WS_P0 + SZ_PART, WS_P2 = WS_P1 + SZ_PART, WS_P3 = WS_P2 + SZ_PART;
constexpr size_t WS_KMEAN = WS_P3 + SZ_PART, WS_CNT = WS_KMEAN + (size_t)64 * 2 * 512 * 4, WS_BAR = WS_CNT + 4096, WS_PML = WS_BAR + 32768;
constexpr size_t WS_LIST = WS_PML + (size_t)T_ * NH * 3 * 2 * 4;
constexpr size_t WS_AB = WS_LIST + (size_t)NH * LISTH * 2;
constexpr size_t WS_BIG = WS_AB + (size_t)T_ * D_ * 2;
constexpr size_t SZ_QKV = (size_t)T_ * LDA_ * 2;
constexpr size_t WS_GATES = WS_BIG, WS_QKVA = WS_GATES + (size_t)T_ * 2048 * 2, WS_QKVB = WS_QKVA + SZ_QKV, WS_END = WS_QKVB + SZ_QKV;
constexpr size_t WS_ACT = WS_BIG, WS_TMP = WS_QKVA, WS_MERGED = WS_TMP + (size_t)T_ * D_ * 4, WS_PO = WS_QKVB;
static_assert(WS_END <= (size_t)256 * 1024 * 1024, "workspace");
static_assert(WS_AB % 256 == 0 && WS_BIG % 256 == 0 && WS_LIST % 16 == 0, "align");

__device__ unsigned g_sync[8192 + 64];

struct Params {
    const float* x; const int* pos;
    const float *n1, *g1, *u1, *d1, *nm, *win, *bg, *wba, *wbb, *wo, *n2, *g2, *u2, *d2, *nf;
    float* out; unsigned char* ws;
    int ph_lo, ph_hi, fpart, use_cg;
};

typedef __bf16 bf16x2_t __attribute__((ext_vector_type(2)));
typedef float f32x2_t __attribute__((ext_vector_type(2)));
__device__ __forceinline__ unsigned cvt_pk_bf16(float lo, float hi) { f32x2_t v = {lo, hi}; bf16x2_t b = __builtin_convertvector(v, bf16x2_t); return __builtin_bit_cast(unsigned, b); }
__device__ __forceinline__ float bf2f(u16 b) { return __uint_as_float(((unsigned)b) << 16); }
__device__ __forceinline__ float bflo(unsigned w) { return __uint_as_float(w << 16); }
__device__ __forceinline__ float bfhi(unsigned w) { return __uint_as_float(w & 0xffff0000u); }
__device__ __forceinline__ float fexp2(float x) { return __builtin_amdgcn_exp2f(x); }
__device__ __forceinline__ float frcp(float x) { return __builtin_amdgcn_rcpf(x); }

namespace pg8 {
constexpr int BM = 256, BK = 64, HALF = 128, HTB = HALF * BK * 2, STAGE_BYTES = 8 * HTB, NXCD = 8, WGM = 8;
__host__ __device__ __forceinline__ int lds_byte(int r, int c) { const int st = (r >> 4) * 2 + (c >> 5), rr = r & 15, cc = c & 31, ob = rr * 64 + cc * 2; return st * 1024 + (ob ^ (((ob >> 9) & 1) << 5)); }
__host__ __device__ __forceinline__ void stage_rc(int b, int& R, int& C) { const int st = b / 1024, sb = b % 1024, swz = sb ^ (((sb >> 9) & 1) << 5); R = (st >> 1) * 16 + swz / 64; C = (st & 1) * 32 + (swz % 64) / 2; }
struct Unit { int pm, pn; };
struct Gemm { const u16* A; const u16* Bt; int M, N, K; };
struct StaticOrder {
    int nM, nN, nwg, G, c;
    __host__ __device__ void init(int M, int N, int G_, int c_) { nM = M / BM; nN = N / BM; nwg = nM * nN; G = G_; c = c_; }
    __host__ __device__ bool next(int i, Unit& u) const {
        const long L = (long)i * G + c; if (L >= nwg) return false;
        int wgid = (int)L; { const int q = nwg / NXCD, r = nwg % NXCD, xcd = wgid % NXCD, off = wgid / NXCD; wgid = (xcd < r ? xcd * (q + 1) : r * (q + 1) + (xcd - r) * q) + off; }
        const int nig = WGM * nN, gid = wgid / nig, fm = gid * WGM, gsz = (nM - fm) < WGM ? (nM - fm) : WGM;
        u.pm = fm + ((wgid % nig) % gsz); u.pn = (wgid % nig) / gsz; return true;
    }
};

template <class Epi>
__device__ __forceinline__ void gemm_phase(LAS unsigned char* lds, const Gemm g, const StaticOrder& S, const Epi& E) {
    int tid_ = threadIdx.x; asm volatile("" : "+v"(tid_));
    const int tid = tid_, wid = __builtin_amdgcn_readfirstlane(tid >> 6), lane = tid & 63, wr = wid >> 2, wc = wid & 3, fr = lane & 15, fq = lane >> 4;
    const int K = g.K, nt = K / BK;
    unsigned voffA[2];
#pragma unroll
    for (int i = 0; i < 2; ++i) { int R, C; stage_rc(tid * 16 + i * 8192, R, C); voffA[i] = (unsigned)(R * K + C) * 2u; }
    const size_t kstep = (size_t)(BK * 2);
    const size_t hstep = (size_t)HALF * K * 2;
    const size_t tstep = 2 * hstep;
    const unsigned ldsw = (unsigned)wid * 1024u;
    const int aoff = lds_byte(wr * 64 + fr, fq * 8), boff = lds_byte(wc * 32 + fr, fq * 8);
#define PG8_SA(b, h) (((b) * 2 + (h)) * HTB)
#define PG8_SB(b, h) ((4 + (b) * 2 + (h)) * HTB)
#define PG8_STAGE(bufoff, gbase, voff) do { _Pragma("unroll") for (int _i = 0; _i < 2; ++_i) \
        __builtin_amdgcn_global_load_lds((const unsigned*)((const char*)(gbase) + (voff)[_i]), (LAS unsigned*)(lds + (bufoff) + ldsw + _i * 8192), 16, 0, 0); } while (0)
#define PG8_LDA(dst, b, h) do { _Pragma("unroll") for (int m = 0; m < 4; ++m) _Pragma("unroll") for (int k = 0; k < 2; ++k) dst[m][k] = *(const LAS bf16x8*)(lds + PG8_SA(b, h) + aoff + m * 2048 + k * 1024); } while (0)
#define PG8_LDB(dst, b, h) do { _Pragma("unroll") for (int n = 0; n < 2; ++n) _Pragma("unroll") for (int k = 0; k < 2; ++k) dst[n][k] = *(const LAS bf16x8*)(lds + PG8_SB(b, h) + boff + n * 2048 + k * 1024); } while (0)
#define PG8_MMA(ai, bj, At, Bt) do { __builtin_amdgcn_s_setprio(1); _Pragma("unroll") for (int m = 0; m < 4; ++m) _Pragma("unroll") for (int n = 0; n < 2; ++n) _Pragma("unroll") for (int k = 0; k < 2; ++k) \
        acc[ai][bj][m][n] = __builtin_amdgcn_mfma_f32_16x16x32_bf16(Bt[n][k], At[m][k], acc[ai][bj][m][n], 0, 0, 0); __builtin_amdgcn_s_setprio(0); } while (0)
#define PG8_WAIT_V(n) asm volatile("s_waitcnt vmcnt(" #n ")" ::: "memory")
#define PG8_WAIT_L(n) asm volatile("s_waitcnt lgkmcnt(" #n ")" ::: "memory")
#define PG8_BAR __builtin_amdgcn_s_barrier()
#define PG8_SCHED __builtin_amdgcn_sched_barrier(0)
    Unit cur, nxt; int ui = 0;
    if (!S.next(0, cur)) return;
    f32x4 acc[2][2][4][2];
#pragma unroll
    for (int a = 0; a < 2; ++a)
#pragma unroll
        for (int b = 0; b < 2; ++b)
#pragma unroll
            for (int m = 0; m < 4; ++m)
#pragma unroll
                for (int n = 0; n < 2; ++n) acc[a][b][m][n] = (f32x4){0.f, 0.f, 0.f, 0.f};
    bf16x8 At[4][2], B0[2][2], B1[2][2];
    const char* cA = (const char*)g.A + (size_t)cur.pm * tstep; const char* cB = (const char*)g.Bt + (size_t)cur.pn * tstep;
    PG8_STAGE(PG8_SB(0, 0), cB, voffA); PG8_STAGE(PG8_SA(0, 0), cA, voffA); PG8_STAGE(PG8_SB(0, 1), cB + hstep, voffA); PG8_STAGE(PG8_SA(0, 1), cA + hstep, voffA);
    if (wr == 1) PG8_BAR;
    PG8_WAIT_V(4); PG8_BAR;
    PG8_STAGE(PG8_SB(1, 0), cB + kstep, voffA); PG8_STAGE(PG8_SA(1, 0), cA + kstep, voffA); PG8_STAGE(PG8_SB(1, 1), cB + hstep + kstep, voffA);
    PG8_WAIT_V(6); PG8_BAR;
    for (;;) {
        const bool has_next = S.next(ui + 1, nxt);
        const char* nA = has_next ? (const char*)g.A + (size_t)nxt.pm * tstep : cA; const char* nB = has_next ? (const char*)g.Bt + (size_t)nxt.pn * tstep : cB;
        for (int t = 0; t < nt; t += 2) {
            const bool last = (t == nt - 2);
            const char* a1 = cA + (size_t)(t + 1) * kstep;
            const char* a2 = last ? nA : cA + (size_t)(t + 2) * kstep; const char* b2 = last ? nB : cB + (size_t)(t + 2) * kstep;
            const char* a3 = a2 + kstep; const char* b3 = b2 + kstep;
            PG8_LDB(B0, 0, 0); PG8_SCHED; PG8_LDA(At, 0, 0); PG8_STAGE(PG8_SA(1, 1), a1 + hstep, voffA);
            PG8_WAIT_L(8); PG8_BAR; PG8_WAIT_L(0); PG8_MMA(0, 0, At, B0); PG8_BAR; PG8_SCHED;
            PG8_LDB(B1, 0, 1); PG8_STAGE(PG8_SB(0, 0), b2, voffA);
            PG8_BAR; PG8_WAIT_L(0); PG8_MMA(0, 1, At, B1); PG8_BAR;
            PG8_LDA(At, 0, 1); PG8_STAGE(PG8_SA(0, 0), a2, voffA);
            PG8_BAR; PG8_WAIT_L(0); PG8_MMA(1, 0, At, B0); PG8_BAR; PG8_SCHED;
            PG8_STAGE(PG8_SB(0, 1), b2 + hstep, voffA);
            PG8_WAIT_V(6); PG8_BAR; PG8_MMA(1, 1, At, B1); PG8_BAR;
            PG8_LDB(B0, 1, 0); PG8_SCHED; PG8_LDA(At, 1, 0); PG8_STAGE(PG8_SA(0, 1), a2 + hstep, voffA);
            PG8_WAIT_L(8); PG8_BAR; PG8_WAIT_L(0); PG8_MMA(0, 0, At, B0); PG8_BAR; PG8_SCHED;
            PG8_LDB(B1, 1, 1); PG8_STAGE(PG8_SB(1, 0), b3, voffA);
            PG8_BAR; PG8_WAIT_L(0); PG8_MMA(0, 1, At, B1); PG8_BAR;
            PG8_LDA(At, 1, 1); PG8_STAGE(PG8_SA(1, 0), a3, voffA);
            PG8_BAR; PG8_WAIT_L(0); PG8_MMA(1, 0, At, B0); PG8_BAR; PG8_SCHED;
            PG8_STAGE(PG8_SB(1, 1), b3 + hstep, voffA);
            PG8_WAIT_V(6); PG8_BAR; PG8_MMA(1, 1, At, B1); PG8_BAR;
        }
        if constexpr (!Epi::AFTER_DRAIN) E(acc, cur, ui, wr, wc, fr, fq);
        if (!has_next) break;
#pragma unroll
        for (int a = 0; a < 2; ++a)
#pragma unroll
            for (int b = 0; b < 2; ++b)
#pragma unroll
                for (int m = 0; m < 4; ++m)
#pragma unroll
                    for (int n = 0; n < 2; ++n) acc[a][b][m][n] = (f32x4){0.f, 0.f, 0.f, 0.f};
        cur = nxt; cA = nA; cB = nB; ++ui;
    }
    PG8_WAIT_V(0);
    if (wr == 0) PG8_BAR;
    PG8_BAR;
    if constexpr (Epi::AFTER_DRAIN) E.fused(acc, cur, wr, wc, fr, fq, lane);
#undef PG8_SA
#undef PG8_SB
#undef PG8_STAGE
#undef PG8_LDA
#undef PG8_LDB
#undef PG8_MMA
#undef PG8_WAIT_V
#undef PG8_WAIT_L
#undef PG8_BAR
#undef PG8_SCHED
}
}
using pg8::Unit;
typedef f32x4 Acc[2][2][4][2];

constexpr int XST_OFF = 152 * 1024, RTAB_OFF = XST_OFF + 64;
__device__ __forceinline__ void build_rtab(LAS unsigned char* lds, const pg8::StaticOrder& S, const float* part) {
    LAS float* rtab = (LAS float*)(lds + RTAB_OFF);
    int nu = 0; { pg8::Unit u; while (nu < 7 && S.next(nu, u)) ++nu; }
    for (int idx = threadIdx.x; idx < nu * 256; idx += 512) { pg8::Unit u; S.next(idx >> 8, u);
        const f32x4* pp = (const f32x4*)(part + (size_t)(u.pm * 256 + (idx & 255)) * 16);
        f32x4 a = pp[0], b = pp[1], c = pp[2], d = pp[3]; f32x4 sv = (a + b) + (c + d);
        rtab[idx] = __builtin_amdgcn_rsqf((sv[0] + sv[1] + sv[2] + sv[3]) * (1.0f / D_) + EPS); }
    __syncthreads();
}
__device__ __forceinline__ void rtab_get(float (&rinv)[2][4], LAS const unsigned char* lds, int ui, int wr, int fr) {
    LAS const float* rtab = (LAS const float*)(lds + RTAB_OFF) + ui * 256 + wr * 64 + fr;
#pragma unroll
    for (int ai = 0; ai < 2; ++ai)
#pragma unroll
        for (int m = 0; m < 4; ++m) rinv[ai][m] = rtab[ai * 128 + m * 16];
}

struct EpiSwiglu {
    static constexpr bool AFTER_DRAIN = false;
    u16* act; LAS const unsigned char* lds;
    __device__ __forceinline__ void operator()(const Acc& acc, const Unit& u, int ui, int wr, int wc, int fr, int fq) const {
        const int row0 = u.pm * 256 + wr * 64 + fr, col0 = u.pn * 128 + wc * 32 + fq * 8;
        float rinv[2][4]; rtab_get(rinv, lds, ui, wr, fr);
#pragma unroll
        for (int ai = 0; ai < 2; ++ai)
#pragma unroll
            for (int m = 0; m < 4; ++m) {
                const float ri = rinv[ai][m]; float v[8];
#pragma unroll
                for (int n = 0; n < 2; ++n)
#pragma unroll
                    for (int j = 0; j < 4; ++j) { const float g = acc[ai][0][m][n][j] * ri, up = acc[ai][1][m][n][j] * ri;
                        v[n * 4 + j] = g * frcp(1.0f + fexp2(-1.4426950408889634f * g)) * up; }
                u32x4 o; o[0] = cvt_pk_bf16(v[0], v[1]); o[1] = cvt_pk_bf16(v[2], v[3]); o[2] = cvt_pk_bf16(v[4], v[5]); o[3] = cvt_pk_bf16(v[6], v[7]);
                *(u32x4*)(act + (size_t)(row0 + ai * 128 + m * 16) * DFF + col0) = o;
            }
    }
};

template <bool OF> struct EpiResid {
    static constexpr bool AFTER_DRAIN = true;
    const u16* resid; float* out; u16* hb; float* part; float scale;
    __device__ __forceinline__ void fused(Acc& acc, const Unit& u, int wr, int wc, int fr, int fq, int) const { (*this)(acc, u, 0, wr, wc, fr, fq); }
    __device__ __forceinline__ void operator()(const Acc& acc, const Unit& u, int ui, int wr, int wc, int fr, int fq) const {
        const int row0 = u.pm * 256 + wr * 64 + fr, col0 = u.pn * 256 + wc * 32 + fq * 8;
        u32x4 rwa[2][4][2];
#pragma unroll
        for (int ai = 0; ai < 2; ++ai)
#pragma unroll
            for (int m = 0; m < 4; ++m)
#pragma unroll
                for (int bj = 0; bj < 2; ++bj) rwa[ai][m][bj] = *(const u32x4*)(resid + (size_t)(row0 + ai * 128 + m * 16) * D_ + col0 + bj * 128);
#pragma unroll
        for (int ai = 0; ai < 2; ++ai) {
#pragma unroll
            for (int m = 0; m < 4; ++m) {
                const int row = row0 + ai * 128 + m * 16; float ss = 0.f;
#pragma unroll
                for (int bj = 0; bj < 2; ++bj) {
                    const size_t o = (size_t)row * D_ + col0 + bj * 128;
                    const u32x4 w = rwa[ai][m][bj];
                    f32x4 h0 = (f32x4){bflo(w[0]), bfhi(w[0]), bflo(w[1]), bfhi(w[1])} + acc[ai][bj][m][0] * scale;
                    f32x4 h1 = (f32x4){bflo(w[2]), bfhi(w[2]), bflo(w[3]), bfhi(w[3])} + acc[ai][bj][m][1] * scale;
                    ss += h0[0] * h0[0] + h0[1] * h0[1] + h0[2] * h0[2] + h0[3] * h0[3] + h1[0] * h1[0] + h1[1] * h1[1] + h1[2] * h1[2] + h1[3] * h1[3];
                    if (OF) { *(f32x4*)(out + o) = h0; *(f32x4*)(out + o + 4) = h1; }
                    else { u32x4 b; b[0] = cvt_pk_bf16(h0[0], h0[1]); b[1] = cvt_pk_bf16(h0[2], h0[3]); b[2] = cvt_pk_bf16(h1[0], h1[1]); b[3] = cvt_pk_bf16(h1[2], h1[3]); *(u32x4*)(hb + o) = b; }
                }
                ss += __shfl_xor(ss, 16); ss += __shfl_xor(ss, 32);
                if (fq == 0) part[(size_t)row * 16 + u.pn * 4 + wc] = ss;
            }
        }
    }
};

struct EpiWin {
    static constexpr bool AFTER_DRAIN = false;
    u16 *qkva, *qkvb, *gates; LAS const unsigned char* lds; const float *cs, *bgate; float* kmp;
    __device__ __forceinline__ void operator()(const Acc& acc, const Unit& u, int ui, int wr, int wc, int fr, int fq) const {
        const int row0 = u.pm * 256 + wr * 64 + fr;
        const int pn = u.pn;
        LAS const float* rtab = (LAS const float*)(lds + RTAB_OFF) + ui * 256 + wr * 64 + fr;
        if (pn >= 12) {
            f32x4 bb[2][2];
#pragma unroll
            for (int bj = 0; bj < 2; ++bj) { const int gc = pn * 256 + bj * 128 + wc * 32 - 3072 + fq * 8; bb[bj][0] = *(const f32x4*)(bgate + gc); bb[bj][1] = *(const f32x4*)(bgate + gc + 4); }
#pragma unroll
            for (int bj = 0; bj < 2; ++bj) { const int gc = pn * 256 + bj * 128 + wc * 32 - 3072 + fq * 8;
#pragma unroll
                for (int ai = 0; ai < 2; ++ai)
#pragma unroll
                    for (int m = 0; m < 4; ++m) { const float ri = rtab[ai * 128 + m * 16]; float v[8];
#pragma unroll
                        for (int j = 0; j < 4; ++j) { v[j] = acc[ai][bj][m][0][j] * ri + bb[bj][0][j]; v[4 + j] = acc[ai][bj][m][1][j] * ri + bb[bj][1][j]; }
#pragma unroll
                        for (int j = 0; j < 8; ++j) v[j] = frcp(1.0f + fexp2(-1.4426950408889634f * v[j]));
                        u32x4 o; o[0] = cvt_pk_bf16(v[0], v[1]); o[1] = cvt_pk_bf16(v[2], v[3]); o[2] = cvt_pk_bf16(v[4], v[5]); o[3] = cvt_pk_bf16(v[6], v[7]);
                        *(u32x4*)(gates + (size_t)(row0 + ai * 128 + m * 16) * 2048 + gc) = o; } }
        } else {
            const bool isk = (pn == 2) || (pn == 3);
#pragma unroll
            for (int bj = 0; bj < 2; ++bj) {
                const int g32 = pn * 256 + bj * 128 + wc * 32;
                u16* base = g32 < 1536 ? qkva + g32 : qkvb + (g32 - 1536);
                const bool rot = (g32 < 1024) && ((g32 & 63) == 0) && (fq < 2);
                f32x4 ks0 = {0.f, 0.f, 0.f, 0.f}, ks1 = {0.f, 0.f, 0.f, 0.f};
                if (rot) {
#pragma unroll
                    for (int ai = 0; ai < 2; ++ai) {
                        f32x4 cc[4], sn[4];
#pragma unroll
                        for (int m = 0; m < 4; ++m) { const int row = row0 + ai * 128 + m * 16; cc[m] = *(const f32x4*)(cs + (size_t)row * 16 + fq * 4); sn[m] = *(const f32x4*)(cs + (size_t)row * 16 + 8 + fq * 4); }
#pragma unroll
                        for (int m = 0; m < 4; ++m) { const float ri = rtab[ai * 128 + m * 16]; const int row = row0 + ai * 128 + m * 16;
                            f32x4 a = acc[ai][bj][m][0] * ri, b = acc[ai][bj][m][1] * ri;
                            f32x4 o1 = a * cc[m] - b * sn[m], o2 = b * cc[m] + a * sn[m];
                            u32x2 w1, w2; w1[0] = cvt_pk_bf16(o1[0], o1[1]); w1[1] = cvt_pk_bf16(o1[2], o1[3]); w2[0] = cvt_pk_bf16(o2[0], o2[1]); w2[1] = cvt_pk_bf16(o2[2], o2[3]);
                            *(u32x2*)(base + (size_t)row * LDA_ + fq * 4) = w1; *(u32x2*)(base + (size_t)row * LDA_ + 8 + fq * 4) = w2;
                            ks0 += o1; ks1 += o2; } }
                } else {
#pragma unroll
                    for (int ai = 0; ai < 2; ++ai)
#pragma unroll
                        for (int m = 0; m < 4; ++m) { const float ri = rtab[ai * 128 + m * 16]; const int row = row0 + ai * 128 + m * 16;
                            f32x4 a = acc[ai][bj][m][0] * ri, b = acc[ai][bj][m][1] * ri;
                            u32x4 o; o[0] = cvt_pk_bf16(a[0], a[1]); o[1] = cvt_pk_bf16(a[2], a[3]); o[2] = cvt_pk_bf16(b[0], b[1]); o[3] = cvt_pk_bf16(b[2], b[3]);
                            *(u32x4*)(base + (size_t)row * LDA_ + fq * 8) = o;
                            ks0 += a; ks1 += b; }
                }
                if (isk) {
#pragma unroll
                    for (int j = 0; j < 4; ++j) {
#pragma unroll
                        for (int o = 1; o < 16; o <<= 1) { ks0[j] += __shfl_xor(ks0[j], o); ks1[j] += __shfl_xor(ks1[j], o); } }
                    if (fr == 0) { float* kp = kmp + (size_t)u.pm * 512 + (g32 - 512);
#pragma unroll
                        for (int j = 0; j < 4; ++j) { atomicAdd(kp + (rot ? fq * 4 : fq * 8) + j, ks0[j]); atomicAdd(kp + (rot ? 8 + fq * 4 : fq * 8 + 4) + j, ks1[j]); } }
                }
            }
        }
    }
};

template <bool FIRST> struct EpiBranch {
    static constexpr bool AFTER_DRAIN = true;
    const u16* gates; u16* tmp; u16* merged;
    __device__ __forceinline__ void fused(Acc& acc, const Unit& u, int wr, int wc, int fr, int fq, int) const { (*this)(acc, u, 0, wr, wc, fr, fq); }
    __device__ __forceinline__ void operator()(const Acc& acc, const Unit& u, int ui, int wr, int wc, int fr, int fq) const {
        const int row0 = u.pm * 256 + wr * 64 + fr, col0 = u.pn * 256 + wc * 32 + fq * 8;
        constexpr int NB = FIRST ? 1 : 2, AIB = FIRST ? 2 : 1;
#pragma unroll
        for (int bt = 0; bt < NB; ++bt) {
            u32x4 gw[AIB][4][2], tw[AIB][4][2];
#pragma unroll
            for (int a2 = 0; a2 < AIB; ++a2)
#pragma unroll
                for (int m = 0; m < 4; ++m)
#pragma unroll
                    for (int bj = 0; bj < 2; ++bj) { const int ai = FIRST ? a2 : bt, row = row0 + ai * 128 + m * 16, col = col0 + bj * 128;
                        gw[a2][m][bj] = *(const u32x4*)(gates + (size_t)row * 2048 + (FIRST ? 0 : 1024) + col);
                        if (!FIRST) tw[a2][m][bj] = *(const u32x4*)(tmp + (size_t)row * D_ + col); }
#pragma unroll
            for (int a2 = 0; a2 < AIB; ++a2)
#pragma unroll
                for (int m = 0; m < 4; ++m)
#pragma unroll
                    for (int bj = 0; bj < 2; ++bj) { const int ai = FIRST ? a2 : bt, row = row0 + ai * 128 + m * 16, col = col0 + bj * 128;
                        const u32x4 g2 = gw[a2][m][bj];
                        f32x4 v0 = (f32x4){bflo(g2[0]), bfhi(g2[0]), bflo(g2[1]), bfhi(g2[1])} * acc[ai][bj][m][0];
                        f32x4 v1 = (f32x4){bflo(g2[2]), bfhi(g2[2]), bflo(g2[3]), bfhi(g2[3])} * acc[ai][bj][m][1];
                        if (!FIRST) { const u32x4 t2 = tw[a2][m][bj]; v0 += (f32x4){bflo(t2[0]), bfhi(t2[0]), bflo(t2[1]), bfhi(t2[1])}; v1 += (f32x4){bflo(t2[2]), bfhi(t2[2]), bflo(t2[3]), bfhi(t2[3])}; }
                        u32x4 b; b[0] = cvt_pk_bf16(v0[0], v0[1]); b[1] = cvt_pk_bf16(v0[2], v0[3]); b[2] = cvt_pk_bf16(v1[0], v1[1]); b[3] = cvt_pk_bf16(v1[2], v1[3]);
                        *(u32x4*)((FIRST ? tmp : merged) + (size_t)row * D_ + col) = b; }
        }
    }
};

struct EpiFinal {
    static constexpr bool AFTER_DRAIN = true;
    const u16* resid; float* out; float* part; unsigned* pcnt; const float* gain; float scale;
    __device__ __forceinline__ void operator()(const Acc&, const Unit&, int, int, int, int, int) const {}
    __device__ __forceinline__ void fused(Acc& acc, const Unit& u, int wr, int wc, int fr, int fq, int lane) const {
        const int row0 = u.pm * 256 + wr * 64 + fr, col0 = u.pn * 256 + wc * 32 + fq * 8;
        u32x4 rwa[2][4][2];
#pragma unroll
        for (int ai = 0; ai < 2; ++ai)
#pragma unroll
            for (int m = 0; m < 4; ++m)
#pragma unroll
                for (int bj = 0; bj < 2; ++bj) rwa[ai][m][bj] = *(const u32x4*)(resid + (size_t)(row0 + ai * 128 + m * 16) * D_ + col0 + bj * 128);
#pragma unroll
        for (int ai = 0; ai < 2; ++ai)
#pragma unroll
            for (int m = 0; m < 4; ++m) { float ss = 0.f;
#pragma unroll
                for (int bj = 0; bj < 2; ++bj) { const u32x4 w = rwa[ai][m][bj];
                    f32x4 h0 = (f32x4){bflo(w[0]), bfhi(w[0]), bflo(w[1]), bfhi(w[1])} + acc[ai][bj][m][0] * scale;
                    f32x4 h1 = (f32x4){bflo(w[2]), bfhi(w[2]), bflo(w[3]), bfhi(w[3])} + acc[ai][bj][m][1] * scale;
                    acc[ai][bj][m][0] = h0; acc[ai][bj][m][1] = h1;
                    ss += h0[0] * h0[0] + h0[1] * h0[1] + h0[2] * h0[2] + h0[3] * h0[3] + h1[0] * h1[0] + h1[1] * h1[1] + h1[2] * h1[2] + h1[3] * h1[3]; }
                ss += __shfl_xor(ss, 16); ss += __shfl_xor(ss, 32);
                if (fq == 0) __hip_atomic_store(part + (size_t)(row0 + ai * 128 + m * 16) * 16 + u.pn * 4 + wc, ss, __ATOMIC_RELAXED, __HIP_MEMORY_SCOPE_AGENT); }
        asm volatile("s_waitcnt vmcnt(0)" ::: "memory");
        unsigned* cw = pcnt + u.pm * 16;
        if (lane == 0) {
            __hip_atomic_fetch_add(cw, 1u, __ATOMIC_RELAXED, __HIP_MEMORY_SCOPE_AGENT);
            unsigned sp = 0;
            while (__hip_atomic_load(cw, __ATOMIC_RELAXED, __HIP_MEMORY_SCOPE_AGENT) < 32u) { __builtin_amdgcn_s_sleep(1); if (++sp > (1u << 22)) break; }
        }
        float rinv[2][4];
        { float pv[2][4][4];
#pragma unroll
          for (int ai = 0; ai < 2; ++ai)
#pragma unroll
            for (int m = 0; m < 4; ++m)
#pragma unroll
              for (int k = 0; k < 4; ++k) pv[ai][m][k] = __hip_atomic_load(part + (size_t)(row0 + ai * 128 + m * 16) * 16 + fq * 4 + k, __ATOMIC_RELAXED, __HIP_MEMORY_SCOPE_AGENT);
#pragma unroll
          for (int ai = 0; ai < 2; ++ai)
#pragma unroll
            for (int m = 0; m < 4; ++m) { float sv = (pv[ai][m][0] + pv[ai][m][1]) + (pv[ai][m][2] + pv[ai][m][3]);
                sv += __shfl_xor(sv, 16); sv += __shfl_xor(sv, 32); rinv[ai][m] = __builtin_amdgcn_rsqf(sv * (1.0f / D_) + EPS); } }
        f32x4 gv[2][2];
#pragma unroll
        for (int bj = 0; bj < 2; ++bj)
#pragma unroll
            for (int n = 0; n < 2; ++n) gv[bj][n] = *(const f32x4*)(gain + col0 + bj * 128 + n * 4);
#pragma unroll
        for (int ai = 0; ai < 2; ++ai)
#pragma unroll
            for (int m = 0; m < 4; ++m)
#pragma unroll
                for (int bj = 0; bj < 2; ++bj)
#pragma unroll
                    for (int n = 0; n < 2; ++n)
                        *(f32x4*)(out + (size_t)(row0 + ai * 128 + m * 16) * D_ + col0 + bj * 128 + n * 4) = acc[ai][bj][m][n] * rinv[ai][m] * gv[bj][n];
    }
};

__device__ __forceinline__ int map_gu(int c, int up) { const int pn = c >> 7, w = c & 127, wc = w >> 5, r = w & 31; return pn * 256 + up * 128 + wc * 32 + ((r >> 2) & 1) * 16 + (r >> 3) * 4 + (r & 3); }
__device__ __forceinline__ int map_perm8(int c) { const int r = c & 31; return (c & ~31) + ((r >> 2) & 1) * 16 + (r >> 3) * 4 + (r & 3); }
__device__ __forceinline__ int map_win(int c) { if (c < 1024 && (c & 63) < 16) { const int r = c & 15, x2 = r >> 3, i = r & 7; return (c & ~63) + x2 * 16 + (i >> 2) * 4 + (i & 3); } return map_perm8(c); }

struct TileDesc { const float* W; u16* Wt; const float* gain; int K, N, mode, tile; };
struct TileRegs { f32x4 v[2]; float gk[2]; };
__device__ __forceinline__ void tile_load(TileRegs& r, const TileDesc& d) {
    const int ntn = d.N >> 6, tk = d.tile / ntn, tn = d.tile - tk * ntn, k0 = tk * 64, n0 = tn * 64, tid = threadIdx.x;
    const float cscale = d.mode == 3 ? (n0 < 512 ? 0.125f * 1.4426950408889634f : (n0 >= 1536 && n0 < 2048) ? 0.125f * 1.4426950408889634f : 1.0f) : 1.0f;
#pragma unroll
    for (int i = 0; i < 2; ++i) { const int e = tid + i * 512, k = e >> 4, c4 = (e & 15) * 4;
        r.v[i] = *(const f32x4*)(d.W + (size_t)(k0 + k) * d.N + n0 + c4); r.gk[i] = (d.gain ? d.gain[k0 + k] : 1.0f) * cscale; }
}
__device__ __forceinline__ void tile_store(LAS float* tl, const TileRegs& r, const TileDesc& d) {
    const int ntn = d.N >> 6, tk = d.tile / ntn, tn = d.tile - tk * ntn, k0 = tk * 64, n0 = tn * 64, tid = threadIdx.x;
    __syncthreads();
#pragma unroll
    for (int i = 0; i < 2; ++i) { const int e = tid + i * 512, k = e >> 4, c4 = (e & 15) * 4; const f32x4 v = r.v[i] * r.gk[i];
        tl[k * 65 + c4] = v[0]; tl[k * 65 + c4 + 1] = v[1]; tl[k * 65 + c4 + 2] = v[2]; tl[k * 65 + c4 + 3] = v[3]; }
    __syncthreads();
    const int n = tid & 63, kg = tid >> 6; float v[8];
#pragma unroll
    for (int i = 0; i < 8; ++i) v[i] = tl[(kg * 8 + i) * 65 + n];
    const int c = n0 + n; const int rr = d.mode == 0 ? c : d.mode == 1 ? map_gu(c, 0) : d.mode == 2 ? map_gu(c, 1) : d.mode == 3 ? map_win(c) : map_perm8(c);
    u32x4 o; o[0] = cvt_pk_bf16(v[0], v[1]); o[1] = cvt_pk_bf16(v[2], v[3]); o[2] = cvt_pk_bf16(v[4], v[5]); o[3] = cvt_pk_bf16(v[6], v[7]);
    *(u32x4*)(d.Wt + (size_t)rr * d.K + k0 + kg * 8) = o;
}

__device__ __forceinline__ void prep_phase(const Params& p, LAS unsigned char* lds) {
    unsigned char* ws = p.ws; LAS float* tl = (LAS float*)lds;
    const int tid = threadIdx.x, lane = tid & 63, wid = tid >> 6, G = gridDim.x;
    if (blockIdx.x == 0) { ((int*)(ws + WS_CNT))[tid] = 0; }
    if (blockIdx.x < 64) ((float*)(ws + WS_KMEAN))[blockIdx.x * 512 + tid] = 0.f;
    constexpr int T_GU = 16 * 44, T_DN = 44 * 16, T_IN = 16 * 80, T_BR = 8 * 16, T_WO = 16 * 16;
    constexpr int o1 = T_GU, o2 = o1 + T_GU, o3 = o2 + T_DN, o4 = o3 + T_IN, o5 = o4 + T_BR, o6 = o5 + T_BR, o7 = o6 + T_WO, o8 = o7 + T_GU, o9 = o8 + T_GU, o10 = o9 + T_DN;
    auto desc = [&](int t) -> TileDesc {
        if (t < o1) return TileDesc{p.g1, (u16*)(ws + WS_GU1), p.n1, D_, DFF, 1, t};
        if (t < o2) return TileDesc{p.u1, (u16*)(ws + WS_GU1), p.n1, D_, DFF, 2, t - o1};
        if (t < o3) return TileDesc{p.d1, (u16*)(ws + WS_DN1), nullptr, DFF, D_, 4, t - o2};
        if (t < o4) return TileDesc{p.win, (u16*)(ws + WS_IN), p.nm, D_, DIN, 3, t - o3};
        if (t < o5) return TileDesc{p.wba, (u16*)(ws + WS_BA), nullptr, 512, D_, 4, t - o4};
        if (t < o6) return TileDesc{p.wbb, (u16*)(ws + WS_BB), nullptr, 512, D_, 4, t - o5};
        if (t < o7) return TileDesc{p.wo, (u16*)(ws + WS_WO), nullptr, D_, D_, 4, t - o6};
        if (t < o8) return TileDesc{p.g2, (u16*)(ws + WS_GU2), p.n2, D_, DFF, 1, t - o7};
        if (t < o9) return TileDesc{p.u2, (u16*)(ws + WS_GU2), p.n2, D_, DFF, 2, t - o8};
        return TileDesc{p.d2, (u16*)(ws + WS_DN2), nullptr, DFF, D_, 4, t - o9};
    };
    const int NPREP = (int)gridDim.x == 256 ? 2 * T_GU : 2 * T_GU + 2 * T_GU + T_DN;
    auto pdesc = [&](int t) -> TileDesc { return t < 2 * T_GU ? desc(t) : desc(t - 2 * T_GU + o7); };
    { int t = blockIdx.x;
      if (t < NPREP) { TileDesc d = pdesc(t); TileRegs ra; tile_load(ra, d);
        for (;;) { const int tn = t + G; const bool more = tn < NPREP; TileDesc dn = d; TileRegs rb = ra;
            if (more) { dn = pdesc(tn); tile_load(rb, dn); }
            tile_store(tl, ra, d);
            if (!more) break;
            d = dn; ra = rb; t = tn; } } }
    u16* xb = (u16*)(ws + WS_AB); float* part0 = (float*)(ws + WS_P0); float* cs = (float*)(ws + WS_CS);
    f32x4 xv[4];
    { const int row0_ = blockIdx.x * 8 + wid; if (row0_ < T_) {
#pragma unroll
        for (int i = 0; i < 4; ++i) xv[i] = *(const f32x4*)(p.x + (size_t)row0_ * D_ + i * 256 + lane * 4); } }
    for (int row = blockIdx.x * 8 + wid; row < T_; row += G * 8) {
        float ss = 0.f; f32x4 cur[4];
#pragma unroll
        for (int i = 0; i < 4; ++i) cur[i] = xv[i];
        if (row + G * 8 < T_) {
#pragma unroll
            for (int i = 0; i < 4; ++i) xv[i] = *(const f32x4*)(p.x + (size_t)(row + G * 8) * D_ + i * 256 + lane * 4); }
#pragma unroll
        for (int i = 0; i < 4; ++i) { const f32x4 v = cur[i]; ss += v[0] * v[0] + v[1] * v[1] + v[2] * v[2] + v[3] * v[3];
            u32x2 b; b[0] = cvt_pk_bf16(v[0], v[1]); b[1] = cvt_pk_bf16(v[2], v[3]); *(u32x2*)(xb + (size_t)row * D_ + i * 256 + lane * 4) = b; }
#pragma unroll
        for (int o = 32; o >= 1; o >>= 1) ss += __shfl_xor(ss, o);
        if (lane < 16) part0[(size_t)row * 16 + lane] = lane == 0 ? ss : 0.f;
        if (lane >= 16 && lane < 24) {
            const int i = lane - 16;
            const float invf = i == 0 ? 1.0f : i == 1 ? 0.1939227432012558f : i == 2 ? 0.03760603070259094f : i == 3 ? 0.007292664609849453f : i == 4 ? 0.0014142135623842478f
                             : i == 5 ? 0.00027424818836152554f : i == 6 ? 5.318296098266728e-05f : 1.0313386155758053e-05f;
            const float ang = (float)p.pos[row] * invf;
            const double a = (double)ang, kk = __builtin_rint(a * 0.15915494309189535), r = a - kk * 6.283185307179586;
            const float rf = (float)r;
            cs[(size_t)row * 16 + i] = __cosf(rf); cs[(size_t)row * 16 + 8 + i] = __sinf(rf);
        }
    }
}


__device__ __forceinline__ void deferred_weights(const Params& p, LAS unsigned char* lds, int j, int nidle, int lo, int hi) {
    unsigned char* ws = p.ws; LAS float* tl = (LAS float*)lds;
    constexpr int T_GU = 16 * 44, T_DN = 44 * 16, T_IN = 16 * 80, T_BR = 8 * 16, T_WO = 16 * 16;
    constexpr int o2 = 2 * T_GU, o3 = o2 + T_DN, o4 = o3 + T_IN, o5 = o4 + T_BR, o6 = o5 + T_BR, o7 = o6 + T_WO, o8 = o7 + T_GU, o9 = o8 + T_GU;
    auto desc = [&](int t) -> TileDesc {
        if (t < o3) return TileDesc{p.d1, (u16*)(ws + WS_DN1), nullptr, DFF, D_, 4, t - o2};
        if (t < o4) return TileDesc{p.win, (u16*)(ws + WS_IN), p.nm, D_, DIN, 3, t - o3};
        if (t < o5) return TileDesc{p.wba, (u16*)(ws + WS_BA), nullptr, 512, D_, 4, t - o4};
        if (t < o6) return TileDesc{p.wbb, (u16*)(ws + WS_BB), nullptr, 512, D_, 4, t - o5};
        if (t < o7) return TileDesc{p.wo, (u16*)(ws + WS_WO), nullptr, D_, D_, 4, t - o6};
        if (t < o8) return TileDesc{p.g2, (u16*)(ws + WS_GU2), p.n2, D_, DFF, 1, t - o7};
        if (t < o9) return TileDesc{p.u2, (u16*)(ws + WS_GU2), p.n2, D_, DFF, 2, t - o8};
        return TileDesc{p.d2, (u16*)(ws + WS_DN2), nullptr, DFF, D_, 4, t - o9};
    };
    int t = lo + j;
    if (t < hi) { TileDesc d = desc(t); TileRegs ra; tile_load(ra, d);
        for (;;) { const int tn = t + nidle; const bool more = tn < hi; TileDesc dn = d; TileRegs rb = ra;
            if (more) { dn = desc(tn); tile_load(rb, dn); }
            tile_store(tl, ra, d);
            if (!more) break;
            d = dn; ra = rb; t = tn; } }
}

__device__ __forceinline__ s16x4 vtr(LAS const unsigned char* p) { typedef short v4i16_t __attribute__((ext_vector_type(4))); return __builtin_bit_cast(s16x4, __builtin_amdgcn_ds_read_tr16_b64_v4i16((LAS v4i16_t*)p)); }

__device__ __forceinline__ void pv_tile(f32x4 (&o)[4], LAS const unsigned char* vs, const bf16x8 (&pf)[2], int lane) {
    const int li = lane & 15, g = lane >> 4, q_ = li >> 2, pp = li & 3;
    LAS const unsigned char* b0 = vs + (4 * g + q_) * 144 + pp * 8;
#pragma unroll
    for (int ks = 0; ks < 2; ++ks)
#pragma unroll
        for (int dt = 0; dt < 4; ++dt) {
            s16x4 lo = vtr(b0 + (32 * ks) * 144 + dt * 32), hi = vtr(b0 + (32 * ks + 16) * 144 + dt * 32);
            bf16x8 va = {lo[0], lo[1], lo[2], lo[3], hi[0], hi[1], hi[2], hi[3]};
            o[dt] = __builtin_amdgcn_mfma_f32_16x16x32_bf16(va, pf[ks], o[dt], 0, 0, 0);
        }
}
__device__ __forceinline__ void pack_p(bf16x8 (&pf)[2], const float (&w)[4][4]) {
#pragma unroll
    for (int ks = 0; ks < 2; ++ks) { u32x4 t; t[0] = cvt_pk_bf16(w[2 * ks][0], w[2 * ks][1]); t[1] = cvt_pk_bf16(w[2 * ks][2], w[2 * ks][3]);
        t[2] = cvt_pk_bf16(w[2 * ks + 1][0], w[2 * ks + 1][1]); t[3] = cvt_pk_bf16(w[2 * ks + 1][2], w[2 * ks + 1][3]); pf[ks] = __builtin_bit_cast(bf16x8, t); }
}
__device__ __forceinline__ void load_qf(bf16x8 (&qf)[2], const u16* qrow, int lane) { const int g = lane >> 4; qf[0] = *(const bf16x8*)(qrow + 8 * g); qf[1] = *(const bf16x8*)(qrow + 32 + 8 * g); }

__device__ __forceinline__ int list_off(int n) { return 256 * (63 * n - (n * (n - 1)) / 2); }

struct Top3 { unsigned k1, k2, k3; };
__device__ __forceinline__ unsigned topk_key(float v, int n) { unsigned u = __float_as_uint(v); u = (u & 0x80000000u) ? ~u : (u | 0x80000000u); return (u & ~63u) | (unsigned)(63 - n); }
__device__ __forceinline__ void top3_insert(Top3& t, unsigned k) {
    const unsigned a1 = t.k1 > k ? t.k1 : k, r1 = t.k1 > k ? k : t.k1;
    const unsigned a2 = t.k2 > r1 ? t.k2 : r1, r2 = t.k2 > r1 ? r1 : t.k2;
    t.k1 = a1; t.k2 = a2; t.k3 = t.k3 > r2 ? t.k3 : r2;
}
__device__ __forceinline__ void topk_item(const Params& p, int item, int lane, LAS int* hist  ) {
    const u16* qkva = (const u16*)(p.ws + WS_QKVA); const float* km = (const float*)(p.ws + WS_KMEAN);
    int* cnt = (int*)(p.ws + WS_CNT); u16* list = (u16*)(p.ws + WS_LIST);
    const int h = item & 7, qc = item >> 3, q0 = qc * 64, own = qc >> 2, r = lane & 15, g = lane >> 4;
    if (own == 0) return;
    int sel[4][3];
#pragma unroll
    for (int qt = 0; qt < 4; ++qt) { sel[qt][0] = 0; sel[qt][1] = 1; sel[qt][2] = 2; }
    if (own > 3) {
        Top3 tp[4];
#pragma unroll
        for (int qt = 0; qt < 4; ++qt) { tp[qt].k1 = 0u; tp[qt].k2 = 0u; tp[qt].k3 = 0u; }
        bf16x8 qfr[4][2];
#pragma unroll
        for (int qt = 0; qt < 4; ++qt) load_qf(qfr[qt], qkva + (size_t)(q0 + 16 * qt + r) * LDA_ + h * 64, lane);
        const int ntile = (own + 15) >> 4;
        for (int nt = 0; nt < ntile; ++nt) {
            const int nrow = 16 * nt + r; const bool nv = nrow < own;
            bf16x8 ahi[2], alo[2];
#pragma unroll
            for (int ks = 0; ks < 2; ++ks) { const float* kp = km + (size_t)(nv ? nrow : 0) * 512 + h * 64 + 32 * ks + 8 * g;
                f32x4 a = *(const f32x4*)kp, b = *(const f32x4*)(kp + 4);
                u32x4 hi; hi[0] = cvt_pk_bf16(a[0], a[1]); hi[1] = cvt_pk_bf16(a[2], a[3]); hi[2] = cvt_pk_bf16(b[0], b[1]); hi[3] = cvt_pk_bf16(b[2], b[3]);
                f32x4 ra = {a[0] - bflo(hi[0]), a[1] - bfhi(hi[0]), a[2] - bflo(hi[1]), a[3] - bfhi(hi[1])}, rb = {b[0] - bflo(hi[2]), b[1] - bfhi(hi[2]), b[2] - bflo(hi[3]), b[3] - bfhi(hi[3])};
                u32x4 lo; lo[0] = cvt_pk_bf16(ra[0], ra[1]); lo[1] = cvt_pk_bf16(ra[2], ra[3]); lo[2] = cvt_pk_bf16(rb[0], rb[1]); lo[3] = cvt_pk_bf16(rb[2], rb[3]);
                ahi[ks] = __builtin_bit_cast(bf16x8, hi); alo[ks] = __builtin_bit_cast(bf16x8, lo); }
#pragma unroll
            for (int qt = 0; qt < 4; ++qt) { f32x4 acc = {0.f, 0.f, 0.f, 0.f};
#pragma unroll
                for (int ks = 0; ks < 2; ++ks) { acc = __builtin_amdgcn_mfma_f32_16x16x32_bf16(ahi[ks], qfr[qt][ks], acc, 0, 0, 0); acc = __builtin_amdgcn_mfma_f32_16x16x32_bf16(alo[ks], qfr[qt][ks], acc, 0, 0, 0); }
#pragma unroll
                for (int j = 0; j < 4; ++j) { const int n = 16 * nt + 4 * g + j; top3_insert(tp[qt], n < own ? topk_key(acc[j], n) : 0u); } }
        }
#pragma unroll
        for (int step = 16; step <= 32; step <<= 1)
#pragma unroll
            for (int qt = 0; qt < 4; ++qt) { const unsigned p1 = __shfl_xor(tp[qt].k1, step), p2 = __shfl_xor(tp[qt].k2, step), p3 = __shfl_xor(tp[qt].k3, step);
                top3_insert(tp[qt], p1); top3_insert(tp[qt], p2); top3_insert(tp[qt], p3); }
#pragma unroll
        for (int qt = 0; qt < 4; ++qt) { sel[qt][0] = 63 - (int)(tp[qt].k1 & 63u); sel[qt][1] = 63 - (int)(tp[qt].k2 & 63u); sel[qt][2] = 63 - (int)(tp[qt].k3 & 63u); }
    }
    const int nsel = own < 3 ? own : 3;
    volatile LAS int* vh = (volatile LAS int*)hist;
    vh[lane] = 0;
    __builtin_amdgcn_fence(__ATOMIC_RELEASE, "wavefront"); __builtin_amdgcn_wave_barrier();
    int rank[4][3];
    if (g == 0) {
#pragma unroll
        for (int qt = 0; qt < 4; ++qt)
#pragma unroll
            for (int s2 = 0; s2 < 3; ++s2) { const int n = sel[qt][s2];
                rank[qt][s2] = s2 < nsel ? __hip_atomic_fetch_add(hist + n, 1, __ATOMIC_RELAXED, __HIP_MEMORY_SCOPE_WORKGROUP) : 0; }
    }
    __builtin_amdgcn_fence(__ATOMIC_ACQ_REL, "wavefront"); __builtin_amdgcn_wave_barrier();
    { const int c = vh[lane]; vh[64 + lane] = c > 0 ? atomicAdd(cnt + h * 64 + lane, c) : 0; }
    __builtin_amdgcn_fence(__ATOMIC_ACQ_REL, "wavefront"); __builtin_amdgcn_wave_barrier();
    if (g == 0) {
#pragma unroll
        for (int qt = 0; qt < 4; ++qt) { const int q = q0 + 16 * qt + r;
#pragma unroll
            for (int s2 = 0; s2 < 3; ++s2) if (s2 < nsel) { const int n = sel[qt][s2];
                list[(size_t)h * LISTH + list_off(n) + vh[64 + n] + rank[qt][s2]] = (u16)(q | (s2 << 14)); } }
    }
}

struct CoopKV { u32x4 k, v; };
#define KB_OFF(b) ((b) * 18432)
#define VB_OFF(b) ((b) * 18432 + 9216)
__device__ __forceinline__ void coop_load(CoopKV& c, const u16* kbase, int tid) { const u16* p = kbase + (size_t)(tid >> 3) * LDA_ + 8 * (tid & 7); c.k = *(const u32x4*)p; c.v = *(const u32x4*)(p + 512); }
__device__ __forceinline__ void qk_lds(f32x4 (&acc)[4], LAS const unsigned char* kb, const bf16x8 (&qf)[2], int lane) {
    const int r = lane & 15, g = lane >> 4;
#pragma unroll
    for (int kt = 0; kt < 4; ++kt) { LAS const unsigned char* kp = kb + (16 * kt + r) * 144 + 16 * g;
        bf16x8 k0 = *(LAS const bf16x8*)kp, k1 = *(LAS const bf16x8*)(kp + 64);
        f32x4 z = {0.f, 0.f, 0.f, 0.f};
        z = __builtin_amdgcn_mfma_f32_16x16x32_bf16(k0, qf[0], z, 0, 0, 0);
        acc[kt] = __builtin_amdgcn_mfma_f32_16x16x32_bf16(k1, qf[1], z, 0, 0, 0); }
}
template <bool CAUSAL>
__device__ __forceinline__ void sm_tile_l(LAS const unsigned char* kb, LAS const unsigned char* vb, int key0, int t, const bf16x8 (&qf)[2], float& m, float& l, f32x4 (&o)[4], int lane) {
    const int g = lane >> 4;
    f32x4 acc[4]; qk_lds(acc, kb, qf, lane);
    float s[4][4]; float lm = -INFINITY;
#pragma unroll
    for (int kt = 0; kt < 4; ++kt)
#pragma unroll
        for (int j = 0; j < 4; ++j) { float v = acc[kt][j]; if (CAUSAL && (key0 + 16 * kt + 4 * g + j) > t) v = -INFINITY; s[kt][j] = v; lm = fmaxf(lm, v); }
    lm = fmaxf(lm, __shfl_xor(lm, 16)); lm = fmaxf(lm, __shfl_xor(lm, 32));
    const float mn = fmaxf(m, lm), al = fexp2(m - mn);
    float sum = 0.f;
#pragma unroll
    for (int kt = 0; kt < 4; ++kt)
#pragma unroll
        for (int j = 0; j < 4; ++j) { s[kt][j] = fexp2(s[kt][j] - mn); sum += s[kt][j]; }
    l = l * al + sum; m = mn;
#pragma unroll
    for (int dt = 0; dt < 4; ++dt) o[dt] *= al;
    bf16x8 pf[2]; pack_p(pf, s);
    pv_tile(o, vb, pf, lane);
}

__device__ __forceinline__ void sel_block_stream(const Params& p, LAS unsigned char* lds, LAS const int* sched, int total, int tid, int wid, int lane) {
    const u16* qkva = (const u16*)(p.ws + WS_QKVA); const u16* list = (const u16*)(p.ws + WS_LIST);
    u16* po = (u16*)(p.ws + WS_PO); float* pml = (float*)(p.ws + WS_PML);
    const int r = lane & 15, g = lane >> 4, G = gridDim.x;
    int i = (G & 7) == 0 ? (int)(blockIdx.x & 7) * (G >> 3) + (int)(blockIdx.x >> 3) : (int)blockIdx.x; if (i >= total) return;
#define SELB_DECODE(kk_, H, N, E, OK, ACT) do { const int hn_ = __builtin_amdgcn_readfirstlane(sched[(kk_) * 4]), grp_ = __builtin_amdgcn_readfirstlane(sched[(kk_) * 4 + 1]), c_ = __builtin_amdgcn_readfirstlane(sched[(kk_) * 4 + 2]); \
        H = hn_ >> 6; N = hn_ & 63; const int e0_ = grp_ * 128 + wid * 16; ACT = e0_ < c_; int ei_ = e0_ + r; OK = ei_ < c_; if (!OK) ei_ = ACT ? e0_ : 0; \
        E = list[(size_t)H * LISTH + list_off(N) + ei_]; } while (0)
    int kq = 0; int h, n; unsigned e; bool ok, act; SELB_DECODE(kq, h, n, e, ok, act);
    bf16x8 qf[2]; load_qf(qf, qkva + (size_t)(e & 0x3FFF) * LDA_ + h * 64, lane);
#define KBIG(b_) ((b_) * 73728)
#define VBIG(b_) ((b_) * 73728 + 36864)
    CoopKV cN[4];
    { const u16* kb0 = qkva + (size_t)(n * 256) * LDA_ + 512 + h * 64;
#pragma unroll
      for (int t4 = 0; t4 < 4; ++t4) coop_load(cN[t4], kb0 + (size_t)t4 * 64 * LDA_, tid);
      const int o_ = (tid >> 3) * 144 + (tid & 7) * 16;
#pragma unroll
      for (int t4 = 0; t4 < 4; ++t4) { *(LAS u32x4*)(lds + KBIG(0) + t4 * 9216 + o_) = cN[t4].k; *(LAS u32x4*)(lds + VBIG(0) + t4 * 9216 + o_) = cN[t4].v; } }
    __syncthreads();
    int buf = 0;
    for (;;) {
        const int i2 = i + G; const bool has_next = i2 < total;
        int h2 = 0, n2 = 0; unsigned e2 = 0; bool ok2 = false, act2 = false;
        if (has_next) { SELB_DECODE(kq + 1, h2, n2, e2, ok2, act2);
            const u16* kb2 = qkva + (size_t)(n2 * 256) * LDA_ + 512 + h2 * 64;
#pragma unroll
            for (int t4 = 0; t4 < 4; ++t4) coop_load(cN[t4], kb2 + (size_t)t4 * 64 * LDA_, tid); }
        f32x4 o[4];
#pragma unroll
        for (int q_ = 0; q_ < 4; ++q_) o[q_] = (f32x4){0.f, 0.f, 0.f, 0.f};
        float m = -INFINITY, l = 0.f; bf16x8 qn[2] = {qf[0], qf[1]};
        if (has_next) load_qf(qn, qkva + (size_t)(e2 & 0x3FFF) * LDA_ + h2 * 64, lane);
        if (act) {
#pragma unroll 1
            for (int tile = 0; tile < 4; ++tile) sm_tile_l<false>(lds + KBIG(buf) + tile * 9216, lds + VBIG(buf) + tile * 9216, 0, 0, qf, m, l, o, lane);
            l += __shfl_xor(l, 16); l += __shfl_xor(l, 32);
            const float inv = frcp(l);
            if (ok) { const size_t sidx = ((size_t)(e & 0x3FFF) * NH + h) * 3 + (e >> 14);
#pragma unroll
                for (int dt = 0; dt < 4; ++dt) { u32x2 b; b[0] = cvt_pk_bf16(o[dt][0] * inv, o[dt][1] * inv); b[1] = cvt_pk_bf16(o[dt][2] * inv, o[dt][3] * inv);
                    *(u32x2*)(po + sidx * 64 + 16 * dt + 4 * g) = b; }
                if (g == 0) { pml[sidx * 2] = m; pml[sidx * 2 + 1] = l; } } }
        if (!has_next) break;
        { const int o_ = (tid >> 3) * 144 + (tid & 7) * 16;
#pragma unroll
          for (int t4 = 0; t4 < 4; ++t4) { *(LAS u32x4*)(lds + KBIG(buf ^ 1) + t4 * 9216 + o_) = cN[t4].k; *(LAS u32x4*)(lds + VBIG(buf ^ 1) + t4 * 9216 + o_) = cN[t4].v; } }
        __syncthreads(); buf ^= 1;
        i = i2; ++kq; h = h2; n = n2; e = e2; ok = ok2; act = act2; qf[0] = qn[0]; qf[1] = qn[1];
    }
#undef KBIG
#undef VBIG
#undef SELB_DECODE
}

__device__ __forceinline__ void own_block_stream(const Params& p, LAS unsigned char* lds, int tid, int wid, int lane) {
    const u16* qkva = (const u16*)(p.ws + WS_QKVA); const u16* po = (const u16*)(p.ws + WS_PO); const float* pml = (const float*)(p.ws + WS_PML);
    u16* ya = (u16*)(p.ws + WS_AB);
    const int r = lane & 15, g = lane >> 4, G = gridDim.x, total = (T_ / 128) * NH;
    int i = (G & 7) == 0 ? (int)(blockIdx.x & 7) * (G >> 3) + (int)(blockIdx.x >> 3) : (int)blockIdx.x, kk = 0; if (i >= total) return;
#define OWN_DEC(ii, k_, C, H) do { C = ((ii) >> 3) ^ ((k_) & 1); H = (ii) & 7; } while (0)
    int cch, h; OWN_DEC(i, kk, cch, h);
    bf16x8 qf[2]; load_qf(qf, qkva + (size_t)(cch * 128 + wid * 16 + r) * LDA_ + h * 64, lane);
#define KBIG(b_) ((b_) * 73728)
#define VBIG(b_) ((b_) * 73728 + 36864)
    CoopKV cN[4]; const int o_ = (tid >> 3) * 144 + (tid & 7) * 16;
    { const u16* kb0 = qkva + (size_t)((cch >> 1) * 256) * LDA_ + 512 + h * 64; const int nt0 = (cch & 1) ? 4 : 2;
#pragma unroll
      for (int t4 = 0; t4 < 4; ++t4) if (t4 < nt0) coop_load(cN[t4], kb0 + (size_t)t4 * 64 * LDA_, tid);
#pragma unroll
      for (int t4 = 0; t4 < 4; ++t4) if (t4 < nt0) { *(LAS u32x4*)(lds + KBIG(0) + t4 * 9216 + o_) = cN[t4].k; *(LAS u32x4*)(lds + VBIG(0) + t4 * 9216 + o_) = cN[t4].v; } }
    __syncthreads();
    int buf = 0;
    for (;;) {
        const int i2 = i + G; const bool has_next = i2 < total; int c2 = 0, h2 = 0; OWN_DEC(i2, kk + 1, c2, h2);
        const int own = cch >> 1, q0 = cch * 128 + wid * 16, t = q0 + r, wmax = ((cch & 1) * 128 + wid * 16 + 15) >> 6;
        const int nt2 = (c2 & 1) ? 4 : 2;
        f32x4 o[4];
#pragma unroll
        for (int q_ = 0; q_ < 4; ++q_) o[q_] = (f32x4){0.f, 0.f, 0.f, 0.f};
        float m = -INFINITY, l = 0.f; bf16x8 qn[2] = {qf[0], qf[1]};
        if (has_next) { const u16* kb2 = qkva + (size_t)((c2 >> 1) * 256) * LDA_ + 512 + h2 * 64;
#pragma unroll
            for (int t4 = 0; t4 < 4; ++t4) if (t4 < nt2) coop_load(cN[t4], kb2 + (size_t)t4 * 64 * LDA_, tid);
            load_qf(qn, qkva + (size_t)(c2 * 128 + wid * 16 + r) * LDA_ + h2 * 64, lane); }
        const int nsel = own < 3 ? own : 3;
        const size_t sidx = ((size_t)t * NH + h) * 3;
        float ms[3], lsv[3]; u32x2 pw[3][4];
#pragma unroll
        for (int s2 = 0; s2 < 3; ++s2) { ms[s2] = -INFINITY; lsv[s2] = 0.f;
#pragma unroll
            for (int dt = 0; dt < 4; ++dt) pw[s2][dt] = (u32x2){0u, 0u};
            if (s2 < nsel) { ms[s2] = pml[(sidx + s2) * 2]; lsv[s2] = pml[(sidx + s2) * 2 + 1];
#pragma unroll
                for (int dt = 0; dt < 4; ++dt) pw[s2][dt] = *(const u32x2*)(po + (sidx + s2) * 64 + 16 * dt + 4 * g); } }
#pragma unroll 1
        for (int tile = 0; tile <= wmax; ++tile) sm_tile_l<true>(lds + KBIG(buf) + tile * 9216, lds + VBIG(buf) + tile * 9216, own * 256 + tile * 64, t, qf, m, l, o, lane);
        l += __shfl_xor(l, 16); l += __shfl_xor(l, 32);
        float M = m;
#pragma unroll
        for (int s2 = 0; s2 < 3; ++s2) M = fmaxf(M, ms[s2]);
        const float a0 = fexp2(m - M); float den = l * a0;
#pragma unroll
        for (int dt = 0; dt < 4; ++dt) o[dt] *= a0;
#pragma unroll
        for (int s2 = 0; s2 < 3; ++s2) { const float a = lsv[s2] * fexp2(ms[s2] - M); den += a;
#pragma unroll
            for (int dt = 0; dt < 4; ++dt) { const u32x2 w = pw[s2][dt];
                o[dt][0] += a * bflo(w[0]); o[dt][1] += a * bfhi(w[0]); o[dt][2] += a * bflo(w[1]); o[dt][3] += a * bfhi(w[1]); } }
        const float inv = frcp(den);
#pragma unroll
        for (int dt = 0; dt < 4; ++dt) { u32x2 b; b[0] = cvt_pk_bf16(o[dt][0] * inv, o[dt][1] * inv); b[1] = cvt_pk_bf16(o[dt][2] * inv, o[dt][3] * inv);
            *(u32x2*)(ya + (size_t)t * 512 + h * 64 + 16 * dt + 4 * g) = b; }
        if (!has_next) break;
#pragma unroll
        for (int t4 = 0; t4 < 4; ++t4) if (t4 < nt2) { *(LAS u32x4*)(lds + KBIG(buf ^ 1) + t4 * 9216 + o_) = cN[t4].k; *(LAS u32x4*)(lds + VBIG(buf ^ 1) + t4 * 9216 + o_) = cN[t4].v; }
        __syncthreads(); buf ^= 1;
        i = i2; ++kk; cch = c2; h = h2; qf[0] = qn[0]; qf[1] = qn[1];
    }
#undef KBIG
#undef VBIG
#undef OWN_DEC
}

__device__ __forceinline__ void sb_tile_l(LAS const unsigned char* kb, LAS const unsigned char* vb, int key0, int t, const bf16x8 (&qf)[2], float& R, f32x4 (&o)[4], int lane) {
    const int g = lane >> 4;
    f32x4 acc[4]; qk_lds(acc, kb, qf, lane);
    float lf[4][4], Tk[4], ex[4];
#pragma unroll
    for (int kt = 0; kt < 4; ++kt) { float c = 0.f;
#pragma unroll
        for (int j = 0; j < 4; ++j) { const bool valid = (key0 + 16 * kt + 4 * g + j) < t; const float z = acc[kt][j];
            const float sp = fmaxf(z, 0.f) + __builtin_amdgcn_logf(1.0f + fexp2(-fabsf(z)));
            acc[kt][j] = z; lf[kt][j] = valid ? -sp : 0.f; c += lf[kt][j]; }
        const float b = __shfl_xor(c, 16), s2 = c + b, d = __shfl_xor(s2, 32);
        Tk[kt] = s2 + d; ex[kt] = ((g & 1) ? 0.f : b) + ((g & 2) ? 0.f : d); }
    float w[4][4]; float run = R;
#pragma unroll
    for (int kt = 3; kt >= 0; --kt) { const float E = run + ex[kt]; float suf = 0.f;
#pragma unroll
        for (int j = 3; j >= 0; --j) { const bool valid = (key0 + 16 * kt + 4 * g + j) < t; w[kt][j] = valid ? fexp2(acc[kt][j] + lf[kt][j] + E + suf) : 0.f; suf += lf[kt][j]; }
        run += Tk[kt]; }
    R = run;
    bf16x8 pf[2]; pack_p(pf, w);
    pv_tile(o, vb, pf, lane);
}

__device__ __forceinline__ void sb_block_stream(const Params& p, LAS unsigned char* lds, int tid, int wid, int lane) {
    const u16* qkvb = (const u16*)(p.ws + WS_QKVB); u16* yb = (u16*)(p.ws + WS_AB) + (size_t)T_ * 512;
    const int r = lane & 15, g = lane >> 4, G = gridDim.x, total = (T_ / 128) * NH;
    int i = (G & 7) == 0 ? (int)(blockIdx.x & 7) * (G >> 3) + (int)(blockIdx.x >> 3) : (int)blockIdx.x; if (i >= total) return;
    int cch = i >> 3, h = i & 7;
    bf16x8 qf[2]; load_qf(qf, qkvb + (size_t)(cch * 128 + wid * 16 + r) * LDA_ + h * 64, lane);
#define KBIG(b_) ((b_) * 73728)
#define VBIG(b_) ((b_) * 73728 + 36864)
    CoopKV cN[3]; const int o_ = (tid >> 3) * 144 + (tid & 7) * 16;
    { const int ns0 = cch == 0 ? 2 : 3;
#pragma unroll
      for (int s4 = 0; s4 < 3; ++s4) if (s4 < ns0) coop_load(cN[s4], qkvb + (size_t)((2 * cch + 1 - s4) * 64) * LDA_ + 512 + h * 64, tid);
#pragma unroll
      for (int s4 = 0; s4 < 3; ++s4) if (s4 < ns0) { *(LAS u32x4*)(lds + KBIG(0) + s4 * 9216 + o_) = cN[s4].k; *(LAS u32x4*)(lds + VBIG(0) + s4 * 9216 + o_) = cN[s4].v; } }
    __syncthreads();
    int buf = 0;
    for (;;) {
        const int i2 = i + G; const bool has_next = i2 < total; const int c2 = i2 >> 3, h2 = i2 & 7;
        const int q0 = cch * 128 + wid * 16, t = q0 + r, dw = 2 * cch + (wid >> 2);
        const int nstep = cch == 0 ? 2 : 3, ns2 = c2 == 0 ? 2 : 3;
        const u16* kb = qkvb + 512 + h * 64;
        f32x4 o[4];
#pragma unroll
        for (int q_ = 0; q_ < 4; ++q_) o[q_] = (f32x4){0.f, 0.f, 0.f, 0.f};
        float R = 0.f; bool done = false; bf16x8 qn[2] = {qf[0], qf[1]};
        if (has_next) {
#pragma unroll
            for (int s4 = 0; s4 < 3; ++s4) if (s4 < ns2) coop_load(cN[s4], qkvb + (size_t)((2 * c2 + 1 - s4) * 64) * LDA_ + 512 + h2 * 64, tid);
            load_qf(qn, qkvb + (size_t)(c2 * 128 + wid * 16 + r) * LDA_ + h2 * 64, lane); }
        int tile = 2 * cch + 1;
#pragma unroll 1
        for (int s4 = 0; s4 < nstep; ++s4, --tile)
            if (tile <= dw && !done) { sb_tile_l(lds + KBIG(buf) + s4 * 9216, lds + VBIG(buf) + s4 * 9216, tile * 64, t, qf, R, o, lane);
                done = (tile == 0) || (__builtin_amdgcn_ballot_w64(R > -57.7f) == 0ull); }
        if (has_next) {
#pragma unroll
            for (int s4 = 0; s4 < 3; ++s4) if (s4 < ns2) { *(LAS u32x4*)(lds + KBIG(buf ^ 1) + s4 * 9216 + o_) = cN[s4].k; *(LAS u32x4*)(lds + VBIG(buf ^ 1) + s4 * 9216 + o_) = cN[s4].v; } }
        int any = __syncthreads_or(done ? 0 : 1);
        while (any && tile >= 0) {
            CoopKV c3; coop_load(c3, kb + (size_t)(tile * 64) * LDA_, tid);
            *(LAS u32x4*)(lds + KBIG(buf) + o_) = c3.k; *(LAS u32x4*)(lds + VBIG(buf) + o_) = c3.v; __syncthreads();
            if (!done) { sb_tile_l(lds + KBIG(buf), lds + VBIG(buf), tile * 64, t, qf, R, o, lane);
                done = (tile == 0) || (__builtin_amdgcn_ballot_w64(R > -57.7f) == 0ull); }
            any = __syncthreads_or(done ? 0 : 1); --tile;
        }
#pragma unroll
        for (int dt = 0; dt < 4; ++dt) { u32x2 b; b[0] = cvt_pk_bf16(o[dt][0], o[dt][1]); b[1] = cvt_pk_bf16(o[dt][2], o[dt][3]);
            *(u32x2*)(yb + (size_t)t * 512 + h * 64 + 16 * dt + 4 * g) = b; }
        if (!has_next) break;
        buf ^= 1;
        i = i2; cch = c2; h = h2; qf[0] = qn[0]; qf[1] = qn[1];
    }
#undef KBIG
#undef VBIG
}

#define XB_TMO      128
#define XB_XCNT(j)  (256  + 64 * (j))
#define XB_XSUB(j)  (1280 + 64 * (j))
#define XB_XGEN(j)  (2304 + 64 * (j))
#define XB_TOP      3328
#define XB_TOPGEN   3392
#define XCD_BAR_WORDS 3456
#define XB_SPIN_CAP (1u << 22)
__device__ __forceinline__ unsigned xb_ld(unsigned* p)              { return __hip_atomic_load(p, __ATOMIC_RELAXED, __HIP_MEMORY_SCOPE_AGENT); }
__device__ __forceinline__ unsigned xb_add(unsigned* p, unsigned v) { return __hip_atomic_fetch_add(p, v, __ATOMIC_RELAXED, __HIP_MEMORY_SCOPE_AGENT); }
__device__ __forceinline__ unsigned xb_xcc_id() { return (unsigned)__builtin_amdgcn_s_getreg((3 << 11) | 20) & 0xFu; }
#define XB_SPIN(cond, bar) do { unsigned _sp = 0; while (cond) { __builtin_amdgcn_s_sleep(1); \
    if ((++_sp & 255u) == 0u) { if (xb_ld(&(bar)[XB_TMO])) break; if (_sp > XB_SPIN_CAP) { atomicAdd(&(bar)[XB_TMO], 1u); break; } } } } while (0)
struct XcdBarrier { unsigned* bar; unsigned x; volatile LAS unsigned* st; };
__device__ __forceinline__ XcdBarrier xcd_barrier_post(unsigned* bar, volatile LAS unsigned* st) {
    XcdBarrier b; b.bar = bar; b.x = xb_xcc_id(); b.st = st;
    if (threadIdx.x == 0) (void)xb_add(&bar[XB_XCNT(b.x)], 1u);
    return b;
}
__device__ __forceinline__ void xcd_barrier_complete(unsigned* bar, unsigned x, unsigned& nloc, unsigned& nx) {
    const unsigned G = gridDim.x * gridDim.y * gridDim.z;
    unsigned sum, cnt, mine, sp = 0u;
    for (;;) {
        sum = 0u; cnt = 0u; mine = 0u;
#pragma unroll
        for (unsigned j = 0; j < 16; ++j) { const unsigned c = xb_ld(&bar[XB_XCNT(j)]); sum += c; cnt += (c > 0u) ? 1u : 0u; mine = (j == x) ? c : mine; }
        if (sum == G) break;
        __builtin_amdgcn_s_sleep(1);
        if ((++sp & 255u) == 0u) { if (xb_ld(&bar[XB_TMO])) break; if (sp > XB_SPIN_CAP) { atomicAdd(&bar[XB_TMO], 1u); break; } }
    }
    nloc = mine > 0u ? mine : 1u; nx = cnt > 0u ? cnt : 1u;
}
__device__ __forceinline__ void xcd_barrier_arrive(const XcdBarrier& b) {
    asm volatile("s_waitcnt vmcnt(0)" ::: "memory");
    __syncthreads();
    if (threadIdx.x == 0) {
        unsigned* bar = b.bar;
        __builtin_amdgcn_s_waitcnt(0);
        unsigned nloc = b.st[0], nx = b.st[1];
        if (nloc == 0u) { xcd_barrier_complete(bar, b.x, nloc, nx); b.st[0] = nloc; b.st[1] = nx; }
        const unsigned old = xb_add(&bar[XB_XSUB(b.x)], 1u);
        const unsigned gen = old / nloc;
        if (old + 1u == (gen + 1u) * nloc) {
            __builtin_amdgcn_fence(__ATOMIC_RELEASE, "agent");
            asm volatile("s_waitcnt vmcnt(0)" ::: "memory");
            const unsigned og = xb_add(&bar[XB_TOP], 1u);
            const unsigned tg = og / nx;
            if (og + 1u == (tg + 1u) * nx) xb_add(&bar[XB_TOPGEN], 1u);
        }
    }
}
__device__ __forceinline__ void xcd_barrier_wait(const XcdBarrier& b) {
    if (threadIdx.x == 0) {
        unsigned* bar = b.bar;
        const unsigned tgen = b.st[2]; b.st[2] = tgen + 1u;
        XB_SPIN(xb_ld(&bar[XB_TOPGEN]) <= tgen, bar);
        __builtin_amdgcn_fence(__ATOMIC_ACQUIRE, "agent");
        asm volatile("s_waitcnt vmcnt(0)" ::: "memory");
    }
    __syncthreads();
}
__device__ __forceinline__ void xcd_barrier(const XcdBarrier& b) { xcd_barrier_arrive(b); xcd_barrier_wait(b); }

#define PH_PROLOG int tid_ = threadIdx.x; asm volatile("" : "+v"(tid_)); const int tid = tid_, lane = tid & 63, wid = __builtin_amdgcn_readfirstlane(tid >> 6); \
    const int G = gridDim.x, W = blockIdx.x * 8 + wid, NW = G * 8; LAS unsigned char* vs = lds + wid * 9216; (void)vs; (void)W; (void)NW; (void)lane; (void)G;
#ifndef REP_MASK
#define REP_MASK 0
#endif
#ifndef REPN
#define REPN 2
#endif
#ifndef EXTRA_SYNCS
#define EXTRA_SYNCS 0
#endif
#define PHASE(N, ...) if constexpr ((PH_MASK >> N) & 1) { if (p.ph_lo <= N && N < p.ph_hi) { \
    for (int rep_ = 0; rep_ < (((REP_MASK >> N) & 1) ? REPN : 1); ++rep_) { if (rep_) xcd_barrier(xb); { PH_PROLOG __VA_ARGS__ } } } } if (p.ph_lo <= N && N + 1 < p.ph_hi) xcd_barrier(xb);
#define PHASE_S(N, SLOT, ...) if constexpr ((PH_MASK >> N) & 1) { if (p.ph_lo <= N && N < p.ph_hi) { { PH_PROLOG __VA_ARGS__ } } } \
    if (p.ph_lo <= N && N + 1 < p.ph_hi) { xcd_barrier_arrive(xb); \
        { constexpr int lo_ = 2 * 16 * 44 + 44 * 16 + 16 * 80 + 2 * 8 * 16 + 16 * 16 + (SLOT) * 512, end_ = 2 * 16 * 44 + 44 * 16 + 16 * 80 + 2 * 8 * 16 + 16 * 16 + 2 * 16 * 44 + 44 * 16; \
          if ((int)gridDim.x == 256) deferred_weights(p, lds, (int)blockIdx.x, 256, lo_, (lo_ + 512 < end_ ? lo_ + 512 : end_)); } \
        xcd_barrier_wait(xb); }

__global__ void __launch_bounds__(512) fwd_megakernel(Params p) {
    extern __shared__ __attribute__((aligned(16))) unsigned char shm_raw[];
    LAS unsigned char* lds = (LAS unsigned char*)shm_raw;
    cg::grid_group grid = cg::this_grid();
    unsigned char* ws = p.ws;
    volatile LAS unsigned* xst = (volatile LAS unsigned*)(lds + XST_OFF);
    if (threadIdx.x == 0) { xst[0] = 0u; xst[1] = 0u; xst[2] = 0u; }
    __syncthreads();
    XcdBarrier xb = xcd_barrier_post(g_sync, xst);
    if (p.use_cg) grid.sync();

    for (int es_ = 0; es_ < EXTRA_SYNCS; ++es_) xcd_barrier(xb);
    PHASE(0, prep_phase(p, lds);)
    PHASE(1, pg8::StaticOrder S; S.init(T_, 2 * DFF, G, blockIdx.x); pg8::Gemm g{(const u16*)(ws + WS_AB), (const u16*)(ws + WS_GU1), T_, 2 * DFF, D_};
             build_rtab(lds, S, (const float*)(ws + WS_P0)); EpiSwiglu E{(u16*)(ws + WS_ACT), lds}; pg8::gemm_phase(lds, g, S, E);
             { const int nfull = (T_ / 256) * (2 * DFF / 256) - 5 * G;
               constexpr int lo_ = 2 * 16 * 44, hi_ = lo_ + 44 * 16 + 16 * 80 + 2 * 8 * 16 + 16 * 16;
               if (nfull >= 0 && nfull < G) { if ((int)blockIdx.x >= nfull) deferred_weights(p, lds, (int)blockIdx.x - nfull, G - nfull, lo_, hi_); }
               else deferred_weights(p, lds, (int)blockIdx.x, G, lo_, hi_); })
    PHASE_S(2, 0, pg8::StaticOrder S; S.init(T_, D_, G, blockIdx.x); pg8::Gemm g{(const u16*)(ws + WS_ACT), (const u16*)(ws + WS_DN1), T_, D_, DFF};
             EpiResid<false> E{(const u16*)(ws + WS_AB), nullptr, (u16*)p.out, (float*)(ws + WS_P1), 0.5f}; pg8::gemm_phase(lds, g, S, E);)
    PHASE_S(3, 1, pg8::StaticOrder S; S.init(T_, DIN, G, blockIdx.x); pg8::Gemm g{(const u16*)p.out, (const u16*)(ws + WS_IN), T_, DIN, D_};
             build_rtab(lds, S, (const float*)(ws + WS_P1)); EpiWin E{(u16*)(ws + WS_QKVA), (u16*)(ws + WS_QKVB), (u16*)(ws + WS_GATES), lds, (const float*)(ws + WS_CS), p.bg, (float*)(ws + WS_KMEAN)}; pg8::gemm_phase(lds, g, S, E);)
    PHASE_S(4, 2, for (int i = W; i < (T_ / 64) * NH; i += NW) topk_item(p, i, lane, (LAS int*)(lds + wid * 512));
             __syncthreads(); sb_block_stream(p, lds, tid, wid, lane); __syncthreads();)
    PHASE_S(6, 3, LAS int* pref = (LAS int*)(lds + 96 * 1024); const int* cnt = (const int*)(ws + WS_CNT);
             __syncthreads();
             pref[tid] = (cnt[tid] + 127) >> 7; __syncthreads();
             for (int o = 1; o < 512; o <<= 1) { const int v = tid >= o ? pref[tid - o] : 0; __syncthreads(); pref[tid] += v; __syncthreads(); }
             const int total = pref[511];
             LAS int* sched = (LAS int*)(lds + 148 * 1024);
             { const int slot0 = (G & 7) == 0 ? (int)(blockIdx.x & 7) * (G >> 3) + (int)(blockIdx.x >> 3) : (int)blockIdx.x; const int ii = slot0 + tid * G;
               if (tid < 64 && ii < total) { int lo = 0; int hi = 511; while (lo < hi) { const int mid = (lo + hi) >> 1; if (pref[mid] > ii) hi = mid; else lo = mid + 1; }
                   sched[tid * 4] = lo; sched[tid * 4 + 1] = ii - (lo ? pref[lo - 1] : 0); sched[tid * 4 + 2] = cnt[lo]; } }
             __syncthreads();
             sel_block_stream(p, lds, sched, total, tid, wid, lane);
             __syncthreads();)
    PHASE_S(7, 4, __syncthreads(); own_block_stream(p, lds, tid, wid, lane); __syncthreads();)
    PHASE(8, { pg8::StaticOrder S; S.init(T_, D_, G, blockIdx.x); pg8::Gemm g{(const u16*)(ws + WS_AB), (const u16*)(ws + WS_BA), T_, D_, 512};
               EpiBranch<true> E{(const u16*)(ws + WS_GATES), (u16*)(ws + WS_TMP), (u16*)(ws + WS_MERGED)}; pg8::gemm_phase(lds, g, S, E); }
             { pg8::StaticOrder S; S.init(T_, D_, G, blockIdx.x); pg8::Gemm g{(const u16*)(ws + WS_AB) + (size_t)T_ * 512, (const u16*)(ws + WS_BB), T_, D_, 512};
               EpiBranch<false> E{(const u16*)(ws + WS_GATES), (u16*)(ws + WS_TMP), (u16*)(ws + WS_MERGED)}; pg8::gemm_phase(lds, g, S, E); })
    PHASE(9, pg8::StaticOrder S; S.init(T_, D_, G, blockIdx.x); pg8::Gemm g{(const u16*)(ws + WS_MERGED), (const u16*)(ws + WS_WO), T_, D_, D_};
             EpiResid<false> E{(const u16*)p.out, nullptr, (u16*)(ws + WS_AB), (float*)(ws + WS_P2), 1.0f}; pg8::gemm_phase(lds, g, S, E);)
    PHASE(10, pg8::StaticOrder S; S.init(T_, 2 * DFF, G, blockIdx.x); pg8::Gemm g{(const u16*)(ws + WS_AB), (const u16*)(ws + WS_GU2), T_, 2 * DFF, D_};
              build_rtab(lds, S, (const float*)(ws + WS_P2)); EpiSwiglu E{(u16*)(ws + WS_ACT), lds}; pg8::gemm_phase(lds, g, S, E);)
    PHASE(11, pg8::StaticOrder S; S.init(T_, D_, G, blockIdx.x); pg8::Gemm g{(const u16*)(ws + WS_ACT), (const u16*)(ws + WS_DN2), T_, D_, DFF};
              EpiFinal E{(const u16*)(ws + WS_AB), p.out, (float*)(ws + WS_P3), g_sync + 4096, p.nf, 0.5f}; pg8::gemm_phase(lds, g, S, E);)
    asm volatile("s_waitcnt vmcnt(0)" ::: "memory");
    __syncthreads();
    if (threadIdx.x == 0) xst[3] = (__hip_atomic_fetch_add(&g_sync[8192], 1u, __ATOMIC_RELAXED, __HIP_MEMORY_SCOPE_AGENT) == gridDim.x - 1u) ? 1u : 0u;
    __syncthreads();
    if (xst[3]) { for (int i2 = threadIdx.x; i2 < 8192; i2 += 512) g_sync[i2] = 0u; if (threadIdx.x == 0) g_sync[8192] = 0u; }
}

extern "C" void kernel_launch(void* const* d_in, const int* in_sizes, int n_in, void* d_out, int out_size, void* d_ws, size_t ws_size, hipStream_t stream) {
    constexpr int LDS_BYTES = 152 * 1024 + 64 + 7 * 1024;
    static int grid = 0;
    if (grid == 0) {
        int dev = 0, cus = 0, per_cu = 0;
        hipGetDevice(&dev); hipDeviceGetAttribute(&cus, hipDeviceAttributeMultiprocessorCount, dev);
        hipFuncSetAttribute((const void*)fwd_megakernel, hipFuncAttributeMaxDynamicSharedMemorySize, LDS_BYTES);
        hipOccupancyMaxActiveBlocksPerMultiprocessor(&per_cu, (const void*)fwd_megakernel, 512, LDS_BYTES);
        if (per_cu < 1) { fprintf(stderr, "occupancy query says %d blocks/CU\n", per_cu); per_cu = 1; }
        (void)hipGetLastError();
        grid = cus;
        if (ws_size < WS_END) { fprintf(stderr, "workspace too small: %zu < %zu\n", ws_size, (size_t)WS_END); grid = -1; }
    }
    if (grid < 0) return;
    Params p{};
    p.x = (const float*)d_in[0]; p.pos = (const int*)d_in[1];
    p.n1 = (const float*)d_in[2]; p.g1 = (const float*)d_in[3]; p.u1 = (const float*)d_in[4]; p.d1 = (const float*)d_in[5];
    p.nm = (const float*)d_in[6]; p.win = (const float*)d_in[7]; p.bg = (const float*)d_in[8]; p.wba = (const float*)d_in[9]; p.wbb = (const float*)d_in[10]; p.wo = (const float*)d_in[11];
    p.n2 = (const float*)d_in[12]; p.g2 = (const float*)d_in[13]; p.u2 = (const float*)d_in[14]; p.d2 = (const float*)d_in[15]; p.nf = (const float*)d_in[16];
    p.out = (float*)d_out; p.ws = (unsigned char*)d_ws;
#ifndef ONE_LAUNCH
#define ONE_LAUNCH 1
#endif
#if ONE_LAUNCH
    p.ph_lo = 0; p.ph_hi = N_PHASES;
    void* args[] = {&p};
    hipError_t e = hipLaunchCooperativeKernel((const void*)fwd_megakernel, dim3(grid), dim3(512), args, LDS_BYTES, stream);
    if (e != hipSuccess) fprintf(stderr, "cooperative launch failed: %s (grid %d)\n", hipGetErrorString(e), grid);
#else
#ifndef DBG_MASK
#define DBG_MASK 0x1fff
#endif
#ifndef DBG_FPART
#define DBG_FPART 0
#endif
    p.fpart = DBG_FPART;
    for (int ph = 0; ph < N_PHASES; ++ph) { if (!((DBG_MASK >> ph) & 1)) continue; p.ph_lo = ph; p.ph_hi = ph + 1; hipLaunchKernelGGL(fwd_megakernel, dim3(grid), dim3(512), LDS_BYTES, stream, p); }
#endif
}
```

```cpp
#include <hip/hip_runtime.h>
#include <hip/hip_cooperative_groups.h>
#include <cstdio>
namespace cg = cooperative_groups;

#define LAS __attribute__((address_space(3)))
typedef unsigned short u16;
typedef short bf16x8 __attribute__((ext_vector_type(8)));
typedef short s16x4 __attribute__((ext_vector_type(4)));
typedef float f32x4 __attribute__((ext_vector_type(4)));
typedef unsigned u32x4 __attribute__((ext_vector_type(4)));
typedef unsigned u32x2 __attribute__((ext_vector_type(2)));

constexpr int T_ = 16384, D_ = 1024, DFF = 2816, DIN = 5120, NH = 8, HD = 64;
constexpr int LDA_ = 1536;
constexpr float EPS = 1e-6f;
constexpr int LISTH = 256 * 2016;
constexpr int N_PHASES = 12;
#ifndef PH_MASK
#define PH_MASK 0x1fff
#endif

constexpr size_t SZ_GU = (size_t)2 * DFF * D_ * 2, SZ_DN = (size_t)D_ * DFF * 2, SZ_IN = (size_t)DIN * D_ * 2, SZ_BR = (size_t)D_ * 512 * 2, SZ_WO = (size_t)D_ * D_ * 2;
constexpr size_t WS_GU1 = 0, WS_DN1 = WS_GU1 + SZ_GU, WS_IN = WS_DN1 + SZ_DN, WS_BA = WS_IN + SZ_IN, WS_BB = WS_BA + SZ_BR, WS_WO = WS_BB + SZ_BR,
                 WS_GU2 = WS_WO + SZ_WO, WS_DN2 = WS_GU2 + SZ_GU, WS_CS = WS_DN2 + SZ_DN;
constexpr size_t SZ_PART = (size_t)T_ * 16 * 4;
constexpr size_t WS_P0 = WS_CS + (size_t)T_ * 16 * 4, WS_P1 = WS_P0 + SZ_PART, WS_P2 = WS_P1 + SZ_PART, WS_P3 = WS_P2 + SZ_PART;
constexpr size_t WS_KMEAN = WS_P3 + SZ_PART, WS_CNT = WS_KMEAN + (size_t)64 * 2 * 512 * 4, WS_BAR = WS_CNT + 4096, WS_PML = WS_BAR + 32768;
constexpr size_t WS_LIST = WS_PML + (size_t)T_ * NH * 3 * 2 * 4;
constexpr size_t WS_AB = WS_LIST + (size_t)NH * LISTH * 2;
constexpr size_t WS_BIG = WS_AB + (size_t)T_ * D_ * 2;
constexpr size_t SZ_QKV = (size_t)T_ * LDA_ * 2;
constexpr size_t WS_GATES = WS_BIG, WS_QKVA = WS_GATES + (size_t)T_ * 2048 * 2, WS_QKVB = WS_QKVA + SZ_QKV, WS_END = WS_QKVB + SZ_QKV;
constexpr size_t WS_ACT = WS_BIG, WS_TMP = WS_QKVA, WS_MERGED = WS_TMP + (size_t)T_ * D_ * 4, WS_PO = WS_QKVB;
static_assert(WS_END <= (size_t)256 * 1024 * 1024, "workspace");
static_assert(WS_AB % 256 == 0 && WS_BIG % 256 == 0 && WS_LIST % 16 == 0, "align");

__device__ unsigned g_sync[8192 + 64];

struct Params {
    const float* x; const int* pos;
    const float *n1, *g1, *u1, *d1, *nm, *win, *bg, *wba, *wbb, *wo, *n2, *g2, *u2, *d2, *nf;
    float* out; unsigned char* ws;
    int ph_lo, ph_hi, fpart, use_cg;
};

typedef __bf16 bf16x2_t __attribute__((ext_vector_type(2)));
typedef float f32x2_t __attribute__((ext_vector_type(2)));
__device__ __forceinline__ unsigned cvt_pk_bf16(float lo, float hi) { f32x2_t v = {lo, hi}; bf16x2_t b = __builtin_convertvector(v, bf16x2_t); return __builtin_bit_cast(unsigned, b); }
__device__ __forceinline__ float bf2f(u16 b) { return __uint_as_float(((unsigned)b) << 16); }
__device__ __forceinline__ float bflo(unsigned w) { return __uint_as_float(w << 16); }
__device__ __forceinline__ float bfhi(unsigned w) { return __uint_as_float(w & 0xffff0000u); }
__device__ __forceinline__ float fexp2(float x) { return __builtin_amdgcn_exp2f(x); }
__device__ __forceinline__ float frcp(float x) { return __builtin_amdgcn_rcpf(x); }

namespace pg8 {
constexpr int BM = 256, BK = 64, HALF = 128, HTB = HALF * BK * 2, STAGE_BYTES = 8 * HTB, NXCD = 8, WGM = 8;
__host__ __device__ __forceinline__ int lds_byte(int r, int c) { const int st = (r >> 4) * 2 + (c >> 5), rr = r & 15, cc = c & 31, ob = rr * 64 + cc * 2; return st * 1024 + (ob ^ (((ob >> 9) & 1) << 5)); }
__host__ __device__ __forceinline__ void stage_rc(int b, int& R, int& C) { const int st = b / 1024, sb = b % 1024, swz = sb ^ (((sb >> 9) & 1) << 5); R = (st >> 1) * 16 + swz / 64; C = (st & 1) * 32 + (swz % 64) / 2; }
struct Unit { int pm, pn; };
struct Gemm { const u16* A; const u16* Bt; int M, N, K; };
struct StaticOrder {
    int nM, nN, nwg, G, c;
    __host__ __device__ void init(int M, int N, int G_, int c_) { nM = M / BM; nN = N / BM; nwg = nM * nN; G = G_; c = c_; }
    __host__ __device__ bool next(int i, Unit& u) const {
        const long L = (long)i * G + c; if (L >= nwg) return false;
        int wgid = (int)L; { const int q = nwg / NXCD, r = nwg % NXCD, xcd = wgid % NXCD, off = wgid / NXCD; wgid = (xcd < r ? xcd * (q + 1) : r * (q + 1) + (xcd - r) * q) + off; }
        const int nig = WGM * nN, gid = wgid / nig, fm = gid * WGM, gsz = (nM - fm) < WGM ? (nM - fm) : WGM;
        u.pm = fm + ((wgid % nig) % gsz); u.pn = (wgid % nig) / gsz; return true;
    }
};

template <class Epi>
__device__ __forceinline__ void gemm_phase(LAS unsigned char* lds, const Gemm g, const StaticOrder& S, const Epi& E) {
    int tid_ = threadIdx.x; asm volatile("" : "+v"(tid_));
    const int tid = tid_, wid = __builtin_amdgcn_readfirstlane(tid >> 6), lane = tid & 63, wr = wid >> 2, wc = wid & 3, fr = lane & 15, fq = lane >> 4;
    const int K = g.K, nt = K / BK;
    unsigned voffA[2];
#pragma unroll
    for (int i = 0; i < 2; ++i) { int R, C; stage_rc(tid * 16 + i * 8192, R, C); voffA[i] = (unsigned)(R * K + C) * 2u; }
    const size_t kstep = (size_t)(BK * 2);
    const size_t hstep = (size_t)HALF * K * 2;
    const size_t tstep = 2 * hstep;
    const unsigned ldsw = (unsigned)wid * 1024u;
    const int aoff = lds_byte(wr * 64 + fr, fq * 8), boff = lds_byte(wc * 32 + fr, fq * 8);
#define PG8_SA(b, h) (((b) * 2 + (h)) * HTB)
#define PG8_SB(b, h) ((4 + (b) * 2 + (h)) * HTB)
#define PG8_STAGE(bufoff, gbase, voff) do { _Pragma("unroll") for (int _i = 0; _i < 2; ++_i) \
        __builtin_amdgcn_global_load_lds((const unsigned*)((const char*)(gbase) + (voff)[_i]), (LAS unsigned*)(lds + (bufoff) + ldsw + _i * 8192), 16, 0, 0); } while (0)
#define PG8_LDA(dst, b, h) do { _Pragma("unroll") for (int m = 0; m < 4; ++m) _Pragma("unroll") for (int k = 0; k < 2; ++k) dst[m][k] = *(const LAS bf16x8*)(lds + PG8_SA(b, h) + aoff + m * 2048 + k * 1024); } while (0)
#define PG8_LDB(dst, b, h) do { _Pragma("unroll") for (int n = 0; n < 2; ++n) _Pragma("unroll") for (int k = 0; k < 2; ++k) dst[n][k] = *(const LAS bf16x8*)(lds + PG8_SB(b, h) + boff + n * 2048 + k * 1024); } while (0)
#define PG8_MMA(ai, bj, At, Bt) do { __builtin_amdgcn_s_setprio(1); _Pragma("unroll") for (int m = 0; m < 4; ++m) _Pragma("unroll") for (int n = 0; n < 2; ++n) _Pragma("unroll") for (int k = 0; k < 2; ++k) \
        acc[ai][bj][m][n] = __builtin_amdgcn_mfma_f32_16x16x32_bf16(Bt[n][k], At[m][k], acc[ai][bj][m][n], 0, 0, 0); __builtin_amdgcn_s_setprio(0); } while (0)
#define PG8_WAIT_V(n) asm volatile("s_waitcnt vmcnt(" #n ")" ::: "memory")
#define PG8_WAIT_L(n) asm volatile("s_waitcnt lgkmcnt(" #n ")" ::: "memory")
#define PG8_BAR __builtin_amdgcn_s_barrier()
#define PG8_SCHED __builtin_amdgcn_sched_barrier(0)
    Unit cur, nxt; int ui = 0;
    if (!S.next(0, cur)) return;
    f32x4 acc[2][2][4][2];
#pragma unroll
    for (int a = 0; a < 2; ++a)
#pragma unroll
        for (int b = 0; b < 2; ++b)
#pragma unroll
            for (int m = 0; m < 4; ++m)
#pragma unroll
                for (int n = 0; n < 2; ++n) acc[a][b][m][n] = (f32x4){0.f, 0.f, 0.f, 0.f};
    bf16x8 At[4][2], B0[2][2], B1[2][2];
    const char* cA = (const char*)g.A + (size_t)cur.pm * tstep; const char* cB = (const char*)g.Bt + (size_t)cur.pn * tstep;
    PG8_STAGE(PG8_SB(0, 0), cB, voffA); PG8_STAGE(PG8_SA(0, 0), cA, voffA); PG8_STAGE(PG8_SB(0, 1), cB + hstep, voffA); PG8_STAGE(PG8_SA(0, 1), cA + hstep, voffA);
    if (wr == 1) PG8_BAR;
    PG8_WAIT_V(4); PG8_BAR;
    PG8_STAGE(PG8_SB(1, 0), cB + kstep, voffA); PG8_STAGE(PG8_SA(1, 0), cA + kstep, voffA); PG8_STAGE(PG8_SB(1, 1), cB + hstep + kstep, voffA);
    PG8_WAIT_V(6); PG8_BAR;
    for (;;) {
        const bool has_next = S.next(ui + 1, nxt);
        const char* nA = has_next ? (const char*)g.A + (size_t)nxt.pm * tstep : cA; const char* nB = has_next ? (const char*)g.Bt + (size_t)nxt.pn * tstep : cB;
        for (int t = 0; t < nt; t += 2) {
            const bool last = (t == nt - 2);
            const char* a1 = cA + (size_t)(t + 1) * kstep;
            const char* a2 = last ? nA : cA + (size_t)(t + 2) * kstep; const char* b2 = last ? nB : cB + (size_t)(t + 2) * kstep;
            const char* a3 = a2 + kstep; const char* b3 = b2 + kstep;
            PG8_LDB(B0, 0, 0); PG8_SCHED; PG8_LDA(At, 0, 0); PG8_STAGE(PG8_SA(1, 1), a1 + hstep, voffA);
            PG8_WAIT_L(8); PG8_BAR; PG8_WAIT_L(0); PG8_MMA(0, 0, At, B0); PG8_BAR; PG8_SCHED;
            PG8_LDB(B1, 0, 1); PG8_STAGE(PG8_SB(0, 0), b2, voffA);
            PG8_BAR; PG8_WAIT_L(0); PG8_MMA(0, 1, At, B1); PG8_BAR;
            PG8_LDA(At, 0, 1); PG8_STAGE(PG8_SA(0, 0), a2, voffA);
            PG8_BAR; PG8_WAIT_L(0); PG8_MMA(1, 0, At, B0); PG8_BAR; PG8_SCHED;
            PG8_STAGE(PG8_SB(0, 1), b2 + hstep, voffA);
            PG8_WAIT_V(6); PG8_BAR; PG8_MMA(1, 1, At, B1); PG8_BAR;
            PG8_LDB(B0, 1, 0); PG8_SCHED; PG8_LDA(At, 1, 0); PG8_STAGE(PG8_SA(0, 1), a2 + hstep, voffA);
            PG8_WAIT_L(8); PG8_BAR; PG8_WAIT_L(0); PG8_MMA(0, 0, At, B0); PG8_BAR; PG8_SCHED;
            PG8_LDB(B1, 1, 1); PG8_STAGE(PG8_SB(1, 0), b3, voffA);
            PG8_BAR; PG8_WAIT_L(0); PG8_MMA(0, 1, At, B1); PG8_BAR;
            PG8_LDA(At, 1, 1); PG8_STAGE(PG8_SA(1, 0), a3, voffA);
            PG8_BAR; PG8_WAIT_L(0); PG8_MMA(1, 0, At, B0); PG8_BAR; PG8_SCHED;
            PG8_STAGE(PG8_SB(1, 1), b3 + hstep, voffA);
            PG8_WAIT_V(6); PG8_BAR; PG8_MMA(1, 1, At, B1); PG8_BAR;
        }
        if constexpr (!Epi::AFTER_DRAIN) E(acc, cur, ui, wr, wc, fr, fq);
        if (!has_next) break;
#pragma unroll
        for (int a = 0; a < 2; ++a)
#pragma unroll
            for (int b = 0; b < 2; ++b)
#pragma unroll
                for (int m = 0; m < 4; ++m)
#pragma unroll
                    for (int n = 0; n < 2; ++n) acc[a][b][m][n] = (f32x4){0.f, 0.f, 0.f, 0.f};
        cur = nxt; cA = nA; cB = nB; ++ui;
    }
    PG8_WAIT_V(0);
    if (wr == 0) PG8_BAR;
    PG8_BAR;
    if constexpr (Epi::AFTER_DRAIN) E.fused(acc, cur, wr, wc, fr, fq, lane);
#undef PG8_SA
#undef PG8_SB
#undef PG8_STAGE
#undef PG8_LDA
#undef PG8_LDB
#undef PG8_MMA
#undef PG8_WAIT_V
#undef PG8_WAIT_L
#undef PG8_BAR
#undef PG8_SCHED
}
}
using pg8::Unit;
typedef f32x4 Acc[2][2][4][2];

constexpr int XST_OFF = 152 * 1024, RTAB_OFF = XST_OFF + 64;
__device__ __forceinline__ void build_rtab(LAS unsigned char* lds, const pg8::StaticOrder& S, const float* part) {
    LAS float* rtab = (LAS float*)(lds + RTAB_OFF);
    int nu = 0; { pg8::Unit u; while (nu < 7 && S.next(nu, u)) ++nu; }
    for (int idx = threadIdx.x; idx < nu * 256; idx += 512) { pg8::Unit u; S.next(idx >> 8, u);
        const f32x4* pp = (const f32x4*)(part + (size_t)(u.pm * 256 + (idx & 255)) * 16);
        f32x4 a = pp[0], b = pp[1], c = pp[2], d = pp[3]; f32x4 sv = (a + b) + (c + d);
        rtab[idx] = __builtin_amdgcn_rsqf((sv[0] + sv[1] + sv[2] + sv[3]) * (1.0f / D_) + EPS); }
    __syncthreads();
}
__device__ __forceinline__ void rtab_get(float (&rinv)[2][4], LAS const unsigned char* lds, int ui, int wr, int fr) {
    LAS const float* rtab = (LAS const float*)(lds + RTAB_OFF) + ui * 256 + wr * 64 + fr;
#pragma unroll
    for (int ai = 0; ai < 2; ++ai)
#pragma unroll
        for (int m = 0; m < 4; ++m) rinv[ai][m] = rtab[ai * 128 + m * 16];
}

struct EpiSwiglu {
    static constexpr bool AFTER_DRAIN = false;
    u16* act; LAS const unsigned char* lds;
    __device__ __forceinline__ void operator()(const Acc& acc, const Unit& u, int ui, int wr, int wc, int fr, int fq) const {
        const int row0 = u.pm * 256 + wr * 64 + fr, col0 = u.pn * 128 + wc * 32 + fq * 8;
        float rinv[2][4]; rtab_get(rinv, lds, ui, wr, fr);
#pragma unroll
        for (int ai = 0; ai < 2; ++ai)
#pragma unroll
            for (int m = 0; m < 4; ++m) {
                const float ri = rinv[ai][m]; float v[8];
#pragma unroll
                for (int n = 0; n < 2; ++n)
#pragma unroll
                    for (int j = 0; j < 4; ++j) { const float g = acc[ai][0][m][n][j] * ri, up = acc[ai][1][m][n][j] * ri;
                        v[n * 4 + j] = g * frcp(1.0f + fexp2(-1.4426950408889634f * g)) * up; }
                u32x4 o; o[0] = cvt_pk_bf16(v[0], v[1]); o[1] = cvt_pk_bf16(v[2], v[3]); o[2] = cvt_pk_bf16(v[4], v[5]); o[3] = cvt_pk_bf16(v[6], v[7]);
                *(u32x4*)(act + (size_t)(row0 + ai * 128 + m * 16) * DFF + col0) = o;
            }
    }
};

template <bool OF> struct EpiResid {
    static constexpr bool AFTER_DRAIN = true;
    const u16* resid; float* out; u16* hb; float* part; float scale;
    __device__ __forceinline__ void fused(Acc& acc, const Unit& u, int wr, int wc, int fr, int fq, int) const { (*this)(acc, u, 0, wr, wc, fr, fq); }
    __device__ __forceinline__ void operator()(const Acc& acc, const Unit& u, int ui, int wr, int wc, int fr, int fq) const {
        const int row0 = u.pm * 256 + wr * 64 + fr, col0 = u.pn * 256 + wc * 32 + fq * 8;
        u32x4 rwa[2][4][2];
#pragma unroll
        for (int ai = 0; ai < 2; ++ai)
#pragma unroll
            for (int m = 0; m < 4; ++m)
#pragma unroll
                for (int bj = 0; bj < 2; ++bj) rwa[ai][m][bj] = *(const u32x4*)(resid + (size_t)(row0 + ai * 128 + m * 16) * D_ + col0 + bj * 128);
#pragma unroll
        for (int ai = 0; ai < 2; ++ai) {
#pragma unroll
            for (int m = 0; m < 4; ++m) {
                const int row = row0 + ai * 128 + m * 16; float ss = 0.f;
#pragma unroll
                for (int bj = 0; bj < 2; ++bj) {
                    const size_t o = (size_t)row * D_ + col0 + bj * 128;
                    const u32x4 w = rwa[ai][m][bj];
                    f32x4 h0 = (f32x4){bflo(w[0]), bfhi(w[0]), bflo(w[1]), bfhi(w[1])} + acc[ai][bj][m][0] * scale;
                    f32x4 h1 = (f32x4){bflo(w[2]), bfhi(w[2]), bflo(w[3]), bfhi(w[3])} + acc[ai][bj][m][1] * scale;
                    ss += h0[0] * h0[0] + h0[1] * h0[1] + h0[2] * h0[2] + h0[3] * h0[3] + h1[0] * h1[0] + h1[1] * h1[1] + h1[2] * h1[2] + h1[3] * h1[3];
                    if (OF) { *(f32x4*)(out + o) = h0; *(f32x4*)(out + o + 4) = h1; }
                    else { u32x4 b; b[0] = cvt_pk_bf16(h0[0], h0[1]); b[1] = cvt_pk_bf16(h0[2], h0[3]); b[2] = cvt_pk_bf16(h1[0], h1[1]); b[3] = cvt_pk_bf16(h1[2], h1[3]); *(u32x4*)(hb + o) = b; }
                }
                ss += __shfl_xor(ss, 16); ss += __shfl_xor(ss, 32);
                if (fq == 0) part[(size_t)row * 16 + u.pn * 4 + wc] = ss;
            }
        }
    }
};

struct EpiWin {
    static constexpr bool AFTER_DRAIN = false;
    u16 *qkva, *qkvb, *gates; LAS const unsigned char* lds; const float *cs, *bgate; float* kmp;
    __device__ __forceinline__ void operator()(const Acc& acc, const Unit& u, int ui, int wr, int wc, int fr, int fq) const {
        const int row0 = u.pm * 256 + wr * 64 + fr;
        const int pn = u.pn;
        LAS const float* rtab = (LAS const float*)(lds + RTAB_OFF) + ui * 256 + wr * 64 + fr;
        if (pn >= 12) {
            f32x4 bb[2][2];
#pragma unroll
            for (int bj = 0; bj < 2; ++bj) { const int gc = pn * 256 + bj * 128 + wc * 32 - 3072 + fq * 8; bb[bj][0] = *(const f32x4*)(bgate + gc); bb[bj][1] = *(const f32x4*)(bgate + gc + 4); }
#pragma unroll
            for (int bj = 0; bj < 2; ++bj) { const int gc = pn * 256 + bj * 128 + wc * 32 - 3072 + fq * 8;
#pragma unroll
                for (int ai = 0; ai < 2; ++ai)
#pragma unroll
                    for (int m = 0; m < 4; ++m) { const float ri = rtab[ai * 128 + m * 16]; float v[8];
#pragma unroll
                        for (int j = 0; j < 4; ++j) { v[j] = acc[ai][bj][m][0][j] * ri + bb[bj][0][j]; v[4 + j] = acc[ai][bj][m][1][j] * ri + bb[bj][1][j]; }
#pragma unroll
                        for (int j = 0; j < 8; ++j) v[j] = frcp(1.0f + fexp2(-1.4426950408889634f * v[j]));
                        u32x4 o; o[0] = cvt_pk_bf16(v[0], v[1]); o[1] = cvt_pk_bf16(v[2], v[3]); o[2] = cvt_pk_bf16(v[4], v[5]); o[3] = cvt_pk_bf16(v[6], v[7]);
                        *(u32x4*)(gates + (size_t)(row0 + ai * 128 + m * 16) * 2048 + gc) = o; } }
        } else {
            const bool isk = (pn == 2) || (pn == 3);
#pragma unroll
            for (int bj = 0; bj < 2; ++bj) {
                const int g32 = pn * 256 + bj * 128 + wc * 32;
                u16* base = g32 < 1536 ? qkva + g32 : qkvb + (g32 - 1536);
                const bool rot = (g32 < 1024) && ((g32 & 63) == 0) && (fq < 2);
                f32x4 ks0 = {0.f, 0.f, 0.f, 0.f}, ks1 = {0.f, 0.f, 0.f, 0.f};
                if (rot) {
#pragma unroll
                    for (int ai = 0; ai < 2; ++ai) {
                        f32x4 cc[4], sn[4];
#pragma unroll
                        for (int m = 0; m < 4; ++m) { const int row = row0 + ai * 128 + m * 16; cc[m] = *(const f32x4*)(cs + (size_t)row * 16 + fq * 4); sn[m] = *(const f32x4*)(cs + (size_t)row * 16 + 8 + fq * 4); }
#pragma unroll
                        for (int m = 0; m < 4; ++m) { const float ri = rtab[ai * 128 + m * 16]; const int row = row0 + ai * 128 + m * 16;
                            f32x4 a = acc[ai][bj][m][0] * ri, b = acc[ai][bj][m][1] * ri;
                            f32x4 o1 = a * cc[m] - b * sn[m], o2 = b * cc[m] + a * sn[m];
                            u32x2 w1, w2; w1[0] = cvt_pk_bf16(o1[0], o1[1]); w1[1] = cvt_pk_bf16(o1[2], o1[3]); w2[0] = cvt_pk_bf16(o2[0], o2[1]); w2[1] = cvt_pk_bf16(o2[2], o2[3]);
                            *(u32x2*)(base + (size_t)row * LDA_ + fq * 4) = w1; *(u32x2*)(base + (size_t)row * LDA_ + 8 + fq * 4) = w2;
                            ks0 += o1; ks1 += o2; } }
                } else {
#pragma unroll
                    for (int ai = 0; ai < 2; ++ai)
#pragma unroll
                        for (int m = 0; m < 4; ++m) { const float ri = rtab[ai * 128 + m * 16]; const int row = row0 + ai * 128 + m * 16;
                            f32x4 a = acc[ai][bj][m][0] * ri, b = acc[ai][bj][m][1] * ri;
                            u32x4 o; o[0] = cvt_pk_bf16(a[0], a[1]); o[1] = cvt_pk_bf16(a[2], a[3]); o[2] = cvt_pk_bf16(b[0], b[1]); o[3] = cvt_pk_bf16(b[2], b[3]);
                            *(u32x4*)(base + (size_t)row * LDA_ + fq * 8) = o;
                            ks0 += a; ks1 += b; }
                }
                if (isk) {
#pragma unroll
                    for (int j = 0; j < 4; ++j) {
#pragma unroll
                        for (int o = 1; o < 16; o <<= 1) { ks0[j] += __shfl_xor(ks0[j], o); ks1[j] += __shfl_xor(ks1[j], o); } }
                    if (fr == 0) { float* kp = kmp + (size_t)u.pm * 512 + (g32 - 512);
#pragma unroll
                        for (int j = 0; j < 4; ++j) { atomicAdd(kp + (rot ? fq * 4 : fq * 8) + j, ks0[j]); atomicAdd(kp + (rot ? 8 + fq * 4 : fq * 8 + 4) + j, ks1[j]); } }
                }
            }
        }
    }
};

template <bool FIRST> struct EpiBranch {
    static constexpr bool AFTER_DRAIN = true;
    const u16* gates; u16* tmp; u16* merged;
    __device__ __forceinline__ void fused(Acc& acc, const Unit& u, int wr, int wc, int fr, int fq, int) const { (*this)(acc, u, 0, wr, wc, fr, fq); }
    __device__ __forceinline__ void operator()(const Acc& acc, const Unit& u, int ui, int wr, int wc, int fr, int fq) const {
        const int row0 = u.pm * 256 + wr * 64 + fr, col0 = u.pn * 256 + wc * 32 + fq * 8;
        constexpr int NB = FIRST ? 1 : 2, AIB = FIRST ? 2 : 1;
#pragma unroll
        for (int bt = 0; bt < NB; ++bt) {
            u32x4 gw[AIB][4][2], tw[AIB][4][2];
#pragma unroll
            for (int a2 = 0; a2 < AIB; ++a2)
#pragma unroll
                for (int m = 0; m < 4; ++m)
#pragma unroll
                    for (int bj = 0; bj < 2; ++bj) { const int ai = FIRST ? a2 : bt, row = row0 + ai * 128 + m * 16, col = col0 + bj * 128;
                        gw[a2][m][bj] = *(const u32x4*)(gates + (size_t)row * 2048 + (FIRST ? 0 : 1024) + col);
                        if (!FIRST) tw[a2][m][bj] = *(const u32x4*)(tmp + (size_t)row * D_ + col); }
#pragma unroll
            for (int a2 = 0; a2 < AIB; ++a2)
#pragma unroll
                for (int m = 0; m < 4; ++m)
#pragma unroll
                    for (int bj = 0; bj < 2; ++bj) { const int ai = FIRST ? a2 : bt, row = row0 + ai * 128 + m * 16, col = col0 + bj * 128;
                        const u32x4 g2 = gw[a2][m][bj];
                        f32x4 v0 = (f32x4){bflo(g2[0]), bfhi(g2[0]), bflo(g2[1]), bfhi(g2[1])} * acc[ai][bj][m][0];
                        f32x4 v1 = (f32x4){bflo(g2[2]), bfhi(g2[2]), bflo(g2[3]), bfhi(g2[3])} * acc[ai][bj][m][1];
                        if (!FIRST) { const u32x4 t2 = tw[a2][m][bj]; v0 += (f32x4){bflo(t2[0]), bfhi(t2[0]), bflo(t2[1]), bfhi(t2[1])}; v1 += (f32x4){bflo(t2[2]), bfhi(t2[2]), bflo(t2[3]), bfhi(t2[3])}; }
                        u32x4 b; b[0] = cvt_pk_bf16(v0[0], v0[1]); b[1] = cvt_pk_bf16(v0[2], v0[3]); b[2] = cvt_pk_bf16(v1[0], v1[1]); b[3] = cvt_pk_bf16(v1[2], v1[3]);
                        *(u32x4*)((FIRST ? tmp : merged) + (size_t)row * D_ + col) = b; }
        }
    }
};

struct EpiFinal {
    static constexpr bool AFTER_DRAIN = true;
    const u16* resid; float* out; float* part; unsigned* pcnt; const float* gain; float scale;
    __device__ __forceinline__ void operator()(const Acc&, const Unit&, int, int, int, int, int) const {}
    __device__ __forceinline__ void fused(Acc& acc, const Unit& u, int wr, int wc, int fr, int fq, int lane) const {
        const int row0 = u.pm * 256 + wr * 64 + fr, col0 = u.pn * 256 + wc * 32 + fq * 8;
        u32x4 rwa[2][4][2];
#pragma unroll
        for (int ai = 0; ai < 2; ++ai)
#pragma unroll
            for (int m = 0; m < 4; ++m)
#pragma unroll
                for (int bj = 0; bj < 2; ++bj) rwa[ai][m][bj] = *(const u32x4*)(resid + (size_t)(row0 + ai * 128 + m * 16) * D_ + col0 + bj * 128);
#pragma unroll
        for (int ai = 0; ai < 2; ++ai)
#pragma unroll
            for (int m = 0; m < 4; ++m) { float ss = 0.f;
#pragma unroll
                for (int bj = 0; bj < 2; ++bj) { const u32x4 w = rwa[ai][m][bj];
                    f32x4 h0 = (f32x4){bflo(w[0]), bfhi(w[0]), bflo(w[1]), bfhi(w[1])} + acc[ai][bj][m][0] * scale;
                    f32x4 h1 = (f32x4){bflo(w[2]), bfhi(w[2]), bflo(w[3]), bfhi(w[3])} + acc[ai][bj][m][1] * scale;
                    acc[ai][bj][m][0] = h0; acc[ai][bj][m][1] = h1;
                    ss += h0[0] * h0[0] + h0[1] * h0[1] + h0[2] * h0[2] + h0[3] * h0[3] + h1[0] * h1[0] + h1[1] * h1[1] + h1[2] * h1[2] + h1[3] * h1[3]; }
                ss += __shfl_xor(ss, 16); ss += __shfl_xor(ss, 32);
                if (fq == 0) __hip_atomic_store(part + (size_t)(row0 + ai * 128 + m * 16) * 16 + u.pn * 4 + wc, ss, __ATOMIC_RELAXED, __HIP_MEMORY_SCOPE_AGENT); }
        asm volatile("s_waitcnt vmcnt(0)" ::: "memory");
        unsigned* cw = pcnt + u.pm * 16;
        if (lane == 0) {
            __hip_atomic_fetch_add(cw, 1u, __ATOMIC_RELAXED, __HIP_MEMORY_SCOPE_AGENT);
            unsigned sp = 0;
            while (__hip_atomic_load(cw, __ATOMIC_RELAXED, __HIP_MEMORY_SCOPE_AGENT) < 32u) { __builtin_amdgcn_s_sleep(1); if (++sp > (1u << 22)) break; }
        }
        float rinv[2][4];
        { float pv[2][4][4];
#pragma unroll
          for (int ai = 0; ai < 2; ++ai)
#pragma unroll
            for (int m = 0; m < 4; ++m)
#pragma unroll
              for (int k = 0; k < 4; ++k) pv[ai][m][k] = __hip_atomic_load(part + (size_t)(row0 + ai * 128 + m * 16) * 16 + fq * 4 + k, __ATOMIC_RELAXED, __HIP_MEMORY_SCOPE_AGENT);
#pragma unroll
          for (int ai = 0; ai < 2; ++ai)
#pragma unroll
            for (int m = 0; m < 4; ++m) { float sv = (pv[ai][m][0] + pv[ai][m][1]) + (pv[ai][m][2] + pv[ai][m][3]);
                sv += __shfl_xor(sv, 16); sv += __shfl_xor(sv, 32); rinv[ai][m] = __builtin_amdgcn_rsqf(sv * (1.0f / D_) + EPS); } }
        f32x4 gv[2][2];
#pragma unroll
        for (int bj = 0; bj < 2; ++bj)
#pragma unroll
            for (int n = 0; n < 2; ++n) gv[bj][n] = *(const f32x4*)(gain + col0 + bj * 128 + n * 4);
#pragma unroll
        for (int ai = 0; ai < 2; ++ai)
#pragma unroll
            for (int m = 0; m < 4; ++m)
#pragma unroll
                for (int bj = 0; bj < 2; ++bj)
#pragma unroll
                    for (int n = 0; n < 2; ++n)
                        *(f32x4*)(out + (size_t)(row0 + ai * 128 + m * 16) * D_ + col0 + bj * 128 + n * 4) = acc[ai][bj][m][n] * rinv[ai][m] * gv[bj][n];
    }
};

__device__ __forceinline__ int map_gu(int c, int up) { const int pn = c >> 7, w = c & 127, wc = w >> 5, r = w & 31; return pn * 256 + up * 128 + wc * 32 + ((r >> 2) & 1) * 16 + (r >> 3) * 4 + (r & 3); }
__device__ __forceinline__ int map_perm8(int c) { const int r = c & 31; return (c & ~31) + ((r >> 2) & 1) * 16 + (r >> 3) * 4 + (r & 3); }
__device__ __forceinline__ int map_win(int c) { if (c < 1024 && (c & 63) < 16) { const int r = c & 15, x2 = r >> 3, i = r & 7; return (c & ~63) + x2 * 16 + (i >> 2) * 4 + (i & 3); } return map_perm8(c); }

struct TileDesc { const float* W; u16* Wt; const float* gain; int K, N, mode, tile; };
struct TileRegs { f32x4 v[2]; float gk[2]; };
__device__ __forceinline__ void tile_load(TileRegs& r, const TileDesc& d) {
    const int ntn = d.N >> 6, tk = d.tile / ntn, tn = d.tile - tk * ntn, k0 = tk * 64, n0 = tn * 64, tid = threadIdx.x;
    const float cscale = d.mode == 3 ? (n0 < 512 ? 0.125f * 1.4426950408889634f : (n0 >= 1536 && n0 < 2048) ? 0.125f * 1.4426950408889634f : 1.0f) : 1.0f;
#pragma unroll
    for (int i = 0; i < 2; ++i) { const int e = tid + i * 512, k = e >> 4, c4 = (e & 15) * 4;
        r.v[i] = *(const f32x4*)(d.W + (size_t)(k0 + k) * d.N + n0 + c4); r.gk[i] = (d.gain ? d.gain[k0 + k] : 1.0f) * cscale; }
}
__device__ __forceinline__ void tile_store(LAS float* tl, const TileRegs& r, const TileDesc& d) {
    const int ntn = d.N >> 6, tk = d.tile / ntn, tn = d.tile - tk * ntn, k0 = tk * 64, n0 = tn * 64, tid = threadIdx.x;
    __syncthreads();
#pragma unroll
    for (int i = 0; i < 2; ++i) { const int e = tid + i * 512, k = e >> 4, c4 = (e & 15) * 4; const f32x4 v = r.v[i] * r.gk[i];
        tl[k * 65 + c4] = v[0]; tl[k * 65 + c4 + 1] = v[1]; tl[k * 65 + c4 + 2] = v[2]; tl[k * 65 + c4 + 3] = v[3]; }
    __syncthreads();
    const int n = tid & 63, kg = tid >> 6; float v[8];
#pragma unroll
    for (int i = 0; i < 8; ++i) v[i] = tl[(kg * 8 + i) * 65 + n];
    const int c = n0 + n; const int rr = d.mode == 0 ? c : d.mode == 1 ? map_gu(c, 0) : d.mode == 2 ? map_gu(c, 1) : d.mode == 3 ? map_win(c) : map_perm8(c);
    u32x4 o; o[0] = cvt_pk_bf16(v[0], v[1]); o[1] = cvt_pk_bf16(v[2], v[3]); o[2] = cvt_pk_bf16(v[4], v[5]); o[3] = cvt_pk_bf16(v[6], v[7]);
    *(u32x4*)(d.Wt + (size_t)rr * d.K + k0 + kg * 8) = o;
}

__device__ __forceinline__ void prep_phase(const Params& p, LAS unsigned char* lds) {
    unsigned char* ws = p.ws; LAS float* tl = (LAS float*)lds;
    const int tid = threadIdx.x, lane = tid & 63, wid = tid >> 6, G = gridDim.x;
    if (blockIdx.x == 0) { ((int*)(ws + WS_CNT))[tid] = 0; }
    if (blockIdx.x < 64) ((float*)(ws + WS_KMEAN))[blockIdx.x * 512 + tid] = 0.f;
    constexpr int T_GU = 16 * 44, T_DN = 44 * 16, T_IN = 16 * 80, T_BR = 8 * 16, T_WO = 16 * 16;
    constexpr int o1 = T_GU, o2 = o1 + T_GU, o3 = o2 + T_DN, o4 = o3 + T_IN, o5 = o4 + T_BR, o6 = o5 + T_BR, o7 = o6 + T_WO, o8 = o7 + T_GU, o9 = o8 + T_GU, o10 = o9 + T_DN;
    auto desc = [&](int t) -> TileDesc {
        if (t < o1) return TileDesc{p.g1, (u16*)(ws + WS_GU1), p.n1, D_, DFF, 1, t};
        if (t < o2) return TileDesc{p.u1, (u16*)(ws + WS_GU1), p.n1, D_, DFF, 2, t - o1};
        if (t < o3) return TileDesc{p.d1, (u16*)(ws + WS_DN1), nullptr, DFF, D_, 4, t - o2};
        if (t < o4) return TileDesc{p.win, (u16*)(ws + WS_IN), p.nm, D_, DIN, 3, t - o3};
        if (t < o5) return TileDesc{p.wba, (u16*)(ws + WS_BA), nullptr, 512, D_, 4, t - o4};
        if (t < o6) return TileDesc{p.wbb, (u16*)(ws + WS_BB), nullptr, 512, D_, 4, t - o5};
        if (t < o7) return TileDesc{p.wo, (u16*)(ws + WS_WO), nullptr, D_, D_, 4, t - o6};
        if (t < o8) return TileDesc{p.g2, (u16*)(ws + WS_GU2), p.n2, D_, DFF, 1, t - o7};
        if (t < o9) return TileDesc{p.u2, (u16*)(ws + WS_GU2), p.n2, D_, DFF, 2, t - o8};
        return TileDesc{p.d2, (u16*)(ws + WS_DN2), nullptr, DFF, D_, 4, t - o9};
    };
    const int NPREP = (int)gridDim.x == 256 ? 2 * T_GU : 2 * T_GU + 2 * T_GU + T_DN;
    auto pdesc = [&](int t) -> TileDesc { return t < 2 * T_GU ? desc(t) : desc(t - 2 * T_GU + o7); };
    { int t = blockIdx.x;
      if (t < NPREP) { TileDesc d = pdesc(t); TileRegs ra; tile_load(ra, d);
        for (;;) { const int tn = t + G; const bool more = tn < NPREP; TileDesc dn = d; TileRegs rb = ra;
            if (more) { dn = pdesc(tn); tile_load(rb, dn); }
            tile_store(tl, ra, d);
            if (!more) break;
            d = dn; ra = rb; t = tn; } } }
    u16* xb = (u16*)(ws + WS_AB); float* part0 = (float*)(ws + WS_P0); float* cs = (float*)(ws + WS_CS);
    f32x4 xv[4];
    { const int row0_ = blockIdx.x * 8 + wid; if (row0_ < T_) {
#pragma unroll
        for (int i = 0; i < 4; ++i) xv[i] = *(const f32x4*)(p.x + (size_t)row0_ * D_ + i * 256 + lane * 4); } }
    for (int row = blockIdx.x * 8 + wid; row < T_; row += G * 8) {
        float ss = 0.f; f32x4 cur[4];
#pragma unroll
        for (int i = 0; i < 4; ++i) cur[i] = xv[i];
        if (row + G * 8 < T_) {
#pragma unroll
            for (int i = 0; i < 4; ++i) xv[i] = *(const f32x4*)(p.x + (size_t)(row + G * 8) * D_ + i * 256 + lane * 4); }
#pragma unroll
        for (int i = 0; i < 4; ++i) { const f32x4 v = cur[i]; ss += v[0] * v[0] + v[1] * v[1] + v[2] * v[2] + v[3] * v[3];
            u32x2 b; b[0] = cvt_pk_bf16(v[0], v[1]); b[1] = cvt_pk_bf16(v[2], v[3]); *(u32x2*)(xb + (size_t)row * D_ + i * 256 + lane * 4) = b; }
#pragma unroll
        for (int o = 32; o >= 1; o >>= 1) ss += __shfl_xor(ss, o);
        if (lane < 16) part0[(size_t)row * 16 + lane] = lane == 0 ? ss : 0.f;
        if (lane >= 16 && lane < 24) {
            const int i = lane - 16;
            const float invf = i == 0 ? 1.0f : i == 1 ? 0.1939227432012558f : i == 2 ? 0.03760603070259094f : i == 3 ? 0.007292664609849453f : i == 4 ? 0.0014142135623842478f
                             : i == 5 ? 0.00027424818836152554f : i == 6 ? 5.318296098266728e-05f : 1.0313386155758053e-05f;
            const float ang = (float)p.pos[row] * invf;
            const double a = (double)ang, kk = __builtin_rint(a * 0.15915494309189535), r = a - kk * 6.283185307179586;
            const float rf = (float)r;
            cs[(size_t)row * 16 + i] = __cosf(rf); cs[(size_t)row * 16 + 8 + i] = __sinf(rf);
        }
    }
}


__device__ __forceinline__ void deferred_weights(const Params& p, LAS unsigned char* lds, int j, int nidle, int lo, int hi) {
    unsigned char* ws = p.ws; LAS float* tl = (LAS float*)lds;
    constexpr int T_GU = 16 * 44, T_DN = 44 * 16, T_IN = 16 * 80, T_BR = 8 * 16, T_WO = 16 * 16;
    constexpr int o2 = 2 * T_GU, o3 = o2 + T_DN, o4 = o3 + T_IN, o5 = o4 + T_BR, o6 = o5 + T_BR, o7 = o6 + T_WO, o8 = o7 + T_GU, o9 = o8 + T_GU;
    auto desc = [&](int t) -> TileDesc {
        if (t < o3) return TileDesc{p.d1, (u16*)(ws + WS_DN1), nullptr, DFF, D_, 4, t - o2};
        if (t < o4) return TileDesc{p.win, (u16*)(ws + WS_IN), p.nm, D_, DIN, 3, t - o3};
        if (t < o5) return TileDesc{p.wba, (u16*)(ws + WS_BA), nullptr, 512, D_, 4, t - o4};
        if (t < o6) return TileDesc{p.wbb, (u16*)(ws + WS_BB), nullptr, 512, D_, 4, t - o5};
        if (t < o7) return TileDesc{p.wo, (u16*)(ws + WS_WO), nullptr, D_, D_, 4, t - o6};
        if (t < o8) return TileDesc{p.g2, (u16*)(ws + WS_GU2), p.n2, D_, DFF, 1, t - o7};
        if (t < o9) return TileDesc{p.u2, (u16*)(ws + WS_GU2), p.n2, D_, DFF, 2, t - o8};
        return TileDesc{p.d2, (u16*)(ws + WS_DN2), nullptr, DFF, D_, 4, t - o9};
    };
    int t = lo + j;
    if (t < hi) { TileDesc d = desc(t); TileRegs ra; tile_load(ra, d);
        for (;;) { const int tn = t + nidle; const bool more = tn < hi; TileDesc dn = d; TileRegs rb = ra;
            if (more) { dn = desc(tn); tile_load(rb, dn); }
            tile_store(tl, ra, d);
            if (!more) break;
            d = dn; ra = rb; t = tn; } }
}

__device__ __forceinline__ s16x4 vtr(LAS const unsigned char* p) { typedef short v4i16_t __attribute__((ext_vector_type(4))); return __builtin_bit_cast(s16x4, __builtin_amdgcn_ds_read_tr16_b64_v4i16((LAS v4i16_t*)p)); }

__device__ __forceinline__ void pv_tile(f32x4 (&o)[4], LAS const unsigned char* vs, const bf16x8 (&pf)[2], int lane) {
    const int li = lane & 15, g = lane >> 4, q_ = li >> 2, pp = li & 3;
    LAS const unsigned char* b0 = vs + (4 * g + q_) * 144 + pp * 8;
#pragma unroll
    for (int ks = 0; ks < 2; ++ks)
#pragma unroll
        for (int dt = 0; dt < 4; ++dt) {
            s16x4 lo = vtr(b0 + (32 * ks) * 144 + dt * 32), hi = vtr(b0 + (32 * ks + 16) * 144 + dt * 32);
            bf16x8 va = {lo[0], lo[1], lo[2], lo[3], hi[0], hi[1], hi[2], hi[3]};
            o[dt] = __builtin_amdgcn_mfma_f32_16x16x32_bf16(va, pf[ks], o[dt], 0, 0, 0);
        }
}
__device__ __forceinline__ void pack_p(bf16x8 (&pf)[2], const float (&w)[4][4]) {
#pragma unroll
    for (int ks = 0; ks < 2; ++ks) { u32x4 t; t[0] = cvt_pk_bf16(w[2 * ks][0], w[2 * ks][1]); t[1] = cvt_pk_bf16(w[2 * ks][2], w[2 * ks][3]);
        t[2] = cvt_pk_bf16(w[2 * ks + 1][0], w[2 * ks + 1][1]); t[3] = cvt_pk_bf16(w[2 * ks + 1][2], w[2 * ks + 1][3]); pf[ks] = __builtin_bit_cast(bf16x8, t); }
}
__device__ __forceinline__ void load_qf(bf16x8 (&qf)[2], const u16* qrow, int lane) { const int g = lane >> 4; qf[0] = *(const bf16x8*)(qrow + 8 * g); qf[1] = *(const bf16x8*)(qrow + 32 + 8 * g); }

__device__ __forceinline__ int list_off(int n) { return 256 * (63 * n - (n * (n - 1)) / 2); }

struct Top3 { unsigned k1, k2, k3; };
__device__ __forceinline__ unsigned topk_key(float v, int n) { unsigned u = __float_as_uint(v); u = (u & 0x80000000u) ? ~u : (u | 0x80000000u); return (u & ~63u) | (unsigned)(63 - n); }
__device__ __forceinline__ void top3_insert(Top3& t, unsigned k) {
    const unsigned a1 = t.k1 > k ? t.k1 : k, r1 = t.k1 > k ? k : t.k1;
    const unsigned a2 = t.k2 > r1 ? t.k2 : r1, r2 = t.k2 > r1 ? r1 : t.k2;
    t.k1 = a1; t.k2 = a2; t.k3 = t.k3 > r2 ? t.k3 : r2;
}
__device__ __forceinline__ void topk_item(const Params& p, int item, int lane, LAS int* hist  ) {
    const u16* qkva = (const u16*)(p.ws + WS_QKVA); const float* km = (const float*)(p.ws + WS_KMEAN);
    int* cnt = (int*)(p.ws + WS_CNT); u16* list = (u16*)(p.ws + WS_LIST);
    const int h = item & 7, qc = item >> 3, q0 = qc * 64, own = qc >> 2, r = lane & 15, g = lane >> 4;
    if (own == 0) return;
    int sel[4][3];
#pragma unroll
    for (int qt = 0; qt < 4; ++qt) { sel[qt][0] = 0; sel[qt][1] = 1; sel[qt][2] = 2; }
    if (own > 3) {
        Top3 tp[4];
#pragma unroll
        for (int qt = 0; qt < 4; ++qt) { tp[qt].k1 = 0u; tp[qt].k2 = 0u; tp[qt].k3 = 0u; }
        bf16x8 qfr[4][2];
#pragma unroll
        for (int qt = 0; qt < 4; ++qt) load_qf(qfr[qt], qkva + (size_t)(q0 + 16 * qt + r) * LDA_ + h * 64, lane);
        const int ntile = (own + 15) >> 4;
        for (int nt = 0; nt < ntile; ++nt) {
            const int nrow = 16 * nt + r; const bool nv = nrow < own;
            bf16x8 ahi[2], alo[2];
#pragma unroll
            for (int ks = 0; ks < 2; ++ks) { const float* kp = km + (size_t)(nv ? nrow : 0) * 512 + h * 64 + 32 * ks + 8 * g;
                f32x4 a = *(const f32x4*)kp, b = *(const f32x4*)(kp + 4);
                u32x4 hi; hi[0] = cvt_pk_bf16(a[0], a[1]); hi[1] = cvt_pk_bf16(a[2], a[3]); hi[2] = cvt_pk_bf16(b[0], b[1]); hi[3] = cvt_pk_bf16(b[2], b[3]);
                f32x4 ra = {a[0] - bflo(hi[0]), a[1] - bfhi(hi[0]), a[2] - bflo(hi[1]), a[3] - bfhi(hi[1])}, rb = {b[0] - bflo(hi[2]), b[1] - bfhi(hi[2]), b[2] - bflo(hi[3]), b[3] - bfhi(hi[3])};
                u32x4 lo; lo[0] = cvt_pk_bf16(ra[0], ra[1]); lo[1] = cvt_pk_bf16(ra[2], ra[3]); lo[2] = cvt_pk_bf16(rb[0], rb[1]); lo[3] = cvt_pk_bf16(rb[2], rb[3]);
                ahi[ks] = __builtin_bit_cast(bf16x8, hi); alo[ks] = __builtin_bit_cast(bf16x8, lo); }
#pragma unroll
            for (int qt = 0; qt < 4; ++qt) { f32x4 acc = {0.f, 0.f, 0.f, 0.f};
#pragma unroll
                for (int ks = 0; ks < 2; ++ks) { acc = __builtin_amdgcn_mfma_f32_16x16x32_bf16(ahi[ks], qfr[qt][ks], acc, 0, 0, 0); acc = __builtin_amdgcn_mfma_f32_16x16x32_bf16(alo[ks], qfr[qt][ks], acc, 0, 0, 0); }
#pragma unroll
                for (int j = 0; j < 4; ++j) { const int n = 16 * nt + 4 * g + j; top3_insert(tp[qt], n < own ? topk_key(acc[j], n) : 0u); } }
        }
#pragma unroll
        for (int step = 16; step <= 32; step <<= 1)
#pragma unroll
            for (int qt = 0; qt < 4; ++qt) { const unsigned p1 = __shfl_xor(tp[qt].k1, step), p2 = __shfl_xor(tp[qt].k2, step), p3 = __shfl_xor(tp[qt].k3, step);
                top3_insert(tp[qt], p1); top3_insert(tp[qt], p2); top3_insert(tp[qt], p3); }
#pragma unroll
        for (int qt = 0; qt < 4; ++qt) { sel[qt][0] = 63 - (int)(tp[qt].k1 & 63u); sel[qt][1] = 63 - (int)(tp[qt].k2 & 63u); sel[qt][2] = 63 - (int)(tp[qt].k3 & 63u); }
    }
    const int nsel = own < 3 ? own : 3;
    volatile LAS int* vh = (volatile LAS int*)hist;
    vh[lane] = 0;
    __builtin_amdgcn_fence(__ATOMIC_RELEASE, "wavefront"); __builtin_amdgcn_wave_barrier();
    int rank[4][3];
    if (g == 0) {
#pragma unroll
        for (int qt = 0; qt < 4; ++qt)
#pragma unroll
            for (int s2 = 0; s2 < 3; ++s2) { const int n = sel[qt][s2];
                rank[qt][s2] = s2 < nsel ? __hip_atomic_fetch_add(hist + n, 1, __ATOMIC_RELAXED, __HIP_MEMORY_SCOPE_WORKGROUP) : 0; }
    }
    __builtin_amdgcn_fence(__ATOMIC_ACQ_REL, "wavefront"); __builtin_amdgcn_wave_barrier();
    { const int c = vh[lane]; vh[64 + lane] = c > 0 ? atomicAdd(cnt + h * 64 + lane, c) : 0; }
    __builtin_amdgcn_fence(__ATOMIC_ACQ_REL, "wavefront"); __builtin_amdgcn_wave_barrier();
    if (g == 0) {
#pragma unroll
        for (int qt = 0; qt < 4; ++qt) { const int q = q0 + 16 * qt + r;
#pragma unroll
            for (int s2 = 0; s2 < 3; ++s2) if (s2 < nsel) { const int n = sel[qt][s2];
                list[(size_t)h * LISTH + list_off(n) + vh[64 + n] + rank[qt][s2]] = (u16)(q | (s2 << 14)); } }
    }
}

struct CoopKV { u32x4 k, v; };
#define KB_OFF(b) ((b) * 18432)
#define VB_OFF(b) ((b) * 18432 + 9216)
__device__ __forceinline__ void coop_load(CoopKV& c, const u16* kbase, int tid) { const u16* p = kbase + (size_t)(tid >> 3) * LDA_ + 8 * (tid & 7); c.k = *(const u32x4*)p; c.v = *(const u32x4*)(p + 512); }
__device__ __forceinline__ void qk_lds(f32x4 (&acc)[4], LAS const unsigned char* kb, const bf16x8 (&qf)[2], int lane) {
    const int r = lane & 15, g = lane >> 4;
#pragma unroll
    for (int kt = 0; kt < 4; ++kt) { LAS const unsigned char* kp = kb + (16 * kt + r) * 144 + 16 * g;
        bf16x8 k0 = *(LAS const bf16x8*)kp, k1 = *(LAS const bf16x8*)(kp + 64);
        f32x4 z = {0.f, 0.f, 0.f, 0.f};
        z = __builtin_amdgcn_mfma_f32_16x16x32_bf16(k0, qf[0], z, 0, 0, 0);
        acc[kt] = __builtin_amdgcn_mfma_f32_16x16x32_bf16(k1, qf[1], z, 0, 0, 0); }
}
template <bool CAUSAL>
__device__ __forceinline__ void sm_tile_l(LAS const unsigned char* kb, LAS const unsigned char* vb, int key0, int t, const bf16x8 (&qf)[2], float& m, float& l, f32x4 (&o)[4], int lane) {
    const int g = lane >> 4;
    f32x4 acc[4]; qk_lds(acc, kb, qf, lane);
    float s[4][4]; float lm = -INFINITY;
#pragma unroll
    for (int kt = 0; kt < 4; ++kt)
#pragma unroll
        for (int j = 0; j < 4; ++j) { float v = acc[kt][j]; if (CAUSAL && (key0 + 16 * kt + 4 * g + j) > t) v = -INFINITY; s[kt][j] = v; lm = fmaxf(lm, v); }
    lm = fmaxf(lm, __shfl_xor(lm, 16)); lm = fmaxf(lm, __shfl_xor(lm, 32));
    const float mn = fmaxf(m, lm), al = fexp2(m - mn);
    float sum = 0.f;
#pragma unroll
    for (int kt = 0; kt < 4; ++kt)
#pragma unroll
        for (int j = 0; j < 4; ++j) { s[kt][j] = fexp2(s[kt][j] - mn); sum += s[kt][j]; }
    l = l * al + sum; m = mn;
#pragma unroll
    for (int dt = 0; dt < 4; ++dt) o[dt] *= al;
    bf16x8 pf[2]; pack_p(pf, s);
    pv_tile(o, vb, pf, lane);
}

__device__ __forceinline__ void sel_block_stream(const Params& p, LAS unsigned char* lds, LAS const int* sched, int total, int tid, int wid, int lane) {
    const u16* qkva = (const u16*)(p.ws + WS_QKVA); const u16* list = (const u16*)(p.ws + WS_LIST);
    u16* po = (u16*)(p.ws + WS_PO); float* pml = (float*)(p.ws + WS_PML);
    const int r = lane & 15, g = lane >> 4, G = gridDim.x;
    int i = (G & 7) == 0 ? (int)(blockIdx.x & 7) * (G >> 3) + (int)(blockIdx.x >> 3) : (int)blockIdx.x; if (i >= total) return;
#define SELB_DECODE(kk_, H, N, E, OK, ACT) do { const int hn_ = __builtin_amdgcn_readfirstlane(sched[(kk_) * 4]), grp_ = __builtin_amdgcn_readfirstlane(sched[(kk_) * 4 + 1]), c_ = __builtin_amdgcn_readfirstlane(sched[(kk_) * 4 + 2]); \
        H = hn_ >> 6; N = hn_ & 63; const int e0_ = grp_ * 128 + wid * 16; ACT = e0_ < c_; int ei_ = e0_ + r; OK = ei_ < c_; if (!OK) ei_ = ACT ? e0_ : 0; \
        E = list[(size_t)H * LISTH + list_off(N) + ei_]; } while (0)
    int kq = 0; int h, n; unsigned e; bool ok, act; SELB_DECODE(kq, h, n, e, ok, act);
    bf16x8 qf[2]; load_qf(qf, qkva + (size_t)(e & 0x3FFF) * LDA_ + h * 64, lane);
#define KBIG(b_) ((b_) * 73728)
#define VBIG(b_) ((b_) * 73728 + 36864)
    CoopKV cN[4];
    { const u16* kb0 = qkva + (size_t)(n * 256) * LDA_ + 512 + h * 64;
#pragma unroll
      for (int t4 = 0; t4 < 4; ++t4) coop_load(cN[t4], kb0 + (size_t)t4 * 64 * LDA_, tid);
      const int o_ = (tid >> 3) * 144 + (tid & 7) * 16;
#pragma unroll
      for (int t4 = 0; t4 < 4; ++t4) { *(LAS u32x4*)(lds + KBIG(0) + t4 * 9216 + o_) = cN[t4].k; *(LAS u32x4*)(lds + VBIG(0) + t4 * 9216 + o_) = cN[t4].v; } }
    __syncthreads();
    int buf = 0;
    for (;;) {
        const int i2 = i + G; const bool has_next = i2 < total;
        int h2 = 0, n2 = 0; unsigned e2 = 0; bool ok2 = false, act2 = false;
        if (has_next) { SELB_DECODE(kq + 1, h2, n2, e2, ok2, act2);
            const u16* kb2 = qkva + (size_t)(n2 * 256) * LDA_ + 512 + h2 * 64;
#pragma unroll
            for (int t4 = 0; t4 < 4; ++t4) coop_load(cN[t4], kb2 + (size_t)t4 * 64 * LDA_, tid); }
        f32x4 o[4];
#pragma unroll
        for (int q_ = 0; q_ < 4; ++q_) o[q_] = (f32x4){0.f, 0.f, 0.f, 0.f};
        float m = -INFINITY, l = 0.f; bf16x8 qn[2] = {qf[0], qf[1]};
        if (has_next) load_qf(qn, qkva + (size_t)(e2 & 0x3FFF) * LDA_ + h2 * 64, lane);
        if (act) {
#pragma unroll 1
            for (int tile = 0; tile < 4; ++tile) sm_tile_l<false>(lds + KBIG(buf) + tile * 9216, lds + VBIG(buf) + tile * 9216, 0, 0, qf, m, l, o, lane);
            l += __shfl_xor(l, 16); l += __shfl_xor(l, 32);
            const float inv = frcp(l);
            if (ok) { const size_t sidx = ((size_t)(e & 0x3FFF) * NH + h) * 3 + (e >> 14);
#pragma unroll
                for (int dt = 0; dt < 4; ++dt) { u32x2 b; b[0] = cvt_pk_bf16(o[dt][0] * inv, o[dt][1] * inv); b[1] = cvt_pk_bf16(o[dt][2] * inv, o[dt][3] * inv);
                    *(u32x2*)(po + sidx * 64 + 16 * dt + 4 * g) = b; }
                if (g == 0) { pml[sidx * 2] = m; pml[sidx * 2 + 1] = l; } } }
        if (!has_next) break;
        { const int o_ = (tid >> 3) * 144 + (tid & 7) * 16;
#pragma unroll
          for (int t4 = 0; t4 < 4; ++t4) { *(LAS u32x4*)(lds + KBIG(buf ^ 1) + t4 * 9216 + o_) = cN[t4].k; *(LAS u32x4*)(lds + VBIG(buf ^ 1) + t4 * 9216 + o_) = cN[t4].v; } }
        __syncthreads(); buf ^= 1;
        i = i2; ++kq; h = h2; n = n2; e = e2; ok = ok2; act = act2; qf[0] = qn[0]; qf[1] = qn[1];
    }
#undef KBIG
#undef VBIG
#undef SELB_DECODE
}

__device__ __forceinline__ void own_block_stream(const Params& p, LAS unsigned char* lds, int tid, int wid, int lane) {
    const u16* qkva = (const u16*)(p.ws + WS_QKVA); const u16* po = (const u16*)(p.ws + WS_PO); const float* pml = (const float*)(p.ws + WS_PML);
    u16* ya = (u16*)(p.ws + WS_AB);
    const int r = lane & 15, g = lane >> 4, G = gridDim.x, total = (T_ / 128) * NH;
    int i = (G & 7) == 0 ? (int)(blockIdx.x & 7) * (G >> 3) + (int)(blockIdx.x >> 3) : (int)blockIdx.x, kk = 0; if (i >= total) return;
#define OWN_DEC(ii, k_, C, H) do { C = ((ii) >> 3) ^ ((k_) & 1); H = (ii) & 7; } while (0)
    int cch, h; OWN_DEC(i, kk, cch, h);
    bf16x8 qf[2]; load_qf(qf, qkva + (size_t)(cch * 128 + wid * 16 + r) * LDA_ + h * 64, lane);
#define KBIG(b_) ((b_) * 73728)
#define VBIG(b_) ((b_) * 73728 + 36864)
    CoopKV cN[4]; const int o_ = (tid >> 3) * 144 + (tid & 7) * 16;
    { const u16* kb0 = qkva + (size_t)((cch >> 1) * 256) * LDA_ + 512 + h * 64; const int nt0 = (cch & 1) ? 4 : 2;
#pragma unroll
      for (int t4 = 0; t4 < 4; ++t4) if (t4 < nt0) coop_load(cN[t4], kb0 + (size_t)t4 * 64 * LDA_, tid);
#pragma unroll
      for (int t4 = 0; t4 < 4; ++t4) if (t4 < nt0) { *(LAS u32x4*)(lds + KBIG(0) + t4 * 9216 + o_) = cN[t4].k; *(LAS u32x4*)(lds + VBIG(0) + t4 * 9216 + o_) = cN[t4].v; } }
    __syncthreads();
    int buf = 0;
    for (;;) {
        const int i2 = i + G; const bool has_next = i2 < total; int c2 = 0, h2 = 0; OWN_DEC(i2, kk + 1, c2, h2);
        const int own = cch >> 1, q0 = cch * 128 + wid * 16, t = q0 + r, wmax = ((cch & 1) * 128 + wid * 16 + 15) >> 6;
        const int nt2 = (c2 & 1) ? 4 : 2;
        f32x4 o[4];
#pragma unroll
        for (int q_ = 0; q_ < 4; ++q_) o[q_] = (f32x4){0.f, 0.f, 0.f, 0.f};
        float m = -INFINITY, l = 0.f; bf16x8 qn[2] = {qf[0], qf[1]};
        if (has_next) { const u16* kb2 = qkva + (size_t)((c2 >> 1) * 256) * LDA_ + 512 + h2 * 64;
#pragma unroll
            for (int t4 = 0; t4 < 4; ++t4) if (t4 < nt2) coop_load(cN[t4], kb2 + (size_t)t4 * 64 * LDA_, tid);
            load_qf(qn, qkva + (size_t)(c2 * 128 + wid * 16 + r) * LDA_ + h2 * 64, lane); }
        const int nsel = own < 3 ? own : 3;
        const size_t sidx = ((size_t)t * NH + h) * 3;
        float ms[3], lsv[3]; u32x2 pw[3][4];
#pragma unroll
        for (int s2 = 0; s2 < 3; ++s2) { ms[s2] = -INFINITY; lsv[s2] = 0.f;
#pragma unroll
            for (int dt = 0; dt < 4; ++dt) pw[s2][dt] = (u32x2){0u, 0u};
            if (s2 < nsel) { ms[s2] = pml[(sidx + s2) * 2]; lsv[s2] = pml[(sidx + s2) * 2 + 1];
#pragma unroll
                for (int dt = 0; dt < 4; ++dt) pw[s2][dt] = *(const u32x2*)(po + (sidx + s2) * 64 + 16 * dt + 4 * g); } }
#pragma unroll 1
        for (int tile = 0; tile <= wmax; ++tile) sm_tile_l<true>(lds + KBIG(buf) + tile * 9216, lds + VBIG(buf) + tile * 9216, own * 256 + tile * 64, t, qf, m, l, o, lane);
        l += __shfl_xor(l, 16); l += __shfl_xor(l, 32);
        float M = m;
#pragma unroll
        for (int s2 = 0; s2 < 3; ++s2) M = fmaxf(M, ms[s2]);
        const float a0 = fexp2(m - M); float den = l * a0;
#pragma unroll
        for (int dt = 0; dt < 4; ++dt) o[dt] *= a0;
#pragma unroll
        for (int s2 = 0; s2 < 3; ++s2) { const float a = lsv[s2] * fexp2(ms[s2] - M); den += a;
#pragma unroll
            for (int dt = 0; dt < 4; ++dt) { const u32x2 w = pw[s2][dt];
                o[dt][0] += a * bflo(w[0]); o[dt][1] += a * bfhi(w[0]); o[dt][2] += a * bflo(w[1]); o[dt][3] += a * bfhi(w[1]); } }
        const float inv = frcp(den);
#pragma unroll
        for (int dt = 0; dt < 4; ++dt) { u32x2 b; b[0] = cvt_pk_bf16(o[dt][0] * inv, o[dt][1] * inv); b[1] = cvt_pk_bf16(o[dt][2] * inv, o[dt][3] * inv);
            *(u32x2*)(ya + (size_t)t * 512 + h * 64 + 16 * dt + 4 * g) = b; }
        if (!has_next) break;
#pragma unroll
        for (int t4 = 0; t4 < 4; ++t4) if (t4 < nt2) { *(LAS u32x4*)(lds + KBIG(buf ^ 1) + t4 * 9216 + o_) = cN[t4].k; *(LAS u32x4*)(lds + VBIG(buf ^ 1) + t4 * 9216 + o_) = cN[t4].v; }
        __syncthreads(); buf ^= 1;
        i = i2; ++kk; cch = c2; h = h2; qf[0] = qn[0]; qf[1] = qn[1];
    }
#undef KBIG
#undef VBIG
#undef OWN_DEC
}

__device__ __forceinline__ void sb_tile_l(LAS const unsigned char* kb, LAS const unsigned char* vb, int key0, int t, const bf16x8 (&qf)[2], float& R, f32x4 (&o)[4], int lane) {
    const int g = lane >> 4;
    f32x4 acc[4]; qk_lds(acc, kb, qf, lane);
    float lf[4][4], Tk[4], ex[4];
#pragma unroll
    for (int kt = 0; kt < 4; ++kt) { float c = 0.f;
#pragma unroll
        for (int j = 0; j < 4; ++j) { const bool valid = (key0 + 16 * kt + 4 * g + j) < t; const float z = acc[kt][j];
            const float sp = fmaxf(z, 0.f) + __builtin_amdgcn_logf(1.0f + fexp2(-fabsf(z)));
            acc[kt][j] = z; lf[kt][j] = valid ? -sp : 0.f; c += lf[kt][j]; }
        const float b = __shfl_xor(c, 16), s2 = c + b, d = __shfl_xor(s2, 32);
        Tk[kt] = s2 + d; ex[kt] = ((g & 1) ? 0.f : b) + ((g & 2) ? 0.f : d); }
    float w[4][4]; float run = R;
#pragma unroll
    for (int kt = 3; kt >= 0; --kt) { const float E = run + ex[kt]; float suf = 0.f;
#pragma unroll
        for (int j = 3; j >= 0; --j) { const bool valid = (key0 + 16 * kt + 4 * g + j) < t; w[kt][j] = valid ? fexp2(acc[kt][j] + lf[kt][j] + E + suf) : 0.f; suf += lf[kt][j]; }
        run += Tk[kt]; }
    R = run;
    bf16x8 pf[2]; pack_p(pf, w);
    pv_tile(o, vb, pf, lane);
}

__device__ __forceinline__ void sb_block_stream(const Params& p, LAS unsigned char* lds, int tid, int wid, int lane) {
    const u16* qkvb = (const u16*)(p.ws + WS_QKVB); u16* yb = (u16*)(p.ws + WS_AB) + (size_t)T_ * 512;
    const int r = lane & 15, g = lane >> 4, G = gridDim.x, total = (T_ / 128) * NH;
    int i = (G & 7) == 0 ? (int)(blockIdx.x & 7) * (G >> 3) + (int)(blockIdx.x >> 3) : (int)blockIdx.x; if (i >= total) return;
    int cch = i >> 3, h = i & 7;
    bf16x8 qf[2]; load_qf(qf, qkvb + (size_t)(cch * 128 + wid * 16 + r) * LDA_ + h * 64, lane);
#define KBIG(b_) ((b_) * 73728)
#define VBIG(b_) ((b_) * 73728 + 36864)
    CoopKV cN[3]; const int o_ = (tid >> 3) * 144 + (tid & 7) * 16;
    { const int ns0 = cch == 0 ? 2 : 3;
#pragma unroll
      for (int s4 = 0; s4 < 3; ++s4) if (s4 < ns0) coop_load(cN[s4], qkvb + (size_t)((2 * cch + 1 - s4) * 64) * LDA_ + 512 + h * 64, tid);
#pragma unroll
      for (int s4 = 0; s4 < 3; ++s4) if (s4 < ns0) { *(LAS u32x4*)(lds + KBIG(0) + s4 * 9216 + o_) = cN[s4].k; *(LAS u32x4*)(lds + VBIG(0) + s4 * 9216 + o_) = cN[s4].v; } }
    __syncthreads();
    int buf = 0;
    for (;;) {
        const int i2 = i + G; const bool has_next = i2 < total; const int c2 = i2 >> 3, h2 = i2 & 7;
        const int q0 = cch * 128 + wid * 16, t = q0 + r, dw = 2 * cch + (wid >> 2);
        const int nstep = cch == 0 ? 2 : 3, ns2 = c2 == 0 ? 2 : 3;
        const u16* kb = qkvb + 512 + h * 64;
        f32x4 o[4];
#pragma unroll
        for (int q_ = 0; q_ < 4; ++q_) o[q_] = (f32x4){0.f, 0.f, 0.f, 0.f};
        float R = 0.f; bool done = false; bf16x8 qn[2] = {qf[0], qf[1]};
        if (has_next) {
#pragma unroll
            for (int s4 = 0; s4 < 3; ++s4) if (s4 < ns2) coop_load(cN[s4], qkvb + (size_t)((2 * c2 + 1 - s4) * 64) * LDA_ + 512 + h2 * 64, tid);
            load_qf(qn, qkvb + (size_t)(c2 * 128 + wid * 16 + r) * LDA_ + h2 * 64, lane); }
        int tile = 2 * cch + 1;
#pragma unroll 1
        for (int s4 = 0; s4 < nstep; ++s4, --tile)
            if (tile <= dw && !done) { sb_tile_l(lds + KBIG(buf) + s4 * 9216, lds + VBIG(buf) + s4 * 9216, tile * 64, t, qf, R, o, lane);
                done = (tile == 0) || (__builtin_amdgcn_ballot_w64(R > -57.7f) == 0ull); }
        if (has_next) {
#pragma unroll
            for (int s4 = 0; s4 < 3; ++s4) if (s4 < ns2) { *(LAS u32x4*)(lds + KBIG(buf ^ 1) + s4 * 9216 + o_) = cN[s4].k; *(LAS u32x4*)(lds + VBIG(buf ^ 1) + s4 * 9216 + o_) = cN[s4].v; } }
        int any = __syncthreads_or(done ? 0 : 1);
        while (any && tile >= 0) {
            CoopKV c3; coop_load(c3, kb + (size_t)(tile * 64) * LDA_, tid);
            *(LAS u32x4*)(lds + KBIG(buf) + o_) = c3.k; *(LAS u32x4*)(lds + VBIG(buf) + o_) = c3.v; __syncthreads();
            if (!done) { sb_tile_l(lds + KBIG(buf), lds + VBIG(buf), tile * 64, t, qf, R, o, lane);
                done = (tile == 0) || (__builtin_amdgcn_ballot_w64(R > -57.7f) == 0ull); }
            any = __syncthreads_or(done ? 0 : 1); --tile;
        }
#pragma unroll
        for (int dt = 0; dt < 4; ++dt) { u32x2 b; b[0] = cvt_pk_bf16(o[dt][0], o[dt][1]); b[1] = cvt_pk_bf16(o[dt][2], o[dt][3]);
            *(u32x2*)(yb + (size_t)t * 512 + h * 64 + 16 * dt + 4 * g) = b; }
        if (!has_next) break;
        buf ^= 1;
        i = i2; cch = c2; h = h2; qf[0] = qn[0]; qf[1] = qn[1];
    }
#undef KBIG
#undef VBIG
}

#define XB_TMO      128
#define XB_XCNT(j)  (256  + 64 * (j))
#define XB_XSUB(j)  (1280 + 64 * (j))
#define XB_XGEN(j)  (2304 + 64 * (j))
#define XB_TOP      3328
#define XB_TOPGEN   3392
#define XCD_BAR_WORDS 3456
#define XB_SPIN_CAP (1u << 22)
__device__ __forceinline__ unsigned xb_ld(unsigned* p)              { return __hip_atomic_load(p, __ATOMIC_RELAXED, __HIP_MEMORY_SCOPE_AGENT); }
__device__ __forceinline__ unsigned xb_add(unsigned* p, unsigned v) { return __hip_atomic_fetch_add(p, v, __ATOMIC_RELAXED, __HIP_MEMORY_SCOPE_AGENT); }
__device__ __forceinline__ unsigned xb_xcc_id() { return (unsigned)__builtin_amdgcn_s_getreg((3 << 11) | 20) & 0xFu; }
#define XB_SPIN(cond, bar) do { unsigned _sp = 0; while (cond) { __builtin_amdgcn_s_sleep(1); \
    if ((++_sp & 255u) == 0u) { if (xb_ld(&(bar)[XB_TMO])) break; if (_sp > XB_SPIN_CAP) { atomicAdd(&(bar)[XB_TMO], 1u); break; } } } } while (0)
struct XcdBarrier { unsigned* bar; unsigned x; volatile LAS unsigned* st; };
__device__ __forceinline__ XcdBarrier xcd_barrier_post(unsigned* bar, volatile LAS unsigned* st) {
    XcdBarrier b; b.bar = bar; b.x = xb_xcc_id(); b.st = st;
    if (threadIdx.x == 0) (void)xb_add(&bar[XB_XCNT(b.x)], 1u);
    return b;
}
__device__ __forceinline__ void xcd_barrier_complete(unsigned* bar, unsigned x, unsigned& nloc, unsigned& nx) {
    const unsigned G = gridDim.x * gridDim.y * gridDim.z;
    unsigned sum, cnt, mine, sp = 0u;
    for (;;) {
        sum = 0u; cnt = 0u; mine = 0u;
#pragma unroll
        for (unsigned j = 0; j < 16; ++j) { const unsigned c = xb_ld(&bar[XB_XCNT(j)]); sum += c; cnt += (c > 0u) ? 1u : 0u; mine = (j == x) ? c : mine; }
        if (sum == G) break;
        __builtin_amdgcn_s_sleep(1);
        if ((++sp & 255u) == 0u) { if (xb_ld(&bar[XB_TMO])) break; if (sp > XB_SPIN_CAP) { atomicAdd(&bar[XB_TMO], 1u); break; } }
    }
    nloc = mine > 0u ? mine : 1u; nx = cnt > 0u ? cnt : 1u;
}
__device__ __forceinline__ void xcd_barrier_arrive(const XcdBarrier& b) {
    asm volatile("s_waitcnt vmcnt(0)" ::: "memory");
    __syncthreads();
    if (threadIdx.x == 0) {
        unsigned* bar = b.bar;
        __builtin_amdgcn_s_waitcnt(0);
        unsigned nloc = b.st[0], nx = b.st[1];
        if (nloc == 0u) { xcd_barrier_complete(bar, b.x, nloc, nx); b.st[0] = nloc; b.st[1] = nx; }
        const unsigned old = xb_add(&bar[XB_XSUB(b.x)], 1u);
        const unsigned gen = old / nloc;
        if (old + 1u == (gen + 1u) * nloc) {
            __builtin_amdgcn_fence(__ATOMIC_RELEASE, "agent");
            asm volatile("s_waitcnt vmcnt(0)" ::: "memory");
            const unsigned og = xb_add(&bar[XB_TOP], 1u);
            const unsigned tg = og / nx;
            if (og + 1u == (tg + 1u) * nx) xb_add(&bar[XB_TOPGEN], 1u);
        }
    }
}
__device__ __forceinline__ void xcd_barrier_wait(const XcdBarrier& b) {
    if (threadIdx.x == 0) {
        unsigned* bar = b.bar;
        const unsigned tgen = b.st[2]; b.st[2] = tgen + 1u;
        XB_SPIN(xb_ld(&bar[XB_TOPGEN]) <= tgen, bar);
        __builtin_amdgcn_fence(__ATOMIC_ACQUIRE, "agent");
        asm volatile("s_waitcnt vmcnt(0)" ::: "memory");
    }
    __syncthreads();
}
__device__ __forceinline__ void xcd_barrier(const XcdBarrier& b) { xcd_barrier_arrive(b); xcd_barrier_wait(b); }

#define PH_PROLOG int tid_ = threadIdx.x; asm volatile("" : "+v"(tid_)); const int tid = tid_, lane = tid & 63, wid = __builtin_amdgcn_readfirstlane(tid >> 6); \
    const int G = gridDim.x, W = blockIdx.x * 8 + wid, NW = G * 8; LAS unsigned char* vs = lds + wid * 9216; (void)vs; (void)W; (void)NW; (void)lane; (void)G;
#ifndef REP_MASK
#define REP_MASK 0
#endif
#ifndef REPN
#define REPN 2
#endif
#ifndef EXTRA_SYNCS
#define EXTRA_SYNCS 0
#endif
#define PHASE(N, ...) if constexpr ((PH_MASK >> N) & 1) { if (p.ph_lo <= N && N < p.ph_hi) { \
    for (int rep_ = 0; rep_ < (((REP_MASK >> N) & 1) ? REPN : 1); ++rep_) { if (rep_) xcd_barrier(xb); { PH_PROLOG __VA_ARGS__ } } } } if (p.ph_lo <= N && N + 1 < p.ph_hi) xcd_barrier(xb);
#define PHASE_S(N, SLOT, ...) if constexpr ((PH_MASK >> N) & 1) { if (p.ph_lo <= N && N < p.ph_hi) { { PH_PROLOG __VA_ARGS__ } } } \
    if (p.ph_lo <= N && N + 1 < p.ph_hi) { xcd_barrier_arrive(xb); \
        { constexpr int lo_ = 2 * 16 * 44 + 44 * 16 + 16 * 80 + 2 * 8 * 16 + 16 * 16 + (SLOT) * 512, end_ = 2 * 16 * 44 + 44 * 16 + 16 * 80 + 2 * 8 * 16 + 16 * 16 + 2 * 16 * 44 + 44 * 16; \
          if ((int)gridDim.x == 256) { if (N == 4) { if ((int)blockIdx.x < 128) deferred_weights(p, lds, (int)blockIdx.x, 128, lo_, (lo_ + 512 < end_ ? lo_ + 512 : end_)); }     \
            else deferred_weights(p, lds, (int)blockIdx.x, 256, lo_, (lo_ + 512 < end_ ? lo_ + 512 : end_)); } } \
        xcd_barrier_wait(xb); }

__global__ void __launch_bounds__(512) fwd_megakernel(Params p) {
    extern __shared__ __attribute__((aligned(16))) unsigned char shm_raw[];
    LAS unsigned char* lds = (LAS unsigned char*)shm_raw;
    cg::grid_group grid = cg::this_grid();
    unsigned char* ws = p.ws;
    volatile LAS unsigned* xst = (volatile LAS unsigned*)(lds + XST_OFF);
    if (threadIdx.x == 0) { xst[0] = 0u; xst[1] = 0u; xst[2] = 0u; }
    __syncthreads();
    XcdBarrier xb = xcd_barrier_post(g_sync, xst);
    if (p.use_cg) grid.sync();

    for (int es_ = 0; es_ < EXTRA_SYNCS; ++es_) xcd_barrier(xb);
    PHASE(0, prep_phase(p, lds);)
    PHASE(1, pg8::StaticOrder S; S.init(T_, 2 * DFF, G, blockIdx.x); pg8::Gemm g{(const u16*)(ws + WS_AB), (const u16*)(ws + WS_GU1), T_, 2 * DFF, D_};
             build_rtab(lds, S, (const float*)(ws + WS_P0)); EpiSwiglu E{(u16*)(ws + WS_ACT), lds}; pg8::gemm_phase(lds, g, S, E);
             { const int nfull = (T_ / 256) * (2 * DFF / 256) - 5 * G;
               constexpr int lo_ = 2 * 16 * 44, hi_ = lo_ + 44 * 16 + 16 * 80 + 2 * 8 * 16 + 16 * 16;
               if (nfull >= 0 && nfull < G) { if ((int)blockIdx.x >= nfull) deferred_weights(p, lds, (int)blockIdx.x - nfull, G - nfull, lo_, hi_); }
               else deferred_weights(p, lds, (int)blockIdx.x, G, lo_, hi_); })
    PHASE_S(2, 0, pg8::StaticOrder S; S.init(T_, D_, G, blockIdx.x); pg8::Gemm g{(const u16*)(ws + WS_ACT), (const u16*)(ws + WS_DN1), T_, D_, DFF};
             EpiResid<false> E{(const u16*)(ws + WS_AB), nullptr, (u16*)p.out, (float*)(ws + WS_P1), 0.5f}; pg8::gemm_phase(lds, g, S, E);)
    PHASE_S(3, 1, pg8::StaticOrder S; S.init(T_, DIN, G, blockIdx.x); pg8::Gemm g{(const u16*)p.out, (const u16*)(ws + WS_IN), T_, DIN, D_};
             build_rtab(lds, S, (const float*)(ws + WS_P1)); EpiWin E{(u16*)(ws + WS_QKVA), (u16*)(ws + WS_QKVB), (u16*)(ws + WS_GATES), lds, (const float*)(ws + WS_CS), p.bg, (float*)(ws + WS_KMEAN)}; pg8::gemm_phase(lds, g, S, E);)
    PHASE_S(4, 2, for (int i = W; i < (T_ / 64) * NH; i += NW) topk_item(p, i, lane, (LAS int*)(lds + wid * 512));
             __syncthreads(); sb_block_stream(p, lds, tid, wid, lane); __syncthreads();)
    PHASE_S(6, 3, LAS int* pref = (LAS int*)(lds + 96 * 1024); const int* cnt = (const int*)(ws + WS_CNT);
             __syncthreads();
             pref[tid] = (cnt[tid] + 127) >> 7; __syncthreads();
             for (int o = 1; o < 512; o <<= 1) { const int v = tid >= o ? pref[tid - o] : 0; __syncthreads(); pref[tid] += v; __syncthreads(); }
             const int total = pref[511];
             LAS int* sched = (LAS int*)(lds + 148 * 1024);
             { const int slot0 = (G & 7) == 0 ? (int)(blockIdx.x & 7) * (G >> 3) + (int)(blockIdx.x >> 3) : (int)blockIdx.x; const int ii = slot0 + tid * G;
               if (tid < 64 && ii < total) { int lo = 0; int hi = 511; while (lo < hi) { const int mid = (lo + hi) >> 1; if (pref[mid] > ii) hi = mid; else lo = mid + 1; }
                   sched[tid * 4] = lo; sched[tid * 4 + 1] = ii - (lo ? pref[lo - 1] : 0); sched[tid * 4 + 2] = cnt[lo]; } }
             __syncthreads();
             sel_block_stream(p, lds, sched, total, tid, wid, lane);
             __syncthreads();)
    PHASE_S(7, 4, __syncthreads(); own_block_stream(p, lds, tid, wid, lane); __syncthreads();)
    PHASE(8, { pg8::StaticOrder S; S.init(T_, D_, G, blockIdx.x); pg8::Gemm g{(const u16*)(ws + WS_AB), (const u16*)(ws + WS_BA), T_, D_, 512};
               EpiBranch<true> E{(const u16*)(ws + WS_GATES), (u16*)(ws + WS_TMP), (u16*)(ws + WS_MERGED)}; pg8::gemm_phase(lds, g, S, E); }
             { pg8::StaticOrder S; S.init(T_, D_, G, blockIdx.x); pg8::Gemm g{(const u16*)(ws + WS_AB) + (size_t)T_ * 512, (const u16*)(ws + WS_BB), T_, D_, 512};
               EpiBranch<false> E{(const u16*)(ws + WS_GATES), (u16*)(ws + WS_TMP), (u16*)(ws + WS_MERGED)}; pg8::gemm_phase(lds, g, S, E); })
    PHASE(9, pg8::StaticOrder S; S.init(T_, D_, G, blockIdx.x); pg8::Gemm g{(const u16*)(ws + WS_MERGED), (const u16*)(ws + WS_WO), T_, D_, D_};
             EpiResid<false> E{(const u16*)p.out, nullptr, (u16*)(ws + WS_AB), (float*)(ws + WS_P2), 1.0f}; pg8::gemm_phase(lds, g, S, E);)
    PHASE(10, pg8::StaticOrder S; S.init(T_, 2 * DFF, G, blockIdx.x); pg8::Gemm g{(const u16*)(ws + WS_AB), (const u16*)(ws + WS_GU2), T_, 2 * DFF, D_};
              build_rtab(lds, S, (const float*)(ws + WS_P2)); EpiSwiglu E{(u16*)(ws + WS_ACT), lds}; pg8::gemm_phase(lds, g, S, E);)
    PHASE(11, pg8::StaticOrder S; S.init(T_, D_, G, blockIdx.x); pg8::Gemm g{(const u16*)(ws + WS_ACT), (const u16*)(ws + WS_DN2), T_, D_, DFF};
              EpiFinal E{(const u16*)(ws + WS_AB), p.out, (float*)(ws + WS_P3), g_sync + 4096, p.nf, 0.5f}; pg8::gemm_phase(lds, g, S, E);)
    asm volatile("s_waitcnt vmcnt(0)" ::: "memory");
    __syncthreads();
    if (threadIdx.x == 0) xst[3] = (__hip_atomic_fetch_add(&g_sync[8192], 1u, __ATOMIC_RELAXED, __HIP_MEMORY_SCOPE_AGENT) == gridDim.x - 1u) ? 1u : 0u;
    __syncthreads();
    if (xst[3]) { for (int i2 = threadIdx.x; i2 < 8192; i2 += 512) g_sync[i2] = 0u; if (threadIdx.x == 0) g_sync[8192] = 0u; }
}

extern "C" void kernel_launch(void* const* d_in, const int* in_sizes, int n_in, void* d_out, int out_size, void* d_ws, size_t ws_size, hipStream_t stream) {
    constexpr int LDS_BYTES = 152 * 1024 + 64 + 7 * 1024;
    static int grid = 0;
    if (grid == 0) {
        int dev = 0, cus = 0, per_cu = 0;
        hipGetDevice(&dev); hipDeviceGetAttribute(&cus, hipDeviceAttributeMultiprocessorCount, dev);
        hipFuncSetAttribute((const void*)fwd_megakernel, hipFuncAttributeMaxDynamicSharedMemorySize, LDS_BYTES);
        hipOccupancyMaxActiveBlocksPerMultiprocessor(&per_cu, (const void*)fwd_megakernel, 512, LDS_BYTES);
        if (per_cu < 1) { fprintf(stderr, "occupancy query says %d blocks/CU\n", per_cu); per_cu = 1; }
        (void)hipGetLastError();
        grid = cus;
        if (ws_size < WS_END) { fprintf(stderr, "workspace too small: %zu < %zu\n", ws_size, (size_t)WS_END); grid = -1; }
    }
    if (grid < 0) return;
    Params p{};
    p.x = (const float*)d_in[0]; p.pos = (const int*)d_in[1];
    p.n1 = (const float*)d_in[2]; p.g1 = (const float*)d_in[3]; p.u1 = (const float*)d_in[4]; p.d1 = (const float*)d_in[5];
    p.nm = (const float*)d_in[6]; p.win = (const float*)d_in[7]; p.bg = (const float*)d_in[8]; p.wba = (const float*)d_in[9]; p.wbb = (const float*)d_in[10]; p.wo = (const float*)d_in[11];
    p.n2 = (const float*)d_in[12]; p.g2 = (const float*)d_in[13]; p.u2 = (const float*)d_in[14]; p.d2 = (const float*)d_in[15]; p.nf = (const float*)d_in[16];
    p.out = (float*)d_out; p.ws = (unsigned char*)d_ws;
#ifndef ONE_LAUNCH
#define ONE_LAUNCH 1
#endif
#if ONE_LAUNCH
    p.ph_lo = 0; p.ph_hi = N_PHASES;
    void* args[] = {&p};
    hipError_t e = hipLaunchCooperativeKernel((const void*)fwd_megakernel, dim3(grid), dim3(512), args, LDS_BYTES, stream);
    if (e != hipSuccess) fprintf(stderr, "cooperative launch failed: %s (grid %d)\n", hipGetErrorString(e), grid);
#else
#ifndef DBG_MASK
#define DBG_MASK 0x1fff
#endif
#ifndef DBG_FPART
#define DBG_FPART 0
#endif
    p.fpart = DBG_FPART;
    for (int ph = 0; ph < N_PHASES; ++ph) { if (!((DBG_MASK >> ph) & 1)) continue; p.ph_lo = ph; p.ph_hi = ph + 1; hipLaunchKernelGGL(fwd_megakernel, dim3(grid), dim3(512), LDS_BYTES, stream, p); }
#endif
}
```

```cpp
#include <hip/hip_runtime.h>
#include <hip/hip_cooperative_groups.h>
#include <cstdio>
namespace cg = cooperative_groups;

#define LAS __attribute__((address_space(3)))
typedef unsigned short u16;
typedef short bf16x8 __attribute__((ext_vector_type(8)));
typedef short s16x4 __attribute__((ext_vector_type(4)));
typedef float f32x4 __attribute__((ext_vector_type(4)));
typedef unsigned u32x4 __attribute__((ext_vector_type(4)));
typedef unsigned u32x2 __attribute__((ext_vector_type(2)));

constexpr int T_ = 16384, D_ = 1024, DFF = 2816, DIN = 5120, NH = 8, HD = 64;
constexpr int LDA_ = 1536;
constexpr float EPS = 1e-6f;
constexpr int LISTH = 256 * 2016;
constexpr int N_PHASES = 12;
#ifndef PH_MASK
#define PH_MASK 0x1fff
#endif

constexpr size_t SZ_GU = (size_t)2 * DFF * D_ * 2, SZ_DN = (size_t)D_ * DFF * 2, SZ_IN = (size_t)DIN * D_ * 2, SZ_BR = (size_t)D_ * 512 * 2, SZ_WO = (size_t)D_ * D_ * 2;
constexpr size_t WS_GU1 = 0, WS_DN1 = WS_GU1 + SZ_GU, WS_IN = WS_DN1 + SZ_DN, WS_BA = WS_IN + SZ_IN, WS_BB = WS_BA + SZ_BR, WS_WO = WS_BB + SZ_BR,
                 WS_GU2 = WS_WO + SZ_WO, WS_DN2 = WS_GU2 + SZ_GU, WS_CS = WS_DN2 + SZ_DN;
constexpr size_t SZ_PART = (size_t)T_ * 16 * 4;
constexpr size_t WS_P0 = WS_CS + (size_t)T_ * 16 * 4, WS_P1 = WS_P0 + SZ_PART, WS_P2 = WS_P1 + SZ_PART, WS_P3 = WS_P2 + SZ_PART;
constexpr size_t WS_KMEAN = WS_P3 + SZ_PART, WS_CNT = WS_KMEAN + (size_t)64 * 2 * 512 * 4, WS_BAR = WS_CNT + 4096, WS_PML = WS_BAR + 32768;
constexpr size_t WS_LIST = WS_PML + (size_t)T_ * NH * 3 * 2 * 4;
constexpr size_t WS_AB = WS_LIST + (size_t)NH * LISTH * 2;
constexpr size_t WS_BIG = WS_AB + (size_t)T_ * D_ * 2;
constexpr size_t SZ_QKV = (size_t)T_ * LDA_ * 2;
constexpr size_t WS_GATES = WS_BIG, WS_QKVA = WS_GATES + (size_t)T_ * 2048 * 2, WS_QKVB = WS_QKVA + SZ_QKV, WS_END = WS_QKVB + SZ_QKV;
constexpr size_t WS_ACT = WS_BIG, WS_TMP = WS_QKVA, WS_MERGED = WS_TMP + (size_t)T_ * D_ * 4, WS_PO = WS_QKVB;
static_assert(WS_END <= (size_t)256 * 1024 * 1024, "workspace");
static_assert(WS_AB % 256 == 0 && WS_BIG % 256 == 0 && WS_LIST % 16 == 0, "align");

__device__ unsigned g_sync[8192 + 64];

struct Params {
    const float* x; const int* pos;
    const float *n1, *g1, *u1, *d1, *nm, *win, *bg, *wba, *wbb, *wo, *n2, *g2, *u2, *d2, *nf;
    float* out; unsigned char* ws;
    int ph_lo, ph_hi, fpart, use_cg;
};

typedef __bf16 bf16x2_t __attribute__((ext_vector_type(2)));
typedef float f32x2_t __attribute__((ext_vector_type(2)));
__device__ __forceinline__ unsigned cvt_pk_bf16(float lo, float hi) { f32x2_t v = {lo, hi}; bf16x2_t b = __builtin_convertvector(v, bf16x2_t); return __builtin_bit_cast(unsigned, b); }
__device__ __forceinline__ float bf2f(u16 b) { return __uint_as_float(((unsigned)b) << 16); }
__device__ __forceinline__ float bflo(unsigned w) { return __uint_as_float(w << 16); }
__device__ __forceinline__ float bfhi(unsigned w) { return __uint_as_float(w & 0xffff0000u); }
__device__ __forceinline__ float fexp2(float x) { return __builtin_amdgcn_exp2f(x); }
__device__ __forceinline__ float frcp(float x) { return __builtin_amdgcn_rcpf(x); }

namespace pg8 {
constexpr int BM = 256, BK = 64, HALF = 128, HTB = HALF * BK * 2, STAGE_BYTES = 8 * HTB, NXCD = 8, WGM = 8;
__host__ __device__ __forceinline__ int lds_byte(int r, int c) { const int st = (r >> 4) * 2 + (c >> 5), rr = r & 15, cc = c & 31, ob = rr * 64 + cc * 2; return st * 1024 + (ob ^ (((ob >> 9) & 1) << 5)); }
__host__ __device__ __forceinline__ void stage_rc(int b, int& R, int& C) { const int st = b / 1024, sb = b % 1024, swz = sb ^ (((sb >> 9) & 1) << 5); R = (st >> 1) * 16 + swz / 64; C = (st & 1) * 32 + (swz % 64) / 2; }
struct Unit { int pm, pn; };
struct Gemm { const u16* A; const u16* Bt; int M, N, K; };
struct StaticOrder {
    int nM, nN, nwg, G, c;
    __host__ __device__ void init(int M, int N, int G_, int c_) { nM = M / BM; nN = N / BM; nwg = nM * nN; G = G_; c = c_; }
    __host__ __device__ bool next(int i, Unit& u) const {
        const long L = (long)i * G + c; if (L >= nwg) return false;
        int wgid = (int)L; { const int q = nwg / NXCD, r = nwg % NXCD, xcd = wgid % NXCD, off = wgid / NXCD; wgid = (xcd < r ? xcd * (q + 1) : r * (q + 1) + (xcd - r) * q) + off; }
        const int nig = WGM * nN, gid = wgid / nig, fm = gid * WGM, gsz = (nM - fm) < WGM ? (nM - fm) : WGM;
        u.pm = fm + ((wgid % nig) % gsz); u.pn = (wgid % nig) / gsz; return true;
    }
};

template <class Epi>
__device__ __forceinline__ void gemm_phase(LAS unsigned char* lds, const Gemm g, const StaticOrder& S, const Epi& E) {
    int tid_ = threadIdx.x; asm volatile("" : "+v"(tid_));
    const int tid = tid_, wid = __builtin_amdgcn_readfirstlane(tid >> 6), lane = tid & 63, wr = wid >> 2, wc = wid & 3, fr = lane & 15, fq = lane >> 4;
    const int K = g.K, nt = K / BK;
    unsigned voffA[2];
#pragma unroll
    for (int i = 0; i < 2; ++i) { int R, C; stage_rc(tid * 16 + i * 8192, R, C); voffA[i] = (unsigned)(R * K + C) * 2u; }
    const size_t kstep = (size_t)(BK * 2);
    const size_t hstep = (size_t)HALF * K * 2;
    const size_t tstep = 2 * hstep;
    const unsigned ldsw = (unsigned)wid * 1024u;
    const int aoff = lds_byte(wr * 64 + fr, fq * 8), boff = lds_byte(wc * 32 + fr, fq * 8);
#define PG8_SA(b, h) (((b) * 2 + (h)) * HTB)
#define PG8_SB(b, h) ((4 + (b) * 2 + (h)) * HTB)
#define PG8_STAGE(bufoff, gbase, voff) do { _Pragma("unroll") for (int _i = 0; _i < 2; ++_i) \
        __builtin_amdgcn_global_load_lds((const unsigned*)((const char*)(gbase) + (voff)[_i]), (LAS unsigned*)(lds + (bufoff) + ldsw + _i * 8192), 16, 0, 0); } while (0)
#define PG8_LDA(dst, b, h) do { _Pragma("unroll") for (int m = 0; m < 4; ++m) _Pragma("unroll") for (int k = 0; k < 2; ++k) dst[m][k] = *(const LAS bf16x8*)(lds + PG8_SA(b, h) + aoff + m * 2048 + k * 1024); } while (0)
#define PG8_LDB(dst, b, h) do { _Pragma("unroll") for (int n = 0; n < 2; ++n) _Pragma("unroll") for (int k = 0; k < 2; ++k) dst[n][k] = *(const LAS bf16x8*)(lds + PG8_SB(b, h) + boff + n * 2048 + k * 1024); } while (0)
#define PG8_MMA(ai, bj, At, Bt) do { __builtin_amdgcn_s_setprio(1); _Pragma("unroll") for (int m = 0; m < 4; ++m) _Pragma("unroll") for (int n = 0; n < 2; ++n) _Pragma("unroll") for (int k = 0; k < 2; ++k) \
        acc[ai][bj][m][n] = __builtin_amdgcn_mfma_f32_16x16x32_bf16(Bt[n][k], At[m][k], acc[ai][bj][m][n], 0, 0, 0); __builtin_amdgcn_s_setprio(0); } while (0)
#define PG8_WAIT_V(n) asm volatile("s_waitcnt vmcnt(" #n ")" ::: "memory")
#define PG8_WAIT_L(n) asm volatile("s_waitcnt lgkmcnt(" #n ")" ::: "memory")
#define PG8_BAR __builtin_amdgcn_s_barrier()
#define PG8_SCHED __builtin_amdgcn_sched_barrier(0)
    Unit cur, nxt; int ui = 0;
    if (!S.next(0, cur)) return;
    f32x4 acc[2][2][4][2];
#pragma unroll
    for (int a = 0; a < 2; ++a)
#pragma unroll
        for (int b = 0; b < 2; ++b)
#pragma unroll
            for (int m = 0; m < 4; ++m)
#pragma unroll
                for (int n = 0; n < 2; ++n) acc[a][b][m][n] = (f32x4){0.f, 0.f, 0.f, 0.f};
    bf16x8 At[4][2], B0[2][2], B1[2][2];
    const char* cA = (const char*)g.A + (size_t)cur.pm * tstep; const char* cB = (const char*)g.Bt + (size_t)cur.pn * tstep;
    PG8_STAGE(PG8_SB(0, 0), cB, voffA); PG8_STAGE(PG8_SA(0, 0), cA, voffA); PG8_STAGE(PG8_SB(0, 1), cB + hstep, voffA); PG8_STAGE(PG8_SA(0, 1), cA + hstep, voffA);
    if (wr == 1) PG8_BAR;
    PG8_WAIT_V(4); PG8_BAR;
    PG8_STAGE(PG8_SB(1, 0), cB + kstep, voffA); PG8_STAGE(PG8_SA(1, 0), cA + kstep, voffA); PG8_STAGE(PG8_SB(1, 1), cB + hstep + kstep, voffA);
    PG8_WAIT_V(6); PG8_BAR;
    for (;;) {
        const bool has_next = S.next(ui + 1, nxt);
        const char* nA = has_next ? (const char*)g.A + (size_t)nxt.pm * tstep : cA; const char* nB = has_next ? (const char*)g.Bt + (size_t)nxt.pn * tstep : cB;
        for (int t = 0; t < nt; t += 2) {
            const bool last = (t == nt - 2);
            const char* a1 = cA + (size_t)(t + 1) * kstep;
            const char* a2 = last ? nA : cA + (size_t)(t + 2) * kstep; const char* b2 = last ? nB : cB + (size_t)(t + 2) * kstep;
            const char* a3 = a2 + kstep; const char* b3 = b2 + kstep;
            PG8_LDB(B0, 0, 0); PG8_SCHED; PG8_LDA(At, 0, 0); PG8_STAGE(PG8_SA(1, 1), a1 + hstep, voffA);
            PG8_WAIT_L(8); PG8_BAR; PG8_WAIT_L(0); PG8_MMA(0, 0, At, B0); PG8_BAR; PG8_SCHED;
            PG8_LDB(B1, 0, 1); PG8_STAGE(PG8_SB(0, 0), b2, voffA);
            PG8_BAR; PG8_WAIT_L(0); PG8_MMA(0, 1, At, B1); PG8_BAR;
            PG8_LDA(At, 0, 1); PG8_STAGE(PG8_SA(0, 0), a2, voffA);
            PG8_BAR; PG8_WAIT_L(0); PG8_MMA(1, 0, At, B0); PG8_BAR; PG8_SCHED;
            PG8_STAGE(PG8_SB(0, 1), b2 + hstep, voffA);
            PG8_WAIT_V(6); PG8_BAR; PG8_MMA(1, 1, At, B1); PG8_BAR;
            PG8_LDB(B0, 1, 0); PG8_SCHED; PG8_LDA(At, 1, 0); PG8_STAGE(PG8_SA(0, 1), a2 + hstep, voffA);
            PG8_WAIT_L(8); PG8_BAR; PG8_WAIT_L(0); PG8_MMA(0, 0, At, B0); PG8_BAR; PG8_SCHED;
            PG8_LDB(B1, 1, 1); PG8_STAGE(PG8_SB(1, 0), b3, voffA);
            PG8_BAR; PG8_WAIT_L(0); PG8_MMA(0, 1, At, B1); PG8_BAR;
            PG8_LDA(At, 1, 1); PG8_STAGE(PG8_SA(1, 0), a3, voffA);
            PG8_BAR; PG8_WAIT_L(0); PG8_MMA(1, 0, At, B0); PG8_BAR; PG8_SCHED;
            PG8_STAGE(PG8_SB(1, 1), b3 + hstep, voffA);
            PG8_WAIT_V(6); PG8_BAR; PG8_MMA(1, 1, At, B1); PG8_BAR;
        }
        if constexpr (!Epi::AFTER_DRAIN) E(acc, cur, ui, wr, wc, fr, fq);
        if (!has_next) break;
#pragma unroll
        for (int a = 0; a < 2; ++a)
#pragma unroll
            for (int b = 0; b < 2; ++b)
#pragma unroll
                for (int m = 0; m < 4; ++m)
#pragma unroll
                    for (int n = 0; n < 2; ++n) acc[a][b][m][n] = (f32x4){0.f, 0.f, 0.f, 0.f};
        cur = nxt; cA = nA; cB = nB; ++ui;
    }
    PG8_WAIT_V(0);
    if (wr == 0) PG8_BAR;
    PG8_BAR;
    if constexpr (Epi::AFTER_DRAIN) E.fused(acc, cur, wr, wc, fr, fq, lane);
#undef PG8_SA
#undef PG8_SB
#undef PG8_STAGE
#undef PG8_LDA
#undef PG8_LDB
#undef PG8_MMA
#undef PG8_WAIT_V
#undef PG8_WAIT_L
#undef PG8_BAR
#undef PG8_SCHED
}
}
using pg8::Unit;
typedef f32x4 Acc[2][2][4][2];

constexpr int XST_OFF = 152 * 1024, RTAB_OFF = XST_OFF + 64;
__device__ __forceinline__ void build_rtab(LAS unsigned char* lds, const pg8::StaticOrder& S, const float* part) {
    LAS float* rtab = (LAS float*)(lds + RTAB_OFF);
    int nu = 0; { pg8::Unit u; while (nu < 7 && S.next(nu, u)) ++nu; }
    for (int idx = threadIdx.x; idx < nu * 256; idx += 512) { pg8::Unit u; S.next(idx >> 8, u);
        const f32x4* pp = (const f32x4*)(part + (size_t)(u.pm * 256 + (idx & 255)) * 16);
        f32x4 a = pp[0], b = pp[1], c = pp[2], d = pp[3]; f32x4 sv = (a + b) + (c + d);
        rtab[idx] = __builtin_amdgcn_rsqf((sv[0] + sv[1] + sv[2] + sv[3]) * (1.0f / D_) + EPS); }
    __syncthreads();
}
__device__ __forceinline__ void rtab_get(float (&rinv)[2][4], LAS const unsigned char* lds, int ui, int wr, int fr) {
    LAS const float* rtab = (LAS const float*)(lds + RTAB_OFF) + ui * 256 + wr * 64 + fr;
#pragma unroll
    for (int ai = 0; ai < 2; ++ai)
#pragma unroll
        for (int m = 0; m < 4; ++m) rinv[ai][m] = rtab[ai * 128 + m * 16];
}

struct EpiSwiglu {
    static constexpr bool AFTER_DRAIN = false;
    u16* act; LAS const unsigned char* lds;
    __device__ __forceinline__ void operator()(const Acc& acc, const Unit& u, int ui, int wr, int wc, int fr, int fq) const {
        const int row0 = u.pm * 256 + wr * 64 + fr, col0 = u.pn * 128 + wc * 32 + fq * 8;
        float rinv[2][4]; rtab_get(rinv, lds, ui, wr, fr);
#pragma unroll
        for (int ai = 0; ai < 2; ++ai)
#pragma unroll
            for (int m = 0; m < 4; ++m) {
                const float ri = rinv[ai][m]; float v[8];
#pragma unroll
                for (int n = 0; n < 2; ++n)
#pragma unroll
                    for (int j = 0; j < 4; ++j) { const float g = acc[ai][0][m][n][j] * ri, up = acc[ai][1][m][n][j] * ri;
                        v[n * 4 + j] = g * frcp(1.0f + fexp2(-1.4426950408889634f * g)) * up; }
                u32x4 o; o[0] = cvt_pk_bf16(v[0], v[1]); o[1] = cvt_pk_bf16(v[2], v[3]); o[2] = cvt_pk_bf16(v[4], v[5]); o[3] = cvt_pk_bf16(v[6], v[7]);
                *(u32x4*)(act + (size_t)(row0 + ai * 128 + m * 16) * DFF + col0) = o;
            }
    }
};

template <bool OF> struct EpiResid {
    static constexpr bool AFTER_DRAIN = true;
    const u16* resid; float* out; u16* hb; float* part; float scale;
    __device__ __forceinline__ void fused(Acc& acc, const Unit& u, int wr, int wc, int fr, int fq, int) const { (*this)(acc, u, 0, wr, wc, fr, fq); }
    __device__ __forceinline__ void operator()(const Acc& acc, const Unit& u, int ui, int wr, int wc, int fr, int fq) const {
        const int row0 = u.pm * 256 + wr * 64 + fr, col0 = u.pn * 256 + wc * 32 + fq * 8;
        u32x4 rwa[2][4][2];
#pragma unroll
        for (int ai = 0; ai < 2; ++ai)
#pragma unroll
            for (int m = 0; m < 4; ++m)
#pragma unroll
                for (int bj = 0; bj < 2; ++bj) rwa[ai][m][bj] = *(const u32x4*)(resid + (size_t)(row0 + ai * 128 + m * 16) * D_ + col0 + bj * 128);
#pragma unroll
        for (int ai = 0; ai < 2; ++ai) {
#pragma unroll
            for (int m = 0; m < 4; ++m) {
                const int row = row0 + ai * 128 + m * 16; float ss = 0.f;
#pragma unroll
                for (int bj = 0; bj < 2; ++bj) {
                    const size_t o = (size_t)row * D_ + col0 + bj * 128;
                    const u32x4 w = rwa[ai][m][bj];
                    f32x4 h0 = (f32x4){bflo(w[0]), bfhi(w[0]), bflo(w[1]), bfhi(w[1])} + acc[ai][bj][m][0] * scale;
                    f32x4 h1 = (f32x4){bflo(w[2]), bfhi(w[2]), bflo(w[3]), bfhi(w[3])} + acc[ai][bj][m][1] * scale;
                    ss += h0[0] * h0[0] + h0[1] * h0[1] + h0[2] * h0[2] + h0[3] * h0[3] + h1[0] * h1[0] + h1[1] * h1[1] + h1[2] * h1[2] + h1[3] * h1[3];
                    if (OF) { *(f32x4*)(out + o) = h0; *(f32x4*)(out + o + 4) = h1; }
                    else { u32x4 b; b[0] = cvt_pk_bf16(h0[0], h0[1]); b[1] = cvt_pk_bf16(h0[2], h0[3]); b[2] = cvt_pk_bf16(h1[0], h1[1]); b[3] = cvt_pk_bf16(h1[2], h1[3]); *(u32x4*)(hb + o) = b; }
                }
                ss += __shfl_xor(ss, 16); ss += __shfl_xor(ss, 32);
                if (fq == 0) part[(size_t)row * 16 + u.pn * 4 + wc] = ss;
            }
        }
    }
};

struct EpiWin {
    static constexpr bool AFTER_DRAIN = false;
    u16 *qkva, *qkvb, *gates; LAS const unsigned char* lds; const float *cs, *bgate; float* kmp;
    __device__ __forceinline__ void operator()(const Acc& acc, const Unit& u, int ui, int wr, int wc, int fr, int fq) const {
        const int row0 = u.pm * 256 + wr * 64 + fr;
        const int pn = u.pn;
        LAS const float* rtab = (LAS const float*)(lds + RTAB_OFF) + ui * 256 + wr * 64 + fr;
        if (pn >= 12) {
            f32x4 bb[2][2];
#pragma unroll
            for (int bj = 0; bj < 2; ++bj) { const int gc = pn * 256 + bj * 128 + wc * 32 - 3072 + fq * 8; bb[bj][0] = *(const f32x4*)(bgate + gc); bb[bj][1] = *(const f32x4*)(bgate + gc + 4); }
#pragma unroll
            for (int bj = 0; bj < 2; ++bj) { const int gc = pn * 256 + bj * 128 + wc * 32 - 3072 + fq * 8;
#pragma unroll
                for (int ai = 0; ai < 2; ++ai)
#pragma unroll
                    for (int m = 0; m < 4; ++m) { const float ri = rtab[ai * 128 + m * 16]; float v[8];
#pragma unroll
                        for (int j = 0; j < 4; ++j) { v[j] = acc[ai][bj][m][0][j] * ri + bb[bj][0][j]; v[4 + j] = acc[ai][bj][m][1][j] * ri + bb[bj][1][j]; }
#pragma unroll
                        for (int j = 0; j < 8; ++j) v[j] = frcp(1.0f + fexp2(-1.4426950408889634f * v[j]));
                        u32x4 o; o[0] = cvt_pk_bf16(v[0], v[1]); o[1] = cvt_pk_bf16(v[2], v[3]); o[2] = cvt_pk_bf16(v[4], v[5]); o[3] = cvt_pk_bf16(v[6], v[7]);
                        *(u32x4*)(gates + (size_t)(row0 + ai * 128 + m * 16) * 2048 + gc) = o; } }
        } else {
            const bool isk = (pn == 2) || (pn == 3);
#pragma unroll
            for (int bj = 0; bj < 2; ++bj) {
                const int g32 = pn * 256 + bj * 128 + wc * 32;
                u16* base = g32 < 1536 ? qkva + g32 : qkvb + (g32 - 1536);
                const bool rot = (g32 < 1024) && ((g32 & 63) == 0) && (fq < 2);
                f32x4 ks0 = {0.f, 0.f, 0.f, 0.f}, ks1 = {0.f, 0.f, 0.f, 0.f};
                if (rot) {
#pragma unroll
                    for (int ai = 0; ai < 2; ++ai) {
                        f32x4 cc[4], sn[4];
#pragma unroll
                        for (int m = 0; m < 4; ++m) { const int row = row0 + ai * 128 + m * 16; cc[m] = *(const f32x4*)(cs + (size_t)row * 16 + fq * 4); sn[m] = *(const f32x4*)(cs + (size_t)row * 16 + 8 + fq * 4); }
#pragma unroll
                        for (int m = 0; m < 4; ++m) { const float ri = rtab[ai * 128 + m * 16]; const int row = row0 + ai * 128 + m * 16;
                            f32x4 a = acc[ai][bj][m][0] * ri, b = acc[ai][bj][m][1] * ri;
                            f32x4 o1 = a * cc[m] - b * sn[m], o2 = b * cc[m] + a * sn[m];
                            u32x2 w1, w2; w1[0] = cvt_pk_bf16(o1[0], o1[1]); w1[1] = cvt_pk_bf16(o1[2], o1[3]); w2[0] = cvt_pk_bf16(o2[0], o2[1]); w2[1] = cvt_pk_bf16(o2[2], o2[3]);
                            *(u32x2*)(base + (size_t)row * LDA_ + fq * 4) = w1; *(u32x2*)(base + (size_t)row * LDA_ + 8 + fq * 4) = w2;
                            ks0 += o1; ks1 += o2; } }
                } else {
#pragma unroll
                    for (int ai = 0; ai < 2; ++ai)
#pragma unroll
                        for (int m = 0; m < 4; ++m) { const float ri = rtab[ai * 128 + m * 16]; const int row = row0 + ai * 128 + m * 16;
                            f32x4 a = acc[ai][bj][m][0] * ri, b = acc[ai][bj][m][1] * ri;
                            u32x4 o; o[0] = cvt_pk_bf16(a[0], a[1]); o[1] = cvt_pk_bf16(a[2], a[3]); o[2] = cvt_pk_bf16(b[0], b[1]); o[3] = cvt_pk_bf16(b[2], b[3]);
                            *(u32x4*)(base + (size_t)row * LDA_ + fq * 8) = o;
                            ks0 += a; ks1 += b; }
                }
                if (isk) {
#pragma unroll
                    for (int j = 0; j < 4; ++j) {
#pragma unroll
                        for (int o = 1; o < 16; o <<= 1) { ks0[j] += __shfl_xor(ks0[j], o); ks1[j] += __shfl_xor(ks1[j], o); } }
                    if (fr == 0) { float* kp = kmp + (size_t)u.pm * 512 + (g32 - 512);
#pragma unroll
                        for (int j = 0; j < 4; ++j) { atomicAdd(kp + (rot ? fq * 4 : fq * 8) + j, ks0[j]); atomicAdd(kp + (rot ? 8 + fq * 4 : fq * 8 + 4) + j, ks1[j]); } }
                }
            }
        }
    }
};

template <bool FIRST> struct EpiBranch {
    static constexpr bool AFTER_DRAIN = true;
    const u16* gates; u16* tmp; u16* merged;
    __device__ __forceinline__ void fused(Acc& acc, const Unit& u, int wr, int wc, int fr, int fq, int) const { (*this)(acc, u, 0, wr, wc, fr, fq); }
    __device__ __forceinline__ void operator()(const Acc& acc, const Unit& u, int ui, int wr, int wc, int fr, int fq) const {
        const int row0 = u.pm * 256 + wr * 64 + fr, col0 = u.pn * 256 + wc * 32 + fq * 8;
        constexpr int NB = FIRST ? 1 : 2, AIB = FIRST ? 2 : 1;
#pragma unroll
        for (int bt = 0; bt < NB; ++bt) {
            u32x4 gw[AIB][4][2], tw[AIB][4][2];
#pragma unroll
            for (int a2 = 0; a2 < AIB; ++a2)
#pragma unroll
                for (int m = 0; m < 4; ++m)
#pragma unroll
                    for (int bj = 0; bj < 2; ++bj) { const int ai = FIRST ? a2 : bt, row = row0 + ai * 128 + m * 16, col = col0 + bj * 128;
                        gw[a2][m][bj] = *(const u32x4*)(gates + (size_t)row * 2048 + (FIRST ? 0 : 1024) + col);
                        if (!FIRST) tw[a2][m][bj] = *(const u32x4*)(tmp + (size_t)row * D_ + col); }
#pragma unroll
            for (int a2 = 0; a2 < AIB; ++a2)
#pragma unroll
                for (int m = 0; m < 4; ++m)
#pragma unroll
                    for (int bj = 0; bj < 2; ++bj) { const int ai = FIRST ? a2 : bt, row = row0 + ai * 128 + m * 16, col = col0 + bj * 128;
                        const u32x4 g2 = gw[a2][m][bj];
                        f32x4 v0 = (f32x4){bflo(g2[0]), bfhi(g2[0]), bflo(g2[1]), bfhi(g2[1])} * acc[ai][bj][m][0];
                        f32x4 v1 = (f32x4){bflo(g2[2]), bfhi(g2[2]), bflo(g2[3]), bfhi(g2[3])} * acc[ai][bj][m][1];
                        if (!FIRST) { const u32x4 t2 = tw[a2][m][bj]; v0 += (f32x4){bflo(t2[0]), bfhi(t2[0]), bflo(t2[1]), bfhi(t2[1])}; v1 += (f32x4){bflo(t2[2]), bfhi(t2[2]), bflo(t2[3]), bfhi(t2[3])}; }
                        u32x4 b; b[0] = cvt_pk_bf16(v0[0], v0[1]); b[1] = cvt_pk_bf16(v0[2], v0[3]); b[2] = cvt_pk_bf16(v1[0], v1[1]); b[3] = cvt_pk_bf16(v1[2], v1[3]);
                        *(u32x4*)((FIRST ? tmp : merged) + (size_t)row * D_ + col) = b; }
        }
    }
};

struct EpiFinal {
    static constexpr bool AFTER_DRAIN = true;
    const u16* resid; float* out; float* part; unsigned* pcnt; const float* gain; float scale;
    __device__ __forceinline__ void operator()(const Acc&, const Unit&, int, int, int, int, int) const {}
    __device__ __forceinline__ void fused(Acc& acc, const Unit& u, int wr, int wc, int fr, int fq, int lane) const {
        const int row0 = u.pm * 256 + wr * 64 + fr, col0 = u.pn * 256 + wc * 32 + fq * 8;
        u32x4 rwa[2][4][2];
#pragma unroll
        for (int ai = 0; ai < 2; ++ai)
#pragma unroll
            for (int m = 0; m < 4; ++m)
#pragma unroll
                for (int bj = 0; bj < 2; ++bj) rwa[ai][m][bj] = *(const u32x4*)(resid + (size_t)(row0 + ai * 128 + m * 16) * D_ + col0 + bj * 128);
#pragma unroll
        for (int ai = 0; ai < 2; ++ai)
#pragma unroll
            for (int m = 0; m < 4; ++m) { float ss = 0.f;
#pragma unroll
                for (int bj = 0; bj < 2; ++bj) { const u32x4 w = rwa[ai][m][bj];
                    f32x4 h0 = (f32x4){bflo(w[0]), bfhi(w[0]), bflo(w[1]), bfhi(w[1])} + acc[ai][bj][m][0] * scale;
                    f32x4 h1 = (f32x4){bflo(w[2]), bfhi(w[2]), bflo(w[3]), bfhi(w[3])} + acc[ai][bj][m][1] * scale;
                    acc[ai][bj][m][0] = h0; acc[ai][bj][m][1] = h1;
                    ss += h0[0] * h0[0] + h0[1] * h0[1] + h0[2] * h0[2] + h0[3] * h0[3] + h1[0] * h1[0] + h1[1] * h1[1] + h1[2] * h1[2] + h1[3] * h1[3]; }
                ss += __shfl_xor(ss, 16); ss += __shfl_xor(ss, 32);
                if (fq == 0) __hip_atomic_store(part + (size_t)(row0 + ai * 128 + m * 16) * 16 + u.pn * 4 + wc, ss, __ATOMIC_RELAXED, __HIP_MEMORY_SCOPE_AGENT); }
        asm volatile("s_waitcnt vmcnt(0)" ::: "memory");
        unsigned* cw = pcnt + u.pm * 16;
        if (lane == 0) {
            __hip_atomic_fetch_add(cw, 1u, __ATOMIC_RELAXED, __HIP_MEMORY_SCOPE_AGENT);
            unsigned sp = 0;
            while (__hip_atomic_load(cw, __ATOMIC_RELAXED, __HIP_MEMORY_SCOPE_AGENT) < 32u) { __builtin_amdgcn_s_sleep(1); if (++sp > (1u << 22)) break; }
        }
        float rinv[2][4];
        { float pv[2][4][4];
#pragma unroll
          for (int ai = 0; ai < 2; ++ai)
#pragma unroll
            for (int m = 0; m < 4; ++m)
#pragma unroll
              for (int k = 0; k < 4; ++k) pv[ai][m][k] = __hip_atomic_load(part + (size_t)(row0 + ai * 128 + m * 16) * 16 + fq * 4 + k, __ATOMIC_RELAXED, __HIP_MEMORY_SCOPE_AGENT);
#pragma unroll
          for (int ai = 0; ai < 2; ++ai)
#pragma unroll
            for (int m = 0; m < 4; ++m) { float sv = (pv[ai][m][0] + pv[ai][m][1]) + (pv[ai][m][2] + pv[ai][m][3]);
                sv += __shfl_xor(sv, 16); sv += __shfl_xor(sv, 32); rinv[ai][m] = __builtin_amdgcn_rsqf(sv * (1.0f / D_) + EPS); } }
        f32x4 gv[2][2];
#pragma unroll
        for (int bj = 0; bj < 2; ++bj)
#pragma unroll
            for (int n = 0; n < 2; ++n) gv[bj][n] = *(const f32x4*)(gain + col0 + bj * 128 + n * 4);
#pragma unroll
        for (int ai = 0; ai < 2; ++ai)
#pragma unroll
            for (int m = 0; m < 4; ++m)
#pragma unroll
                for (int bj = 0; bj < 2; ++bj)
#pragma unroll
                    for (int n = 0; n < 2; ++n)
                        *(f32x4*)(out + (size_t)(row0 + ai * 128 + m * 16) * D_ + col0 + bj * 128 + n * 4) = acc[ai][bj][m][n] * rinv[ai][m] * gv[bj][n];
    }
};

__device__ __forceinline__ int map_gu(int c, int up) { const int pn = c >> 7, w = c & 127, wc = w >> 5, r = w & 31; return pn * 256 + up * 128 + wc * 32 + ((r >> 2) & 1) * 16 + (r >> 3) * 4 + (r & 3); }
__device__ __forceinline__ int map_perm8(int c) { const int r = c & 31; return (c & ~31) + ((r >> 2) & 1) * 16 + (r >> 3) * 4 + (r & 3); }
__device__ __forceinline__ int map_win(int c) { if (c < 1024 && (c & 63) < 16) { const int r = c & 15, x2 = r >> 3, i = r & 7; return (c & ~63) + x2 * 16 + (i >> 2) * 4 + (i & 3); } return map_perm8(c); }

struct TileDesc { const float* W; u16* Wt; const float* gain; int K, N, mode, tile; };
struct TileRegs { f32x4 v[2]; float gk[2]; };
__device__ __forceinline__ void tile_load(TileRegs& r, const TileDesc& d) {
    const int ntn = d.N >> 6, tk = d.tile / ntn, tn = d.tile - tk * ntn, k0 = tk * 64, n0 = tn * 64, tid = threadIdx.x;
    const float cscale = d.mode == 3 ? (n0 < 512 ? 0.125f * 1.4426950408889634f : (n0 >= 1536 && n0 < 2048) ? 0.125f * 1.4426950408889634f : 1.0f) : 1.0f;
#pragma unroll
    for (int i = 0; i < 2; ++i) { const int e = tid + i * 512, k = e >> 4, c4 = (e & 15) * 4;
        r.v[i] = *(const f32x4*)(d.W + (size_t)(k0 + k) * d.N + n0 + c4); r.gk[i] = (d.gain ? d.gain[k0 + k] : 1.0f) * cscale; }
}
__device__ __forceinline__ void tile_store(LAS float* tl, const TileRegs& r, const TileDesc& d) {
    const int ntn = d.N >> 6, tk = d.tile / ntn, tn = d.tile - tk * ntn, k0 = tk * 64, n0 = tn * 64, tid = threadIdx.x;
    __syncthreads();
#pragma unroll
    for (int i = 0; i < 2; ++i) { const int e = tid + i * 512, k = e >> 4, c4 = (e & 15) * 4; const f32x4 v = r.v[i] * r.gk[i];
        tl[k * 65 + c4] = v[0]; tl[k * 65 + c4 + 1] = v[1]; tl[k * 65 + c4 + 2] = v[2]; tl[k * 65 + c4 + 3] = v[3]; }
    __syncthreads();
    const int n = tid & 63, kg = tid >> 6; float v[8];
#pragma unroll
    for (int i = 0; i < 8; ++i) v[i] = tl[(kg * 8 + i) * 65 + n];
    const int c = n0 + n; const int rr = d.mode == 0 ? c : d.mode == 1 ? map_gu(c, 0) : d.mode == 2 ? map_gu(c, 1) : d.mode == 3 ? map_win(c) : map_perm8(c);
    u32x4 o; o[0] = cvt_pk_bf16(v[0], v[1]); o[1] = cvt_pk_bf16(v[2], v[3]); o[2] = cvt_pk_bf16(v[4], v[5]); o[3] = cvt_pk_bf16(v[6], v[7]);
    *(u32x4*)(d.Wt + (size_t)rr * d.K + k0 + kg * 8) = o;
}

__device__ __forceinline__ void prep_phase(const Params& p, LAS unsigned char* lds) {
    unsigned char* ws = p.ws; LAS float* tl = (LAS float*)lds;
    const int tid = threadIdx.x, lane = tid & 63, wid = tid >> 6, G = gridDim.x;
    if (blockIdx.x == 0) { ((int*)(ws + WS_CNT))[tid] = 0; }
    if (blockIdx.x < 64) ((float*)(ws + WS_KMEAN))[blockIdx.x * 512 + tid] = 0.f;
    constexpr int T_GU = 16 * 44, T_DN = 44 * 16, T_IN = 16 * 80, T_BR = 8 * 16, T_WO = 16 * 16;
    constexpr int o1 = T_GU, o2 = o1 + T_GU, o3 = o2 + T_DN, o4 = o3 + T_IN, o5 = o4 + T_BR, o6 = o5 + T_BR, o7 = o6 + T_WO, o8 = o7 + T_GU, o9 = o8 + T_GU, o10 = o9 + T_DN;
    auto desc = [&](int t) -> TileDesc {
        if (t < o1) return TileDesc{p.g1, (u16*)(ws + WS_GU1), p.n1, D_, DFF, 1, t};
        if (t < o2) return TileDesc{p.u1, (u16*)(ws + WS_GU1), p.n1, D_, DFF, 2, t - o1};
        if (t < o3) return TileDesc{p.d1, (u16*)(ws + WS_DN1), nullptr, DFF, D_, 4, t - o2};
        if (t < o4) return TileDesc{p.win, (u16*)(ws + WS_IN), p.nm, D_, DIN, 3, t - o3};
        if (t < o5) return TileDesc{p.wba, (u16*)(ws + WS_BA), nullptr, 512, D_, 4, t - o4};
        if (t < o6) return TileDesc{p.wbb, (u16*)(ws + WS_BB), nullptr, 512, D_, 4, t - o5};
        if (t < o7) return TileDesc{p.wo, (u16*)(ws + WS_WO), nullptr, D_, D_, 4, t - o6};
        if (t < o8) return TileDesc{p.g2, (u16*)(ws + WS_GU2), p.n2, D_, DFF, 1, t - o7};
        if (t < o9) return TileDesc{p.u2, (u16*)(ws + WS_GU2), p.n2, D_, DFF, 2, t - o8};
        return TileDesc{p.d2, (u16*)(ws + WS_DN2), nullptr, DFF, D_, 4, t - o9};
    };
    const int NPREP = (int)gridDim.x == 256 ? 2 * T_GU : 2 * T_GU + 2 * T_GU + T_DN;
    auto pdesc = [&](int t) -> TileDesc { return t < 2 * T_GU ? desc(t) : desc(t - 2 * T_GU + o7); };
    { int t = blockIdx.x;
      if (t < NPREP) { TileDesc d = pdesc(t); TileRegs ra; tile_load(ra, d);
        for (;;) { const int tn = t + G; const bool more = tn < NPREP; TileDesc dn = d; TileRegs rb = ra;
            if (more) { dn = pdesc(tn); tile_load(rb, dn); }
            tile_store(tl, ra, d);
            if (!more) break;
            d = dn; ra = rb; t = tn; } } }
    u16* xb = (u16*)(ws + WS_AB); float* part0 = (float*)(ws + WS_P0); float* cs = (float*)(ws + WS_CS);
    f32x4 xv[4];
    { const int row0_ = blockIdx.x * 8 + wid; if (row0_ < T_) {
#pragma unroll
        for (int i = 0; i < 4; ++i) xv[i] = *(const f32x4*)(p.x + (size_t)row0_ * D_ + i * 256 + lane * 4); } }
    for (int row = blockIdx.x * 8 + wid; row < T_; row += G * 8) {
        float ss = 0.f; f32x4 cur[4];
#pragma unroll
        for (int i = 0; i < 4; ++i) cur[i] = xv[i];
        if (row + G * 8 < T_) {
#pragma unroll
            for (int i = 0; i < 4; ++i) xv[i] = *(const f32x4*)(p.x + (size_t)(row + G * 8) * D_ + i * 256 + lane * 4); }
#pragma unroll
        for (int i = 0; i < 4; ++i) { const f32x4 v = cur[i]; ss += v[0] * v[0] + v[1] * v[1] + v[2] * v[2] + v[3] * v[3];
            u32x2 b; b[0] = cvt_pk_bf16(v[0], v[1]); b[1] = cvt_pk_bf16(v[2], v[3]); *(u32x2*)(xb + (size_t)row * D_ + i * 256 + lane * 4) = b; }
#pragma unroll
        for (int o = 32; o >= 1; o >>= 1) ss += __shfl_xor(ss, o);
        if (lane < 16) part0[(size_t)row * 16 + lane] = lane == 0 ? ss : 0.f;
        if (lane >= 16 && lane < 24) {
            const int i = lane - 16;
            const float invf = i == 0 ? 1.0f : i == 1 ? 0.1939227432012558f : i == 2 ? 0.03760603070259094f : i == 3 ? 0.007292664609849453f : i == 4 ? 0.0014142135623842478f
                             : i == 5 ? 0.00027424818836152554f : i == 6 ? 5.318296098266728e-05f : 1.0313386155758053e-05f;
            const float ang = (float)p.pos[row] * invf;
            const double a = (double)ang, kk = __builtin_rint(a * 0.15915494309189535), r = a - kk * 6.283185307179586;
            const float rf = (float)r;
            cs[(size_t)row * 16 + i] = __cosf(rf); cs[(size_t)row * 16 + 8 + i] = __sinf(rf);
        }
    }
}


__device__ __forceinline__ void deferred_weights(const Params& p, LAS unsigned char* lds, int j, int nidle, int lo, int hi) {
    unsigned char* ws = p.ws; LAS float* tl = (LAS float*)lds;
    constexpr int T_GU = 16 * 44, T_DN = 44 * 16, T_IN = 16 * 80, T_BR = 8 * 16, T_WO = 16 * 16;
    constexpr int o2 = 2 * T_GU, o3 = o2 + T_DN, o4 = o3 + T_IN, o5 = o4 + T_BR, o6 = o5 + T_BR, o7 = o6 + T_WO, o8 = o7 + T_GU, o9 = o8 + T_GU;
    auto desc = [&](int t) -> TileDesc {
        if (t < o3) return TileDesc{p.d1, (u16*)(ws + WS_DN1), nullptr, DFF, D_, 4, t - o2};
        if (t < o4) return TileDesc{p.win, (u16*)(ws + WS_IN), p.nm, D_, DIN, 3, t - o3};
        if (t < o5) return TileDesc{p.wba, (u16*)(ws + WS_BA), nullptr, 512, D_, 4, t - o4};
        if (t < o6) return TileDesc{p.wbb, (u16*)(ws + WS_BB), nullptr, 512, D_, 4, t - o5};
        if (t < o7) return TileDesc{p.wo, (u16*)(ws + WS_WO), nullptr, D_, D_, 4, t - o6};
        if (t < o8) return TileDesc{p.g2, (u16*)(ws + WS_GU2), p.n2, D_, DFF, 1, t - o7};
        if (t < o9) return TileDesc{p.u2, (u16*)(ws + WS_GU2), p.n2, D_, DFF, 2, t - o8};
        return TileDesc{p.d2, (u16*)(ws + WS_DN2), nullptr, DFF, D_, 4, t - o9};
    };
    int t = lo + j;
    if (t < hi) { TileDesc d = desc(t); TileRegs ra; tile_load(ra, d);
        for (;;) { const int tn = t + nidle; const bool more = tn < hi; TileDesc dn = d; TileRegs rb = ra;
            if (more) { dn = desc(tn); tile_load(rb, dn); }
            tile_store(tl, ra, d);
            if (!more) break;
            d = dn; ra = rb; t = tn; } }
}

__device__ __forceinline__ s16x4 vtr(LAS const unsigned char* p) { typedef short v4i16_t __attribute__((ext_vector_type(4))); return __builtin_bit_cast(s16x4, __builtin_amdgcn_ds_read_tr16_b64_v4i16((LAS v4i16_t*)p)); }

__device__ __forceinline__ void pv_tile(f32x4 (&o)[4], LAS const unsigned char* vs, const bf16x8 (&pf)[2], int lane) {
    const int li = lane & 15, g = lane >> 4, q_ = li >> 2, pp = li & 3;
    LAS const unsigned char* b0 = vs + (4 * g + q_) * 144 + pp * 8;
#pragma unroll
    for (int ks = 0; ks < 2; ++ks)
#pragma unroll
        for (int dt = 0; dt < 4; ++dt) {
            s16x4 lo = vtr(b0 + (32 * ks) * 144 + dt * 32), hi = vtr(b0 + (32 * ks + 16) * 144 + dt * 32);
            bf16x8 va = {lo[0], lo[1], lo[2], lo[3], hi[0], hi[1], hi[2], hi[3]};
            o[dt] = __builtin_amdgcn_mfma_f32_16x16x32_bf16(va, pf[ks], o[dt], 0, 0, 0);
        }
}
__device__ __forceinline__ void pack_p(bf16x8 (&pf)[2], const float (&w)[4][4]) {
#pragma unroll
    for (int ks = 0; ks < 2; ++ks) { u32x4 t; t[0] = cvt_pk_bf16(w[2 * ks][0], w[2 * ks][1]); t[1] = cvt_pk_bf16(w[2 * ks][2], w[2 * ks][3]);
        t[2] = cvt_pk_bf16(w[2 * ks + 1][0], w[2 * ks + 1][1]); t[3] = cvt_pk_bf16(w[2 * ks + 1][2], w[2 * ks + 1][3]); pf[ks] = __builtin_bit_cast(bf16x8, t); }
}
__device__ __forceinline__ void load_qf(bf16x8 (&qf)[2], const u16* qrow, int lane) { const int g = lane >> 4; qf[0] = *(const bf16x8*)(qrow + 8 * g); qf[1] = *(const bf16x8*)(qrow + 32 + 8 * g); }

__device__ __forceinline__ int list_off(int n) { return 256 * (63 * n - (n * (n - 1)) / 2); }

struct Top3 { unsigned k1, k2, k3; };
__device__ __forceinline__ unsigned topk_key(float v, int n) { unsigned u = __float_as_uint(v); u = (u & 0x80000000u) ? ~u : (u | 0x80000000u); return (u & ~63u) | (unsigned)(63 - n); }
__device__ __forceinline__ void top3_insert(Top3& t, unsigned k) {
    const unsigned a1 = t.k1 > k ? t.k1 : k, r1 = t.k1 > k ? k : t.k1;
    const unsigned a2 = t.k2 > r1 ? t.k2 : r1, r2 = t.k2 > r1 ? r1 : t.k2;
    t.k1 = a1; t.k2 = a2; t.k3 = t.k3 > r2 ? t.k3 : r2;
}
__device__ __forceinline__ void topk_item(const Params& p, int item, int lane, LAS int* hist  ) {
    const u16* qkva = (const u16*)(p.ws + WS_QKVA); const float* km = (const float*)(p.ws + WS_KMEAN);
    int* cnt = (int*)(p.ws + WS_CNT); u16* list = (u16*)(p.ws + WS_LIST);
    const int h = item & 7, qc = item >> 3, q0 = qc * 64, own = qc >> 2, r = lane & 15, g = lane >> 4;
    if (own == 0) return;
    int sel[4][3];
#pragma unroll
    for (int qt = 0; qt < 4; ++qt) { sel[qt][0] = 0; sel[qt][1] = 1; sel[qt][2] = 2; }
    if (own > 3) {
        Top3 tp[4];
#pragma unroll
        for (int qt = 0; qt < 4; ++qt) { tp[qt].k1 = 0u; tp[qt].k2 = 0u; tp[qt].k3 = 0u; }
        bf16x8 qfr[4][2];
#pragma unroll
        for (int qt = 0; qt < 4; ++qt) load_qf(qfr[qt], qkva + (size_t)(q0 + 16 * qt + r) * LDA_ + h * 64, lane);
        const int ntile = (own + 15) >> 4;
        for (int nt = 0; nt < ntile; ++nt) {
            const int nrow = 16 * nt + r; const bool nv = nrow < own;
            bf16x8 ahi[2], alo[2];
#pragma unroll
            for (int ks = 0; ks < 2; ++ks) { const float* kp = km + (size_t)(nv ? nrow : 0) * 512 + h * 64 + 32 * ks + 8 * g;
                f32x4 a = *(const f32x4*)kp, b = *(const f32x4*)(kp + 4);
                u32x4 hi; hi[0] = cvt_pk_bf16(a[0], a[1]); hi[1] = cvt_pk_bf16(a[2], a[3]); hi[2] = cvt_pk_bf16(b[0], b[1]); hi[3] = cvt_pk_bf16(b[2], b[3]);
                f32x4 ra = {a[0] - bflo(hi[0]), a[1] - bfhi(hi[0]), a[2] - bflo(hi[1]), a[3] - bfhi(hi[1])}, rb = {b[0] - bflo(hi[2]), b[1] - bfhi(hi[2]), b[2] - bflo(hi[3]), b[3] - bfhi(hi[3])};
                u32x4 lo; lo[0] = cvt_pk_bf16(ra[0], ra[1]); lo[1] = cvt_pk_bf16(ra[2], ra[3]); lo[2] = cvt_pk_bf16(rb[0], rb[1]); lo[3] = cvt_pk_bf16(rb[2], rb[3]);
                ahi[ks] = __builtin_bit_cast(bf16x8, hi); alo[ks] = __builtin_bit_cast(bf16x8, lo); }
#pragma unroll
            for (int qt = 0; qt < 4; ++qt) { f32x4 acc = {0.f, 0.f, 0.f, 0.f};
#pragma unroll
                for (int ks = 0; ks < 2; ++ks) { acc = __builtin_amdgcn_mfma_f32_16x16x32_bf16(ahi[ks], qfr[qt][ks], acc, 0, 0, 0); acc = __builtin_amdgcn_mfma_f32_16x16x32_bf16(alo[ks], qfr[qt][ks], acc, 0, 0, 0); }
#pragma unroll
                for (int j = 0; j < 4; ++j) { const int n = 16 * nt + 4 * g + j; top3_insert(tp[qt], n < own ? topk_key(acc[j], n) : 0u); } }
        }
#pragma unroll
        for (int step = 16; step <= 32; step <<= 1)
#pragma unroll
            for (int qt = 0; qt < 4; ++qt) { const unsigned p1 = __shfl_xor(tp[qt].k1, step), p2 = __shfl_xor(tp[qt].k2, step), p3 = __shfl_xor(tp[qt].k3, step);
                top3_insert(tp[qt], p1); top3_insert(tp[qt], p2); top3_insert(tp[qt], p3); }
#pragma unroll
        for (int qt = 0; qt < 4; ++qt) { sel[qt][0] = 63 - (int)(tp[qt].k1 & 63u); sel[qt][1] = 63 - (int)(tp[qt].k2 & 63u); sel[qt][2] = 63 - (int)(tp[qt].k3 & 63u); }
    }
    const int nsel = own < 3 ? own : 3;
    volatile LAS int* vh = (volatile LAS int*)hist;
    vh[lane] = 0;
    __builtin_amdgcn_fence(__ATOMIC_RELEASE, "wavefront"); __builtin_amdgcn_wave_barrier();
    int rank[4][3];
    if (g == 0) {
#pragma unroll
        for (int qt = 0; qt < 4; ++qt)
#pragma unroll
            for (int s2 = 0; s2 < 3; ++s2) { const int n = sel[qt][s2];
                rank[qt][s2] = s2 < nsel ? __hip_atomic_fetch_add(hist + n, 1, __ATOMIC_RELAXED, __HIP_MEMORY_SCOPE_WORKGROUP) : 0; }
    }
    __builtin_amdgcn_fence(__ATOMIC_ACQ_REL, "wavefront"); __builtin_amdgcn_wave_barrier();
    { const int c = vh[lane]; vh[64 + lane] = c > 0 ? atomicAdd(cnt + h * 64 + lane, c) : 0; }
    __builtin_amdgcn_fence(__ATOMIC_ACQ_REL, "wavefront"); __builtin_amdgcn_wave_barrier();
    if (g == 0) {
#pragma unroll
        for (int qt = 0; qt < 4; ++qt) { const int q = q0 + 16 * qt + r;
#pragma unroll
            for (int s2 = 0; s2 < 3; ++s2) if (s2 < nsel) { const int n = sel[qt][s2];
                list[(size_t)h * LISTH + list_off(n) + vh[64 + n] + rank[qt][s2]] = (u16)(q | (s2 << 14)); } }
    }
}

struct CoopKV { u32x4 k, v; };
#define KB_OFF(b) ((b) * 18432)
#define VB_OFF(b) ((b) * 18432 + 9216)
__device__ __forceinline__ void coop_load(CoopKV& c, const u16* kbase, int tid) { const u16* p = kbase + (size_t)(tid >> 3) * LDA_ + 8 * (tid & 7); c.k = *(const u32x4*)p; c.v = *(const u32x4*)(p + 512); }
__device__ __forceinline__ void qk_lds(f32x4 (&acc)[4], LAS const unsigned char* kb, const bf16x8 (&qf)[2], int lane) {
    const int r = lane & 15, g = lane >> 4;
#pragma unroll
    for (int kt = 0; kt < 4; ++kt) { LAS const unsigned char* kp = kb + (16 * kt + r) * 144 + 16 * g;
        bf16x8 k0 = *(LAS const bf16x8*)kp, k1 = *(LAS const bf16x8*)(kp + 64);
        f32x4 z = {0.f, 0.f, 0.f, 0.f};
        z = __builtin_amdgcn_mfma_f32_16x16x32_bf16(k0, qf[0], z, 0, 0, 0);
        acc[kt] = __builtin_amdgcn_mfma_f32_16x16x32_bf16(k1, qf[1], z, 0, 0, 0); }
}
template <bool CAUSAL>
__device__ __forceinline__ void sm_tile_l(LAS const unsigned char* kb, LAS const unsigned char* vb, int key0, int t, const bf16x8 (&qf)[2], float& m, float& l, f32x4 (&o)[4], int lane) {
    const int g = lane >> 4;
    f32x4 acc[4]; qk_lds(acc, kb, qf, lane);
    float s[4][4]; float lm = -INFINITY;
#pragma unroll
    for (int kt = 0; kt < 4; ++kt)
#pragma unroll
        for (int j = 0; j < 4; ++j) { float v = acc[kt][j]; if (CAUSAL && (key0 + 16 * kt + 4 * g + j) > t) v = -INFINITY; s[kt][j] = v; lm = fmaxf(lm, v); }
    lm = fmaxf(lm, __shfl_xor(lm, 16)); lm = fmaxf(lm, __shfl_xor(lm, 32));
    const float mn = fmaxf(m, lm), al = fexp2(m - mn);
    float sum = 0.f;
#pragma unroll
    for (int kt = 0; kt < 4; ++kt)
#pragma unroll
        for (int j = 0; j < 4; ++j) { s[kt][j] = fexp2(s[kt][j] - mn); sum += s[kt][j]; }
    l = l * al + sum; m = mn;
#pragma unroll
    for (int dt = 0; dt < 4; ++dt) o[dt] *= al;
    bf16x8 pf[2]; pack_p(pf, s);
    pv_tile(o, vb, pf, lane);
}

__device__ __forceinline__ void sel_block_stream(const Params& p, LAS unsigned char* lds, LAS const int* sched, int total, int tid, int wid, int lane) {
    const u16* qkva = (const u16*)(p.ws + WS_QKVA); const u16* list = (const u16*)(p.ws + WS_LIST);
    u16* po = (u16*)(p.ws + WS_PO); float* pml = (float*)(p.ws + WS_PML);
    const int r = lane & 15, g = lane >> 4, G = gridDim.x;
    int i = (G & 7) == 0 ? (int)(blockIdx.x & 7) * (G >> 3) + (int)(blockIdx.x >> 3) : (int)blockIdx.x; if (i >= total) return;
#define SELB_DECODE(kk_, H, N, E, OK, ACT) do { const int hn_ = __builtin_amdgcn_readfirstlane(sched[(kk_) * 4]), grp_ = __builtin_amdgcn_readfirstlane(sched[(kk_) * 4 + 1]), c_ = __builtin_amdgcn_readfirstlane(sched[(kk_) * 4 + 2]); \
        H = hn_ >> 6; N = hn_ & 63; const int e0_ = grp_ * 128 + wid * 16; ACT = e0_ < c_; int ei_ = e0_ + r; OK = ei_ < c_; if (!OK) ei_ = ACT ? e0_ : 0; \
        E = list[(size_t)H * LISTH + list_off(N) + ei_]; } while (0)
    int kq = 0; int h, n; unsigned e; bool ok, act; SELB_DECODE(kq, h, n, e, ok, act);
    bf16x8 qf[2]; load_qf(qf, qkva + (size_t)(e & 0x3FFF) * LDA_ + h * 64, lane);
#define KBIG(b_) ((b_) * 73728)
#define VBIG(b_) ((b_) * 73728 + 36864)
    CoopKV cN[4];
    { const u16* kb0 = qkva + (size_t)(n * 256) * LDA_ + 512 + h * 64;
#pragma unroll
      for (int t4 = 0; t4 < 4; ++t4) coop_load(cN[t4], kb0 + (size_t)t4 * 64 * LDA_, tid);
      const int o_ = (tid >> 3) * 144 + (tid & 7) * 16;
#pragma unroll
      for (int t4 = 0; t4 < 4; ++t4) { *(LAS u32x4*)(lds + KBIG(0) + t4 * 9216 + o_) = cN[t4].k; *(LAS u32x4*)(lds + VBIG(0) + t4 * 9216 + o_) = cN[t4].v; } }
    __syncthreads();
    int buf = 0;
    for (;;) {
        const int i2 = i + G; const bool has_next = i2 < total;
        int h2 = 0, n2 = 0; unsigned e2 = 0; bool ok2 = false, act2 = false;
        if (has_next) { SELB_DECODE(kq + 1, h2, n2, e2, ok2, act2);
            const u16* kb2 = qkva + (size_t)(n2 * 256) * LDA_ + 512 + h2 * 64;
#pragma unroll
            for (int t4 = 0; t4 < 4; ++t4) coop_load(cN[t4], kb2 + (size_t)t4 * 64 * LDA_, tid); }
        f32x4 o[4];
#pragma unroll
        for (int q_ = 0; q_ < 4; ++q_) o[q_] = (f32x4){0.f, 0.f, 0.f, 0.f};
        float m = -INFINITY, l = 0.f; bf16x8 qn[2] = {qf[0], qf[1]};
        if (has_next) load_qf(qn, qkva + (size_t)(e2 & 0x3FFF) * LDA_ + h2 * 64, lane);
        if (act) {
#pragma unroll 1
            for (int tile = 0; tile < 4; ++tile) sm_tile_l<false>(lds + KBIG(buf) + tile * 9216, lds + VBIG(buf) + tile * 9216, 0, 0, qf, m, l, o, lane);
            l += __shfl_xor(l, 16); l += __shfl_xor(l, 32);
            const float inv = frcp(l);
            if (ok) { const size_t sidx = ((size_t)(e & 0x3FFF) * NH + h) * 3 + (e >> 14);
#pragma unroll
                for (int dt = 0; dt < 4; ++dt) { u32x2 b; b[0] = cvt_pk_bf16(o[dt][0] * inv, o[dt][1] * inv); b[1] = cvt_pk_bf16(o[dt][2] * inv, o[dt][3] * inv);
                    *(u32x2*)(po + sidx * 64 + 16 * dt + 4 * g) = b; }
                if (g == 0) { pml[sidx * 2] = m; pml[sidx * 2 + 1] = l; } } }
        if (!has_next) break;
        { const int o_ = (tid >> 3) * 144 + (tid & 7) * 16;
#pragma unroll
          for (int t4 = 0; t4 < 4; ++t4) { *(LAS u32x4*)(lds + KBIG(buf ^ 1) + t4 * 9216 + o_) = cN[t4].k; *(LAS u32x4*)(lds + VBIG(buf ^ 1) + t4 * 9216 + o_) = cN[t4].v; } }
        __syncthreads(); buf ^= 1;
        i = i2; ++kq; h = h2; n = n2; e = e2; ok = ok2; act = act2; qf[0] = qn[0]; qf[1] = qn[1];
    }
#undef KBIG
#undef VBIG
#undef SELB_DECODE
}

__device__ __forceinline__ void own_block_stream(const Params& p, LAS unsigned char* lds, int tid, int wid, int lane) {
    const u16* qkva = (const u16*)(p.ws + WS_QKVA); const u16* po = (const u16*)(p.ws + WS_PO); const float* pml = (const float*)(p.ws + WS_PML);
    u16* ya = (u16*)(p.ws + WS_AB);
    const int r = lane & 15, g = lane >> 4, G = gridDim.x, total = (T_ / 128) * NH;
    int i = (G & 7) == 0 ? (int)(blockIdx.x & 7) * (G >> 3) + (int)(blockIdx.x >> 3) : (int)blockIdx.x, kk = 0; if (i >= total) return;
#define OWN_DEC(ii, k_, C, H) do { C = ((ii) >> 3) ^ ((k_) & 1); H = (ii) & 7; } while (0)
    int cch, h; OWN_DEC(i, kk, cch, h);
    bf16x8 qf[2]; load_qf(qf, qkva + (size_t)(cch * 128 + wid * 16 + r) * LDA_ + h * 64, lane);
#define KBIG(b_) ((b_) * 73728)
#define VBIG(b_) ((b_) * 73728 + 36864)
    CoopKV cN[4]; const int o_ = (tid >> 3) * 144 + (tid & 7) * 16;
    { const u16* kb0 = qkva + (size_t)((cch >> 1) * 256) * LDA_ + 512 + h * 64; const int nt0 = (cch & 1) ? 4 : 2;
#pragma unroll
      for (int t4 = 0; t4 < 4; ++t4) if (t4 < nt0) coop_load(cN[t4], kb0 + (size_t)t4 * 64 * LDA_, tid);
#pragma unroll
      for (int t4 = 0; t4 < 4; ++t4) if (t4 < nt0) { *(LAS u32x4*)(lds + KBIG(0) + t4 * 9216 + o_) = cN[t4].k; *(LAS u32x4*)(lds + VBIG(0) + t4 * 9216 + o_) = cN[t4].v; } }
    __syncthreads();
    int buf = 0;
    for (;;) {
        const int i2 = i + G; const bool has_next = i2 < total; int c2 = 0, h2 = 0; OWN_DEC(i2, kk + 1, c2, h2);
        const int own = cch >> 1, q0 = cch * 128 + wid * 16, t = q0 + r, wmax = ((cch & 1) * 128 + wid * 16 + 15) >> 6;
        const int nt2 = (c2 & 1) ? 4 : 2;
        f32x4 o[4];
#pragma unroll
        for (int q_ = 0; q_ < 4; ++q_) o[q_] = (f32x4){0.f, 0.f, 0.f, 0.f};
        float m = -INFINITY, l = 0.f; bf16x8 qn[2] = {qf[0], qf[1]};
        if (has_next) { const u16* kb2 = qkva + (size_t)((c2 >> 1) * 256) * LDA_ + 512 + h2 * 64;
#pragma unroll
            for (int t4 = 0; t4 < 4; ++t4) if (t4 < nt2) coop_load(cN[t4], kb2 + (size_t)t4 * 64 * LDA_, tid);
            load_qf(qn, qkva + (size_t)(c2 * 128 + wid * 16 + r) * LDA_ + h2 * 64, lane); }
        const int nsel = own < 3 ? own : 3;
        const size_t sidx = ((size_t)t * NH + h) * 3;
        float ms[3], lsv[3]; u32x2 pw[3][4];
#pragma unroll
        for (int s2 = 0; s2 < 3; ++s2) { ms[s2] = -INFINITY; lsv[s2] = 0.f;
#pragma unroll
            for (int dt = 0; dt < 4; ++dt) pw[s2][dt] = (u32x2){0u, 0u};
            if (s2 < nsel) { ms[s2] = pml[(sidx + s2) * 2]; lsv[s2] = pml[(sidx + s2) * 2 + 1];
#pragma unroll
                for (int dt = 0; dt < 4; ++dt) pw[s2][dt] = *(const u32x2*)(po + (sidx + s2) * 64 + 16 * dt + 4 * g); } }
#pragma unroll 1
        for (int tile = 0; tile <= wmax; ++tile) sm_tile_l<true>(lds + KBIG(buf) + tile * 9216, lds + VBIG(buf) + tile * 9216, own * 256 + tile * 64, t, qf, m, l, o, lane);
        l += __shfl_xor(l, 16); l += __shfl_xor(l, 32);
        float M = m;
#pragma unroll
        for (int s2 = 0; s2 < 3; ++s2) M = fmaxf(M, ms[s2]);
        const float a0 = fexp2(m - M); float den = l * a0;
#pragma unroll
        for (int dt = 0; dt < 4; ++dt) o[dt] *= a0;
#pragma unroll
        for (int s2 = 0; s2 < 3; ++s2) { const float a = lsv[s2] * fexp2(ms[s2] - M); den += a;
#pragma unroll
            for (int dt = 0; dt < 4; ++dt) { const u32x2 w = pw[s2][dt];
                o[dt][0] += a * bflo(w[0]); o[dt][1] += a * bfhi(w[0]); o[dt][2] += a * bflo(w[1]); o[dt][3] += a * bfhi(w[1]); } }
        const float inv = frcp(den);
#pragma unroll
        for (int dt = 0; dt < 4; ++dt) { u32x2 b; b[0] = cvt_pk_bf16(o[dt][0] * inv, o[dt][1] * inv); b[1] = cvt_pk_bf16(o[dt][2] * inv, o[dt][3] * inv);
            *(u32x2*)(ya + (size_t)t * 512 + h * 64 + 16 * dt + 4 * g) = b; }
        if (!has_next) break;
#pragma unroll
        for (int t4 = 0; t4 < 4; ++t4) if (t4 < nt2) { *(LAS u32x4*)(lds + KBIG(buf ^ 1) + t4 * 9216 + o_) = cN[t4].k; *(LAS u32x4*)(lds + VBIG(buf ^ 1) + t4 * 9216 + o_) = cN[t4].v; }
        __syncthreads(); buf ^= 1;
        i = i2; ++kk; cch = c2; h = h2; qf[0] = qn[0]; qf[1] = qn[1];
    }
#undef KBIG
#undef VBIG
#undef OWN_DEC
}

__device__ __forceinline__ void sb_tile_l(LAS const unsigned char* kb, LAS const unsigned char* vb, int key0, int t, const bf16x8 (&qf)[2], float& R, f32x4 (&o)[4], int lane) {
    const int g = lane >> 4;
    f32x4 acc[4]; qk_lds(acc, kb, qf, lane);
    float lf[4][4], Tk[4], ex[4];
#pragma unroll
    for (int kt = 0; kt < 4; ++kt) { float c = 0.f;
#pragma unroll
        for (int j = 0; j < 4; ++j) { const bool valid = (key0 + 16 * kt + 4 * g + j) < t; const float z = acc[kt][j];
            const float sp = fmaxf(z, 0.f) + __builtin_amdgcn_logf(1.0f + fexp2(-fabsf(z)));
            acc[kt][j] = z; lf[kt][j] = valid ? -sp : 0.f; c += lf[kt][j]; }
        const float b = __shfl_xor(c, 16), s2 = c + b, d = __shfl_xor(s2, 32);
        Tk[kt] = s2 + d; ex[kt] = ((g & 1) ? 0.f : b) + ((g & 2) ? 0.f : d); }
    float w[4][4]; float run = R;
#pragma unroll
    for (int kt = 3; kt >= 0; --kt) { const float E = run + ex[kt]; float suf = 0.f;
#pragma unroll
        for (int j = 3; j >= 0; --j) { const bool valid = (key0 + 16 * kt + 4 * g + j) < t; w[kt][j] = valid ? fexp2(acc[kt][j] + lf[kt][j] + E + suf) : 0.f; suf += lf[kt][j]; }
        run += Tk[kt]; }
    R = run;
    bf16x8 pf[2]; pack_p(pf, w);
    pv_tile(o, vb, pf, lane);
}

__device__ __forceinline__ void sb_block_stream(const Params& p, LAS unsigned char* lds, int tid, int wid, int lane) {
    const u16* qkvb = (const u16*)(p.ws + WS_QKVB); u16* yb = (u16*)(p.ws + WS_AB) + (size_t)T_ * 512;
    const int r = lane & 15, g = lane >> 4, G = gridDim.x, total = (T_ / 128) * NH;
    int i = (G & 7) == 0 ? (int)(blockIdx.x & 7) * (G >> 3) + (int)(blockIdx.x >> 3) : (int)blockIdx.x; if (i >= total) return;
    int cch = i >> 3, h = i & 7;
    bf16x8 qf[2]; load_qf(qf, qkvb + (size_t)(cch * 128 + wid * 16 + r) * LDA_ + h * 64, lane);
#define KBIG(b_) ((b_) * 73728)
#define VBIG(b_) ((b_) * 73728 + 36864)
    CoopKV cN[3]; const int o_ = (tid >> 3) * 144 + (tid & 7) * 16;
    { const int ns0 = cch == 0 ? 2 : 3;
#pragma unroll
      for (int s4 = 0; s4 < 3; ++s4) if (s4 < ns0) coop_load(cN[s4], qkvb + (size_t)((2 * cch + 1 - s4) * 64) * LDA_ + 512 + h * 64, tid);
#pragma unroll
      for (int s4 = 0; s4 < 3; ++s4) if (s4 < ns0) { *(LAS u32x4*)(lds + KBIG(0) + s4 * 9216 + o_) = cN[s4].k; *(LAS u32x4*)(lds + VBIG(0) + s4 * 9216 + o_) = cN[s4].v; } }
    __syncthreads();
    int buf = 0;
    for (;;) {
        const int i2 = i + G; const bool has_next = i2 < total; const int c2 = i2 >> 3, h2 = i2 & 7;
        const int q0 = cch * 128 + wid * 16, t = q0 + r, dw = 2 * cch + (wid >> 2);
        const int nstep = cch == 0 ? 2 : 3, ns2 = c2 == 0 ? 2 : 3;
        const u16* kb = qkvb + 512 + h * 64;
        f32x4 o[4];
#pragma unroll
        for (int q_ = 0; q_ < 4; ++q_) o[q_] = (f32x4){0.f, 0.f, 0.f, 0.f};
        float R = 0.f; bool done = false; bf16x8 qn[2] = {qf[0], qf[1]};
        if (has_next) {
#pragma unroll
            for (int s4 = 0; s4 < 3; ++s4) if (s4 < ns2) coop_load(cN[s4], qkvb + (size_t)((2 * c2 + 1 - s4) * 64) * LDA_ + 512 + h2 * 64, tid);
            load_qf(qn, qkvb + (size_t)(c2 * 128 + wid * 16 + r) * LDA_ + h2 * 64, lane); }
        int tile = 2 * cch + 1;
#pragma unroll 1
        for (int s4 = 0; s4 < nstep; ++s4, --tile)
            if (tile <= dw && !done) { sb_tile_l(lds + KBIG(buf) + s4 * 9216, lds + VBIG(buf) + s4 * 9216, tile * 64, t, qf, R, o, lane);
                done = (tile == 0) || (__builtin_amdgcn_ballot_w64(R > -57.7f) == 0ull); }
        if (has_next) {
#pragma unroll
            for (int s4 = 0; s4 < 3; ++s4) if (s4 < ns2) { *(LAS u32x4*)(lds + KBIG(buf ^ 1) + s4 * 9216 + o_) = cN[s4].k; *(LAS u32x4*)(lds + VBIG(buf ^ 1) + s4 * 9216 + o_) = cN[s4].v; } }
        int any = __syncthreads_or(done ? 0 : 1);
        while (any && tile >= 0) {
            CoopKV c3; coop_load(c3, kb + (size_t)(tile * 64) * LDA_, tid);
            *(LAS u32x4*)(lds + KBIG(buf) + o_) = c3.k; *(LAS u32x4*)(lds + VBIG(buf) + o_) = c3.v; __syncthreads();
            if (!done) { sb_tile_l(lds + KBIG(buf), lds + VBIG(buf), tile * 64, t, qf, R, o, lane);
                done = (tile == 0) || (__builtin_amdgcn_ballot_w64(R > -57.7f) == 0ull); }
            any = __syncthreads_or(done ? 0 : 1); --tile;
        }
#pragma unroll
        for (int dt = 0; dt < 4; ++dt) { u32x2 b; b[0] = cvt_pk_bf16(o[dt][0], o[dt][1]); b[1] = cvt_pk_bf16(o[dt][2], o[dt][3]);
            *(u32x2*)(yb + (size_t)t * 512 + h * 64 + 16 * dt + 4 * g) = b; }
        if (!has_next) break;
        buf ^= 1;
        i = i2; cch = c2; h = h2; qf[0] = qn[0]; qf[1] = qn[1];
    }
#undef KBIG
#undef VBIG
}

#define XB_TMO      128
#define XB_XCNT(j)  (256  + 64 * (j))
#define XB_XSUB(j)  (1280 + 64 * (j))
#define XB_XGEN(j)  (2304 + 64 * (j))
#define XB_TOP      3328
#define XB_TOPGEN   3392
#define XCD_BAR_WORDS 3456
#define XB_SPIN_CAP (1u << 22)
__device__ __forceinline__ unsigned xb_ld(unsigned* p)              { return __hip_atomic_load(p, __ATOMIC_RELAXED, __HIP_MEMORY_SCOPE_AGENT); }
__device__ __forceinline__ unsigned xb_add(unsigned* p, unsigned v) { return __hip_atomic_fetch_add(p, v, __ATOMIC_RELAXED, __HIP_MEMORY_SCOPE_AGENT); }
__device__ __forceinline__ unsigned xb_xcc_id() { return (unsigned)__builtin_amdgcn_s_getreg((3 << 11) | 20) & 0xFu; }
#define XB_SPIN(cond, bar) do { unsigned _sp = 0; while (cond) { __builtin_amdgcn_s_sleep(1); \
    if ((++_sp & 255u) == 0u) { if (xb_ld(&(bar)[XB_TMO])) break; if (_sp > XB_SPIN_CAP) { atomicAdd(&(bar)[XB_TMO], 1u); break; } } } } while (0)
struct XcdBarrier { unsigned* bar; unsigned x; volatile LAS unsigned* st; };
__device__ __forceinline__ XcdBarrier xcd_barrier_post(unsigned* bar, volatile LAS unsigned* st) {
    XcdBarrier b; b.bar = bar; b.x = xb_xcc_id(); b.st = st;
    if (threadIdx.x == 0) (void)xb_add(&bar[XB_XCNT(b.x)], 1u);
    return b;
}
__device__ __forceinline__ void xcd_barrier_complete(unsigned* bar, unsigned x, unsigned& nloc, unsigned& nx) {
    const unsigned G = gridDim.x * gridDim.y * gridDim.z;
    unsigned sum, cnt, mine, sp = 0u;
    for (;;) {
        sum = 0u; cnt = 0u; mine = 0u;
#pragma unroll
        for (unsigned j = 0; j < 16; ++j) { const unsigned c = xb_ld(&bar[XB_XCNT(j)]); sum += c; cnt += (c > 0u) ? 1u : 0u; mine = (j == x) ? c : mine; }
        if (sum == G) break;
        __builtin_amdgcn_s_sleep(1);
        if ((++sp & 255u) == 0u) { if (xb_ld(&bar[XB_TMO])) break; if (sp > XB_SPIN_CAP) { atomicAdd(&bar[XB_TMO], 1u); break; } }
    }
    nloc = mine > 0u ? mine : 1u; nx = cnt > 0u ? cnt : 1u;
}
__device__ __forceinline__ void xcd_barrier_arrive(const XcdBarrier& b) {
    asm volatile("s_waitcnt vmcnt(0)" ::: "memory");
    __syncthreads();
    if (threadIdx.x == 0) {
        unsigned* bar = b.bar;
        __builtin_amdgcn_s_waitcnt(0);
        unsigned nloc = b.st[0], nx = b.st[1];
        if (nloc == 0u) { xcd_barrier_complete(bar, b.x, nloc, nx); b.st[0] = nloc; b.st[1] = nx; }
        const unsigned old = xb_add(&bar[XB_XSUB(b.x)], 1u);
        const unsigned gen = old / nloc;
        if (old + 1u == (gen + 1u) * nloc) {
            __builtin_amdgcn_fence(__ATOMIC_RELEASE, "agent");
            asm volatile("s_waitcnt vmcnt(0)" ::: "memory");
            const unsigned og = xb_add(&bar[XB_TOP], 1u);
            const unsigned tg = og / nx;
            if (og + 1u == (tg + 1u) * nx) xb_add(&bar[XB_TOPGEN], 1u);
        }
    }
}
__device__ __forceinline__ void xcd_barrier_wait(const XcdBarrier& b) {
    if (threadIdx.x == 0) {
        unsigned* bar = b.bar;
        const unsigned tgen = b.st[2]; b.st[2] = tgen + 1u;
        XB_SPIN(xb_ld(&bar[XB_TOPGEN]) <= tgen, bar);
        __builtin_amdgcn_fence(__ATOMIC_ACQUIRE, "agent");
        asm volatile("s_waitcnt vmcnt(0)" ::: "memory");
    }
    __syncthreads();
}
__device__ __forceinline__ void xcd_barrier(const XcdBarrier& b) { xcd_barrier_arrive(b); xcd_barrier_wait(b); }

#define PH_PROLOG int tid_ = threadIdx.x; asm volatile("" : "+v"(tid_)); const int tid = tid_, lane = tid & 63, wid = __builtin_amdgcn_readfirstlane(tid >> 6); \
    const int G = gridDim.x, W = blockIdx.x * 8 + wid, NW = G * 8; LAS unsigned char* vs = lds + wid * 9216; (void)vs; (void)W; (void)NW; (void)lane; (void)G;
#ifndef REP_MASK
#define REP_MASK 0
#endif
#ifndef REPN
#define REPN 2
#endif
#ifndef EXTRA_SYNCS
#define EXTRA_SYNCS 0
#endif
#define PHASE(N, ...) if constexpr ((PH_MASK >> N) & 1) { if (p.ph_lo <= N && N < p.ph_hi) { \
    for (int rep_ = 0; rep_ < (((REP_MASK >> N) & 1) ? REPN : 1); ++rep_) { if (rep_) xcd_barrier(xb); { PH_PROLOG __VA_ARGS__ } } } } if (p.ph_lo <= N && N + 1 < p.ph_hi) xcd_barrier(xb);
#define PHASE_S(N, SLOT, ...) if constexpr ((PH_MASK >> N) & 1) { if (p.ph_lo <= N && N < p.ph_hi) { { PH_PROLOG __VA_ARGS__ } } } \
    if (p.ph_lo <= N && N + 1 < p.ph_hi) { xcd_barrier_arrive(xb); \
        { constexpr int lo_ = 2 * 16 * 44 + 44 * 16 + 16 * 80 + 2 * 8 * 16 + 16 * 16 + (SLOT) * 512, end_ = 2 * 16 * 44 + 44 * 16 + 16 * 80 + 2 * 8 * 16 + 16 * 16 + 2 * 16 * 44 + 44 * 16; \
          if ((int)gridDim.x == 256) { if (N == 4) { if ((int)blockIdx.x < 128) deferred_weights(p, lds, (int)blockIdx.x, 128, lo_, (lo_ + 512 < end_ ? lo_ + 512 : end_)); }     \
            else deferred_weights(p, lds, (int)blockIdx.x, 256, lo_, (lo_ + 512 < end_ ? lo_ + 512 : end_)); } } \
        xcd_barrier_wait(xb); }

__global__ void __launch_bounds__(512) fwd_megakernel(Params p) {
    extern __shared__ __attribute__((aligned(16))) unsigned char shm_raw[];
    LAS unsigned char* lds = (LAS unsigned char*)shm_raw;
    cg::grid_group grid = cg::this_grid();
    unsigned char* ws = p.ws;
    volatile LAS unsigned* xst = (volatile LAS unsigned*)(lds + XST_OFF);
    if (threadIdx.x == 0) { xst[0] = 0u; xst[1] = 0u; xst[2] = 0u; }
    __syncthreads();
    XcdBarrier xb = xcd_barrier_post(g_sync, xst);
    if (p.use_cg) grid.sync();

    for (int es_ = 0; es_ < EXTRA_SYNCS; ++es_) xcd_barrier(xb);
    PHASE(0, prep_phase(p, lds);)
    PHASE(1, pg8::StaticOrder S; S.init(T_, 2 * DFF, G, blockIdx.x); pg8::Gemm g{(const u16*)(ws + WS_AB), (const u16*)(ws + WS_GU1), T_, 2 * DFF, D_};
             build_rtab(lds, S, (const float*)(ws + WS_P0)); EpiSwiglu E{(u16*)(ws + WS_ACT), lds}; pg8::gemm_phase(lds, g, S, E);
             { const int nfull = (T_ / 256) * (2 * DFF / 256) - 5 * G;
               constexpr int lo_ = 2 * 16 * 44, hi_ = lo_ + 44 * 16 + 16 * 80 + 2 * 8 * 16 + 16 * 16;
               if (nfull >= 0 && nfull < G) { if ((int)blockIdx.x >= nfull) deferred_weights(p, lds, (int)blockIdx.x - nfull, G - nfull, lo_, hi_); }
               else deferred_weights(p, lds, (int)blockIdx.x, G, lo_, hi_); })
    PHASE_S(2, 0, pg8::StaticOrder S; S.init(T_, D_, G, blockIdx.x); pg8::Gemm g{(const u16*)(ws + WS_ACT), (const u16*)(ws + WS_DN1), T_, D_, DFF};
             EpiResid<false> E{(const u16*)(ws + WS_AB), nullptr, (u16*)p.out, (float*)(ws + WS_P1), 0.5f}; pg8::gemm_phase(lds, g, S, E);)
    PHASE_S(3, 1, pg8::StaticOrder S; S.init(T_, DIN, G, blockIdx.x); pg8::Gemm g{(const u16*)p.out, (const u16*)(ws + WS_IN), T_, DIN, D_};
             build_rtab(lds, S, (const float*)(ws + WS_P1)); EpiWin E{(u16*)(ws + WS_QKVA), (u16*)(ws + WS_QKVB), (u16*)(ws + WS_GATES), lds, (const float*)(ws + WS_CS), p.bg, (float*)(ws + WS_KMEAN)}; pg8::gemm_phase(lds, g, S, E);)
    PHASE_S(4, 2, for (int i = W; i < (T_ / 64) * NH; i += NW) topk_item(p, i, lane, (LAS int*)(lds + wid * 512));
             __syncthreads(); sb_block_stream(p, lds, tid, wid, lane); __syncthreads();)
    PHASE_S(6, 3, LAS int* pref = (LAS int*)(lds + 96 * 1024); const int* cnt = (const int*)(ws + WS_CNT);
             __syncthreads();
             { int v = (cnt[tid] + 127) >> 7;
               for (int o = 1; o < 64; o <<= 1) { const int u = __shfl_up(v, o); if (lane >= o) v += u; }
               LAS int* wtot = pref + 512; if (lane == 63) wtot[wid] = v; __syncthreads();
               int add = 0; for (int w2 = 0; w2 < wid; ++w2) add += wtot[w2];
               pref[tid] = v + add; __syncthreads(); }
             const int total = pref[511];
             LAS int* sched = (LAS int*)(lds + 148 * 1024);
             { const int slot0 = (G & 7) == 0 ? (int)(blockIdx.x & 7) * (G >> 3) + (int)(blockIdx.x >> 3) : (int)blockIdx.x; const int ii = slot0 + tid * G;
               if (tid < 64 && ii < total) { int lo = 0; int hi = 511; while (lo < hi) { const int mid = (lo + hi) >> 1; if (pref[mid] > ii) hi = mid; else lo = mid + 1; }
                   sched[tid * 4] = lo; sched[tid * 4 + 1] = ii - (lo ? pref[lo - 1] : 0); sched[tid * 4 + 2] = cnt[lo]; } }
             __syncthreads();
             sel_block_stream(p, lds, sched, total, tid, wid, lane);
             __syncthreads();)
    PHASE_S(7, 4, __syncthreads(); own_block_stream(p, lds, tid, wid, lane); __syncthreads();)
    PHASE(8, { pg8::StaticOrder S; S.init(T_, D_, G, blockIdx.x); pg8::Gemm g{(const u16*)(ws + WS_AB), (const u16*)(ws + WS_BA), T_, D_, 512};
               EpiBranch<true> E{(const u16*)(ws + WS_GATES), (u16*)(ws + WS_TMP), (u16*)(ws + WS_MERGED)}; pg8::gemm_phase(lds, g, S, E); }
             { pg8::StaticOrder S; S.init(T_, D_, G, blockIdx.x); pg8::Gemm g{(const u16*)(ws + WS_AB) + (size_t)T_ * 512, (const u16*)(ws + WS_BB), T_, D_, 512};
               EpiBranch<false> E{(const u16*)(ws + WS_GATES), (u16*)(ws + WS_TMP), (u16*)(ws + WS_MERGED)}; pg8::gemm_phase(lds, g, S, E); })
    PHASE(9, pg8::StaticOrder S; S.init(T_, D_, G, blockIdx.x); pg8::Gemm g{(const u16*)(ws + WS_MERGED), (const u16*)(ws + WS_WO), T_, D_, D_};
             EpiResid<false> E{(const u16*)p.out, nullptr, (u16*)(ws + WS_AB), (float*)(ws + WS_P2), 1.0f}; pg8::gemm_phase(lds, g, S, E);)
    PHASE(10, pg8::StaticOrder S; S.init(T_, 2 * DFF, G, blockIdx.x); pg8::Gemm g{(const u16*)(ws + WS_AB), (const u16*)(ws + WS_GU2), T_, 2 * DFF, D_};
              build_rtab(lds, S, (const float*)(ws + WS_P2)); EpiSwiglu E{(u16*)(ws + WS_ACT), lds}; pg8::gemm_phase(lds, g, S, E);)
    PHASE(11, pg8::StaticOrder S; S.init(T_, D_, G, blockIdx.x); pg8::Gemm g{(const u16*)(ws + WS_ACT), (const u16*)(ws + WS_DN2), T_, D_, DFF};
              EpiFinal E{(const u16*)(ws + WS_AB), p.out, (float*)(ws + WS_P3), g_sync + 4096, p.nf, 0.5f}; pg8::gemm_phase(lds, g, S, E);)
    asm volatile("s_waitcnt vmcnt(0)" ::: "memory");
    __syncthreads();
    if (threadIdx.x == 0) xst[3] = (__hip_atomic_fetch_add(&g_sync[8192], 1u, __ATOMIC_RELAXED, __HIP_MEMORY_SCOPE_AGENT) == gridDim.x - 1u) ? 1u : 0u;
    __syncthreads();
    if (xst[3]) { for (int i2 = threadIdx.x; i2 < 8192; i2 += 512) g_sync[i2] = 0u; if (threadIdx.x == 0) g_sync[8192] = 0u; }
}

extern "C" void kernel_launch(void* const* d_in, const int* in_sizes, int n_in, void* d_out, int out_size, void* d_ws, size_t ws_size, hipStream_t stream) {
    constexpr int LDS_BYTES = 152 * 1024 + 64 + 7 * 1024;
    static int grid = 0;
    if (grid == 0) {
        int dev = 0, cus = 0, per_cu = 0;
        hipGetDevice(&dev); hipDeviceGetAttribute(&cus, hipDeviceAttributeMultiprocessorCount, dev);
        hipFuncSetAttribute((const void*)fwd_megakernel, hipFuncAttributeMaxDynamicSharedMemorySize, LDS_BYTES);
        hipOccupancyMaxActiveBlocksPerMultiprocessor(&per_cu, (const void*)fwd_megakernel, 512, LDS_BYTES);
        if (per_cu < 1) { fprintf(stderr, "occupancy query says %d blocks/CU\n", per_cu); per_cu = 1; }
        (void)hipGetLastError();
        grid = cus;
        if (ws_size < WS_END) { fprintf(stderr, "workspace too small: %zu < %zu\n", ws_size, (size_t)WS_END); grid = -1; }
    }
    if (grid < 0) return;
    Params p{};
    p.x = (const float*)d_in[0]; p.pos = (const int*)d_in[1];
    p.n1 = (const float*)d_in[2]; p.g1 = (const float*)d_in[3]; p.u1 = (const float*)d_in[4]; p.d1 = (const float*)d_in[5];
    p.nm = (const float*)d_in[6]; p.win = (const float*)d_in[7]; p.bg = (const float*)d_in[8]; p.wba = (const float*)d_in[9]; p.wbb = (const float*)d_in[10]; p.wo = (const float*)d_in[11];
    p.n2 = (const float*)d_in[12]; p.g2 = (const float*)d_in[13]; p.u2 = (const float*)d_in[14]; p.d2 = (const float*)d_in[15]; p.nf = (const float*)d_in[16];
    p.out = (float*)d_out; p.ws = (unsigned char*)d_ws;
#ifndef ONE_LAUNCH
#define ONE_LAUNCH 1
#endif
#if ONE_LAUNCH
    p.ph_lo = 0; p.ph_hi = N_PHASES;
    void* args[] = {&p};
    hipError_t e = hipLaunchCooperativeKernel((const void*)fwd_megakernel, dim3(grid), dim3(512), args, LDS_BYTES, stream);
    if (e != hipSuccess) fprintf(stderr, "cooperative launch failed: %s (grid %d)\n", hipGetErrorString(e), grid);
#else
#ifndef DBG_MASK
#define DBG_MASK 0x1fff
#endif
#ifndef DBG_FPART
#define DBG_FPART 0
#endif
    p.fpart = DBG_FPART;
    for (int ph = 0; ph < N_PHASES; ++ph) { if (!((DBG_MASK >> ph) & 1)) continue; p.ph_lo = ph; p.ph_hi = ph + 1; hipLaunchKernelGGL(fwd_megakernel, dim3(grid), dim3(512), LDS_BYTES, stream, p); }
#endif
}
```
